# Optimizing an MI355X kernel written in HIP

```python
import math
import jax
import jax.numpy as jnp
from jax import lax
import numpy as np

D_MODEL = 2048
BATCH = 2
SEQ = 4096
DEPTH = 4

N_MIXERS = 3
D_INNER = D_MODEL
CHUNK = 128
SG_GROUPS = 16
SG_GROUP_DIM = D_INNER // SG_GROUPS
SG_COLS = 3 * D_INNER
HEAD_DIM = 64
SWA_HEADS = D_INNER // HEAD_DIM
SWA_KV_HEADS = SWA_HEADS // 8
SWA_REP = SWA_HEADS // SWA_KV_HEADS
WINDOW = 128
BLOCK = 128
ROPE_THETA = 10000.0
SWA_COLS = 2 * D_INNER + 2 * SWA_KV_HEADS * HEAD_DIM
RWKV_HEAD_DIM = 64
RWKV_HEADS = D_INNER // RWKV_HEAD_DIM
DECAY_LORA = 96
AAA_LORA = 96
RWKV_COLS = 4 * D_INNER + DECAY_LORA + AAA_LORA
DECAY_SCALE = math.exp(-0.5)
GN_EPS = 64e-5
RMS_EPS = 1e-6
LN_EPS = 1e-5
N_A = (DEPTH + 2) // 3
N_B = (DEPTH + 1) // 3
N_C = DEPTH // 3

kernel_name = 'hybrid_sgmlp_swa_rwkv7_adaln'


def rms_norm(x, g):
    xf = x.astype(jnp.float32)
    y = xf * lax.rsqrt(jnp.mean(xf * xf, axis=-1, keepdims=True) + RMS_EPS)
    return (y * g.astype(jnp.float32)).astype(x.dtype)


def token_shift(t):
    return jnp.concatenate([jnp.zeros_like(t[:, :1]), t[:, :-1]], axis=1)


def rope(x, positions):
    half = HEAD_DIM // 2
    inv_freq = ROPE_THETA ** (-jnp.arange(half, dtype=jnp.float32) / half)
    ang = positions.astype(jnp.float32)[..., None] * inv_freq
    cos = jnp.cos(ang)[:, :, None, :]
    sin = jnp.sin(ang)[:, :, None, :]
    xf = x.astype(jnp.float32)
    x1, x2 = xf[..., :half], xf[..., half:]
    return jnp.concatenate([x1 * cos - x2 * sin, x2 * cos + x1 * sin], axis=-1).astype(x.dtype)


def chunked_spatial_gating(p, ln_g, ln_b, w_s, b_s):
    B, T, _ = p.shape
    u, v, z = jnp.split(p, 3, axis=-1)
    u = jax.nn.gelu(u)
    vf = jax.nn.gelu(v).astype(jnp.float32)
    mean = jnp.mean(vf, axis=-1, keepdims=True)
    var = jnp.mean(jnp.square(vf - mean), axis=-1, keepdims=True)
    v = ((vf - mean) * lax.rsqrt(var + LN_EPS) * ln_g.astype(jnp.float32) + ln_b.astype(jnp.float32)).astype(p.dtype)
    nc = T // CHUNK
    v = v.reshape(B, nc, CHUNK, SG_GROUPS, SG_GROUP_DIM)
    causal = jnp.tril(jnp.ones((CHUNK, CHUNK), dtype=bool))
    w = jnp.where(causal[None], w_s, jnp.zeros_like(w_s))
    f = jnp.einsum('gts,bnsgc->bntgc', w, v) + b_s.T[:, :, None]
    f = f.reshape(B, T, D_INNER)
    return u * f * jax.nn.silu(z)


def sliding_window_attention(p, positions, sinks):
    B, T, _ = p.shape
    kvw = SWA_KV_HEADS * HEAD_DIM
    q, k, v, z = jnp.split(p, [D_INNER, D_INNER + kvw, D_INNER + 2 * kvw], axis=-1)
    q = rope(q.reshape(B, T, SWA_HEADS, HEAD_DIM), positions)
    k = rope(k.reshape(B, T, SWA_KV_HEADS, HEAD_DIM), positions)
    v = v.reshape(B, T, SWA_KV_HEADS, HEAD_DIM)
    nb = T // BLOCK
    qb = q.reshape(B, nb, BLOCK, SWA_KV_HEADS, SWA_REP, HEAD_DIM)

    def with_prev(t):
        tb = t.reshape(B, nb, BLOCK, SWA_KV_HEADS, HEAD_DIM)
        prev = jnp.concatenate([jnp.zeros_like(tb[:, :1]), tb[:, :-1]], axis=1)
        return jnp.concatenate([prev, tb], axis=2)

    kb, vb = with_prev(k), with_prev(v)
    s = jnp.einsum('bnqgrd,bnkgd->bngrqk', qb, kb,
                   preferred_element_type=jnp.float32) * (HEAD_DIM ** -0.5)
    qi = jnp.arange(BLOCK)[:, None]
    kj = jnp.arange(2 * BLOCK)[None, :]
    rel = qi + BLOCK - kj
    band = (rel >= 0) & (rel < WINDOW)
    key_pos = jnp.arange(nb)[:, None] * BLOCK + jnp.arange(2 * BLOCK)[None, :] - BLOCK
    mask = band[None] & (key_pos >= 0)[:, None, :]
    s = jnp.where(mask[None, :, None, None], s, -jnp.inf)
    sink = sinks.astype(jnp.float32).reshape(SWA_KV_HEADS, SWA_REP)[None, None, :, :, None, None]
    m = jnp.maximum(jnp.max(s, axis=-1, keepdims=True), sink)
    e = jnp.exp(s - m)
    denom = jnp.sum(e, axis=-1, keepdims=True) + jnp.exp(sink - m)
    prob = (e / denom).astype(p.dtype)
    o = jnp.einsum('bngrqk,bnkgd->bnqgrd', prob, vb).reshape(B, T, D_INNER)
    return o * jax.nn.silu(z)


def rwkv7_time_mix(p, mu, w0, w_lora, a0, a_lora, k_k, k_a, r_k, gn_g, gn_b):
    B, T, _ = p.shape
    H, N = RWKV_HEADS, RWKV_HEAD_DIM
    p = p + (token_shift(p) - p) * mu
    r, k, v, z, dw, da = jnp.split(p, [D_INNER, 2 * D_INNER, 3 * D_INNER, 4 * D_INNER,
                                       4 * D_INNER + DECAY_LORA], axis=-1)
    decay = jnp.exp(-DECAY_SCALE * jax.nn.sigmoid((w0 + jnp.tanh(dw) @ w_lora).astype(jnp.float32)))
    a = jax.nn.sigmoid((a0 + da @ a_lora).astype(jnp.float32))

    def heads(t):
        return t.astype(jnp.float32).reshape(B, T, H, N)

    r, k, v, decay, a = heads(r), heads(k), heads(v), heads(decay), heads(a)
    kk = k * k_k.astype(jnp.float32).reshape(H, N)
    kk = kk / jnp.maximum(jnp.sqrt(jnp.sum(kk * kk, axis=-1, keepdims=True)), 1e-12)
    k = k * (1.0 + (a - 1.0) * k_a.astype(jnp.float32).reshape(H, N))
    b_vec = kk * a

    def step(S, inp):
        r_t, w_t, k_t, v_t, kk_t, b_t = inp
        sa = jnp.einsum('bhvk,bhk->bhv', S, kk_t)
        S = S * w_t[:, :, None, :] - sa[..., None] * b_t[:, :, None, :] + v_t[..., None] * k_t[:, :, None, :]
        y = jnp.einsum('bhvk,bhk->bhv', S, r_t)
        return S, y

    xs = tuple(jnp.moveaxis(t, 1, 0) for t in (r, decay, k, v, kk, b_vec))
    S0 = jnp.zeros((B, H, N, N), jnp.float32)
    _, y = lax.scan(step, S0, xs)
    y = jnp.moveaxis(y, 0, 1)
    mean = jnp.mean(y, axis=-1, keepdims=True)
    var = jnp.mean(jnp.square(y - mean), axis=-1, keepdims=True)
    y = (y - mean) * lax.rsqrt(var + GN_EPS) * gn_g.astype(jnp.float32).reshape(H, N) \
        + gn_b.astype(jnp.float32).reshape(H, N)
    y = y + jnp.sum(r * k * r_k.astype(jnp.float32), axis=-1, keepdims=True) * v
    y = y.reshape(B, T, D_INNER).astype(p.dtype)
    return y * jax.nn.silu(z)


def setup_inputs(seed: int = 0) -> dict:
    key = jax.random.key(seed)
    keys = jax.random.split(key, 32)

    def nrm(i, shape, scale):
        return jax.random.normal(keys[i], shape, jnp.float32) * scale

    positions = jax.random.randint(keys[2], (BATCH, 1), 0, 1024, dtype=jnp.int32) \
        + jnp.arange(SEQ, dtype=jnp.int32)[None, :]
    return {
        'x': nrm(0, (BATCH, SEQ, D_MODEL), 1.0),
        'c': nrm(1, (BATCH, D_MODEL), 1.0),
        'positions': positions,
        'norm_g': 1.0 + nrm(3, (DEPTH, D_MODEL), 0.1),
        'mod_w': nrm(4, (DEPTH, D_MODEL, 3 * D_MODEL), 0.5 * D_MODEL ** -0.5),
        'mod_b': nrm(5, (DEPTH, 3 * D_MODEL), 0.02),
        'final_norm_g': 1.0 + nrm(6, (D_MODEL,), 0.1),
        'sg_w_in': nrm(7, (N_A, D_MODEL, SG_COLS), D_MODEL ** -0.5),
        'sg_w_out': nrm(8, (N_A, D_INNER, D_MODEL), D_INNER ** -0.5),
        'sg_ln_g': 1.0 + nrm(9, (N_A, D_INNER), 0.1),
        'sg_ln_b': nrm(10, (N_A, D_INNER), 0.02),
        'sg_w_spatial': nrm(11, (N_A, SG_GROUPS, CHUNK, CHUNK), CHUNK ** -0.5),
        'sg_b_spatial': 1.0 + nrm(12, (N_A, SG_GROUPS, CHUNK), 0.1),
        'swa_w_in': nrm(13, (N_B, D_MODEL, SWA_COLS), D_MODEL ** -0.5),
        'swa_w_out': nrm(14, (N_B, D_INNER, D_MODEL), D_INNER ** -0.5),
        'swa_sinks': nrm(15, (N_B, SWA_HEADS), 1.0),
        'rwkv_w_in': nrm(16, (N_C, D_MODEL, RWKV_COLS), D_MODEL ** -0.5),
        'rwkv_w_out': nrm(17, (N_C, D_INNER, D_MODEL), D_INNER ** -0.5),
        'rwkv_mu': jax.random.uniform(keys[18], (N_C, RWKV_COLS), jnp.float32),
        'rwkv_w0': jax.random.uniform(keys[19], (N_C, D_INNER), jnp.float32, -4.0, 1.0),
        'rwkv_w_lora': nrm(20, (N_C, DECAY_LORA, D_INNER), DECAY_LORA ** -0.5),
        'rwkv_a0': nrm(21, (N_C, D_INNER), 0.5),
        'rwkv_a_lora': nrm(22, (N_C, AAA_LORA, D_INNER), 0.5 * AAA_LORA ** -0.5),
        'rwkv_k_k': 0.85 + nrm(23, (N_C, D_INNER), 0.1),
        'rwkv_k_a': 1.0 + nrm(24, (N_C, D_INNER), 0.1),
        'rwkv_r_k': nrm(25, (N_C, RWKV_HEADS, RWKV_HEAD_DIM), 0.1),
        'rwkv_gn_g': 1.0 + nrm(26, (N_C, D_INNER), 0.1),
        'rwkv_gn_b': nrm(27, (N_C, D_INNER), 0.02),
    }


def reference(x, c, positions, norm_g, mod_w, mod_b, final_norm_g,
              sg_w_in, sg_w_out, sg_ln_g, sg_ln_b, sg_w_spatial, sg_b_spatial,
              swa_w_in, swa_w_out, swa_sinks,
              rwkv_w_in, rwkv_w_out, rwkv_mu, rwkv_w0, rwkv_w_lora, rwkv_a0, rwkv_a_lora,
              rwkv_k_k, rwkv_k_a, rwkv_r_k, rwkv_gn_g, rwkv_gn_b):
    cond = jax.nn.silu(c)
    for i in range(DEPTH):
        kind, j = i % N_MIXERS, i // N_MIXERS
        mod = (cond @ mod_w[i] + mod_b[i])[:, None, :]
        shift, scale, gate = jnp.split(mod, 3, axis=-1)
        h = rms_norm(x, norm_g[i]) * (1.0 + scale) + shift
        if kind == 0:
            y = chunked_spatial_gating(h @ sg_w_in[j], sg_ln_g[j], sg_ln_b[j],
                                       sg_w_spatial[j], sg_b_spatial[j]) @ sg_w_out[j]
        elif kind == 1:
            y = sliding_window_attention(h @ swa_w_in[j], positions, swa_sinks[j]) @ swa_w_out[j]
        else:
            y = rwkv7_time_mix(h @ rwkv_w_in[j], rwkv_mu[j], rwkv_w0[j], rwkv_w_lora[j],
                               rwkv_a0[j], rwkv_a_lora[j], rwkv_k_k[j], rwkv_k_a[j],
                               rwkv_r_k[j], rwkv_gn_g[j], rwkv_gn_b[j]) @ rwkv_w_out[j]
        x = x + gate * y
    return rms_norm(x, final_norm_g)
```

```cpp
#include <hip/hip_runtime.h>
#include <hip/hip_cooperative_groups.h>
#include <cstdio>
#include <cstdint>
namespace cg = cooperative_groups;

#ifndef SINGLE_LAUNCH
#define SINGLE_LAUNCH 1
#endif

#define LAS __attribute__((address_space(3)))
typedef unsigned short bf16_t;
typedef short bf16x8 __attribute__((ext_vector_type(8)));
typedef float f32x4 __attribute__((ext_vector_type(4)));
typedef float f32x2 __attribute__((ext_vector_type(2)));
typedef unsigned u32x4 __attribute__((ext_vector_type(4)));
typedef unsigned u32x2 __attribute__((ext_vector_type(2)));

constexpr int BATCH = 2, SEQ = 4096, DM = 2048, M = BATCH * SEQ;
constexpr int N_SG = 6144, N_SWA = 4608, N_RW = 8384, N_RWP = 8448;
constexpr int NWAVES = 8, NTHREADS = 512;
constexpr int NCH = 32, CHL = 128;
constexpr float DECAY_SCALE = 0.6065306597126334f;

constexpr size_t MiB = 1u << 20;
constexpr size_t WS_CTL = 0, CTL_BYTES = 1 * MiB;
constexpr size_t WS_BAR = 512 * 1024;
constexpr size_t WS_SSQ = 256 * 1024;
constexpr size_t WS_BIAS = 7 * MiB + 512 * 1024;
constexpr size_t WS_ROPE = 1 * MiB;
constexpr size_t WS_STATS = 3 * MiB;
constexpr size_t WS_BONUS = 5 * MiB;
constexpr size_t WS_LORA = 6 * MiB;
constexpr size_t WS_W = 8 * MiB;
constexpr size_t W_SGIN0 = WS_W, W_SGIN1 = W_SGIN0 + 24 * MiB, W_SGOUT0 = W_SGIN1 + 24 * MiB, W_SGOUT1 = W_SGOUT0 + 8 * MiB;
constexpr size_t W_SWAIN = W_SGOUT1 + 8 * MiB, W_SWAOUT = W_SWAIN + 18 * MiB, W_RWIN = W_SWAOUT + 8 * MiB, W_RWOUT = W_RWIN + 33 * MiB;
constexpr size_t WS_X = 140 * MiB;
constexpr size_t WS_XN = 204 * MiB;
constexpr size_t WS_A2 = 236 * MiB;
constexpr size_t WS_P = 268 * MiB;
constexpr size_t WS_RW = 400 * MiB;
constexpr size_t WS_END = 656 * MiB;
static_assert(W_RWOUT + 8 * MiB <= WS_X, "ws map");

__device__ __forceinline__ unsigned pk2(float lo, float hi) { unsigned r; asm("v_cvt_pk_bf16_f32 %0, %1, %2" : "=v"(r) : "v"(lo), "v"(hi)); return r; }
__device__ __forceinline__ unsigned f2bf(float f) { return pk2(f, 0.f) & 0xffffu; }
__device__ __forceinline__ float bflo(unsigned w) { return __builtin_bit_cast(float, w << 16); }
__device__ __forceinline__ float bfhi(unsigned w) { return __builtin_bit_cast(float, w & 0xffff0000u); }
__device__ __forceinline__ float bf2f(bf16_t h) { return __builtin_bit_cast(float, (unsigned)h << 16); }
__device__ __forceinline__ unsigned cvt_pk_bf16(float lo, float hi) { unsigned r; asm volatile("v_cvt_pk_bf16_f32 %0, %1, %2" : "=v"(r) : "v"(lo), "v"(hi)); return r; }
__device__ __forceinline__ float frcp(float x) { return __builtin_amdgcn_rcpf(x); }
__device__ __forceinline__ float sigmoidf_(float x) { return frcp(1.0f + __expf(-x)); }
__device__ __forceinline__ float siluf_(float x) { return x * frcp(1.0f + __expf(-x)); }
__device__ __forceinline__ float geluf_(float x) { return x * frcp(1.0f + __expf(-1.5957691216057308f * (x + 0.044715f * x * x * x))); }
__device__ __forceinline__ float tanhf_(float x) { return 1.0f - 2.0f * frcp(__expf(2.0f * x) + 1.0f); }
__device__ __forceinline__ float wave_sum(float v) {
#pragma unroll
    for (int o = 1; o < 64; o <<= 1) v += __shfl_xor(v, o);
    return v;
}
__device__ __forceinline__ void unpack8(u32x4 w, float (&f)[8]) {
    f[0] = bflo(w.x); f[1] = bfhi(w.x); f[2] = bflo(w.y); f[3] = bfhi(w.y); f[4] = bflo(w.z); f[5] = bfhi(w.z); f[6] = bflo(w.w); f[7] = bfhi(w.w);
}
__device__ __forceinline__ u32x4 pack8(const float (&f)[8]) {
    u32x4 w; w.x = pk2(f[0], f[1]); w.y = pk2(f[2], f[3]); w.z = pk2(f[4], f[5]); w.w = pk2(f[6], f[7]); return w;
}

namespace pg8 {
constexpr int BM = 256, BK = 64, HALF = 128, HTB = HALF * BK * 2, STAGE_BYTES = 8 * HTB, NXCD = 8, WGM = 8;
__host__ __device__ __forceinline__ int lds_byte(int r, int c) { const int st = (r >> 4) * 2 + (c >> 5), rr = r & 15, cc = c & 31, ob = rr * 64 + cc * 2; return st * 1024 + (ob ^ (((ob >> 9) & 1) << 5)); }
__host__ __device__ __forceinline__ void stage_rc(int b, int& R, int& C) { const int st = b / 1024, sb = b % 1024, swz = sb ^ (((sb >> 9) & 1) << 5); R = (st >> 1) * 16 + swz / 64; C = (st & 1) * 32 + (swz % 64) / 2; }
__host__ __device__ __forceinline__ int perm32(int rho) { const int n = rho >> 4, i = rho & 15; return 8 * (i >> 2) + 4 * n + (i & 3); }
struct Unit { int pm, pn; };
struct Gemm { const bf16_t* A; const bf16_t* Bt; int M, N, K; };
struct StaticOrder {
    int nM, nN, nwg, G, c;
    __device__ void init(int M_, int N_, int G_, int c_) { nM = M_ / BM; nN = N_ / BM; nwg = nM * nN; G = G_; c = c_; }
    __device__ bool next(int i, Unit& u) const {
        const long L = (long)i * G + c; if (L >= nwg) return false;
        int wgid = (int)L; { const int q = nwg / NXCD, r = nwg % NXCD, xcd = wgid % NXCD, off = wgid / NXCD; wgid = (xcd < r ? xcd * (q + 1) : r * (q + 1) + (xcd - r) * q) + off; }
        const int nig = WGM * nN, gid = wgid / nig, fm = gid * WGM, gsz = (nM - fm) < WGM ? (nM - fm) : WGM;
        u.pm = fm + ((wgid % nig) % gsz); u.pn = (wgid % nig) / gsz; return true;
    }
};
template <class Epi>
__device__ __forceinline__ void gemm_phase(LAS unsigned char* lds, const Gemm g, const StaticOrder& S, const Epi& E) {
    const int tid = threadIdx.x, wid = __builtin_amdgcn_readfirstlane(tid >> 6), lane = tid & 63, wr = wid >> 2, wc = wid & 3, fr = lane & 15, fq = lane >> 4;
    const int K = g.K, nt = K / BK;
    unsigned voffA[2], voffB[2];
#pragma unroll
    for (int i = 0; i < 2; ++i) { int R, C; stage_rc(tid * 16 + i * 8192, R, C); const int Rb = (R & ~31) + perm32(R & 31);
        voffA[i] = (unsigned)(R * K + C) * 2u; voffB[i] = (unsigned)(Rb * K + C) * 2u; }
    const size_t kstep = (size_t)(BK * 2);
    const size_t hstep = (size_t)HALF * K * 2;
    const size_t tstep = 2 * hstep;
    const unsigned ldsw = (unsigned)wid * 1024u;
    const int aoff = lds_byte(wr * 64 + fr, fq * 8), boff = lds_byte(wc * 32 + fr, fq * 8);
#define PG8_SA(b, h) (((b) * 2 + (h)) * HTB)
#define PG8_SB(b, h) ((4 + (b) * 2 + (h)) * HTB)
#define PG8_STAGE(bufoff, gbase, voff) do { _Pragma("unroll") for (int _i = 0; _i < 2; ++_i) \
        __builtin_amdgcn_global_load_lds((const unsigned*)((const char*)(gbase) + (voff)[_i]), (LAS unsigned*)(lds + (bufoff) + ldsw + _i * 8192), 16, 0, 0); } while (0)
#define PG8_LDA(dst, b, h) do { _Pragma("unroll") for (int m = 0; m < 4; ++m) _Pragma("unroll") for (int k = 0; k < 2; ++k) dst[m][k] = *(const LAS bf16x8*)(lds + PG8_SA(b, h) + aoff + m * 2048 + k * 1024); } while (0)
#define PG8_LDB(dst, b, h) do { _Pragma("unroll") for (int n = 0; n < 2; ++n) _Pragma("unroll") for (int k = 0; k < 2; ++k) dst[n][k] = *(const LAS bf16x8*)(lds + PG8_SB(b, h) + boff + n * 2048 + k * 1024); } while (0)
#define PG8_MMA(ai, bj, At, Bt) do { __builtin_amdgcn_s_setprio(1); _Pragma("unroll") for (int m = 0; m < 4; ++m) _Pragma("unroll") for (int n = 0; n < 2; ++n) _Pragma("unroll") for (int k = 0; k < 2; ++k) \
        acc[ai][bj][m][n] = __builtin_amdgcn_mfma_f32_16x16x32_bf16(Bt[n][k], At[m][k], acc[ai][bj][m][n], 0, 0, 0); __builtin_amdgcn_s_setprio(0); } while (0)
#define PG8_WAIT_V(n) asm volatile("s_waitcnt vmcnt(" #n ")" ::: "memory")
#define PG8_WAIT_L(n) asm volatile("s_waitcnt lgkmcnt(" #n ")" ::: "memory")
#define PG8_BAR __builtin_amdgcn_s_barrier()
#define PG8_SCHED __builtin_amdgcn_sched_barrier(0)
    Unit cur, nxt; int ui = 0;
    if (!S.next(0, cur)) return;
    f32x4 acc[2][2][4][2];
#pragma unroll
    for (int a = 0; a < 2; ++a)
#pragma unroll
        for (int b = 0; b < 2; ++b)
#pragma unroll
            for (int m = 0; m < 4; ++m)
#pragma unroll
                for (int n = 0; n < 2; ++n) acc[a][b][m][n] = (f32x4){0.f, 0.f, 0.f, 0.f};
    bf16x8 At[4][2], B0[2][2], B1[2][2];
    const char* cA = (const char*)g.A + (size_t)cur.pm * tstep; const char* cB = (const char*)g.Bt + (size_t)cur.pn * tstep;
    PG8_STAGE(PG8_SB(0, 0), cB, voffB); PG8_STAGE(PG8_SB(0, 1), cB + hstep, voffB); PG8_STAGE(PG8_SA(0, 0), cA, voffA); PG8_STAGE(PG8_SA(0, 1), cA + hstep, voffA);
    if (wr == 1) PG8_BAR;
    PG8_WAIT_V(2); PG8_BAR;
    PG8_STAGE(PG8_SB(1, 0), cB + kstep, voffB); PG8_STAGE(PG8_SA(1, 0), cA + kstep, voffA); PG8_STAGE(PG8_SB(1, 1), cB + hstep + kstep, voffB);
    PG8_WAIT_V(6); PG8_BAR;
    for (;;) {
        const bool has_next = S.next(ui + 1, nxt);
        const char* nA = has_next ? (const char*)g.A + (size_t)nxt.pm * tstep : cA; const char* nB = has_next ? (const char*)g.Bt + (size_t)nxt.pn * tstep : cB;
        for (int t = 0; t < nt; t += 2) {
            const bool last = (t == nt - 2);
            const char* a1 = cA + (size_t)(t + 1) * kstep;
            const char* a2 = last ? nA : cA + (size_t)(t + 2) * kstep; const char* b2 = last ? nB : cB + (size_t)(t + 2) * kstep;
            const char* a3 = a2 + kstep; const char* b3 = b2 + kstep;
            PG8_LDB(B0, 0, 0); PG8_LDB(B1, 0, 1); PG8_SCHED; PG8_LDA(At, 0, 0); PG8_STAGE(PG8_SA(1, 1), a1 + hstep, voffA);
            PG8_WAIT_V(8); PG8_WAIT_L(0); PG8_BAR; PG8_MMA(0, 0, At, B0); PG8_MMA(0, 1, At, B1); PG8_BAR; PG8_SCHED;
            PG8_LDA(At, 0, 1); PG8_STAGE(PG8_SB(0, 0), b2, voffB); PG8_STAGE(PG8_SB(0, 1), b2 + hstep, voffB); PG8_STAGE(PG8_SA(0, 0), a2, voffA);
            PG8_WAIT_V(8); PG8_WAIT_L(0); PG8_BAR; PG8_MMA(1, 0, At, B0); PG8_MMA(1, 1, At, B1); PG8_BAR; PG8_SCHED;
            PG8_LDB(B0, 1, 0); PG8_LDB(B1, 1, 1); PG8_SCHED; PG8_LDA(At, 1, 0); PG8_STAGE(PG8_SA(0, 1), a2 + hstep, voffA);
            PG8_WAIT_V(8); PG8_WAIT_L(0); PG8_BAR; PG8_MMA(0, 0, At, B0); PG8_MMA(0, 1, At, B1); PG8_BAR; PG8_SCHED;
            PG8_LDA(At, 1, 1); PG8_STAGE(PG8_SB(1, 0), b3, voffB); PG8_STAGE(PG8_SB(1, 1), b3 + hstep, voffB); PG8_STAGE(PG8_SA(1, 0), a3, voffA);
            PG8_WAIT_V(8); PG8_WAIT_L(0); PG8_BAR; PG8_MMA(1, 0, At, B0); PG8_MMA(1, 1, At, B1); PG8_BAR; PG8_SCHED;
        }
        if (wr == 0) PG8_BAR;
        E(acc, cur, wr, wc, fr, fq);
        if (!has_next) break;
#pragma unroll
        for (int a = 0; a < 2; ++a)
#pragma unroll
            for (int b = 0; b < 2; ++b)
#pragma unroll
                for (int m = 0; m < 4; ++m)
#pragma unroll
                    for (int n = 0; n < 2; ++n) acc[a][b][m][n] = (f32x4){0.f, 0.f, 0.f, 0.f};
        cur = nxt; cA = nA; cB = nB; ++ui;
        if (wr == 1) PG8_BAR;
    }
    PG8_WAIT_V(0);
    PG8_BAR;
#undef PG8_SA
#undef PG8_SB
#undef PG8_STAGE
#undef PG8_LDA
#undef PG8_LDB
#undef PG8_MMA
#undef PG8_WAIT_V
#undef PG8_WAIT_L
#undef PG8_BAR
#undef PG8_SCHED
}
}
using pg8::Unit;
typedef f32x4 Acc[2][2][4][2];

struct EpiSG {
    bf16_t* P0; float* stats;
    __device__ __forceinline__ void operator()(const Acc& acc, const Unit& u, int wr, int wc, int fr, int fq) const {
        const int row0 = u.pm * 256 + wr * 64 + fr;
        if (u.pn < 16) {
            const int col0 = u.pn * 128 + wc * 32 + 8 * fq;
#pragma unroll
            for (int ai = 0; ai < 2; ++ai)
#pragma unroll
                for (int m = 0; m < 4; ++m) {
                    const int row = row0 + ai * 128 + m * 16;
                    f32x4 a = acc[ai][0][m][0], b = acc[ai][0][m][1]; const f32x4 za = acc[ai][1][m][0], zb = acc[ai][1][m][1];
#pragma unroll
                    for (int e = 0; e < 4; ++e) { a[e] = geluf_(a[e]) * siluf_(za[e]); b[e] = geluf_(b[e]) * siluf_(zb[e]); }
                    u32x4 w; w.x = cvt_pk_bf16(a[0], a[1]); w.y = cvt_pk_bf16(a[2], a[3]); w.z = cvt_pk_bf16(b[0], b[1]); w.w = cvt_pk_bf16(b[2], b[3]);
                    *(u32x4*)(P0 + (size_t)row * DM + col0) = w;
                }
        } else {
            const int vt = u.pn - 16, col0 = vt * 256 + wc * 32 + 8 * fq;
            bf16_t* base = P0 + (size_t)M * DM;
#pragma unroll
            for (int ai = 0; ai < 2; ++ai)
#pragma unroll
                for (int m = 0; m < 4; ++m) {
                    const int row = row0 + ai * 128 + m * 16; float s = 0.f, q = 0.f;
#pragma unroll
                    for (int bj = 0; bj < 2; ++bj) {
                        f32x4 a = acc[ai][bj][m][0], b = acc[ai][bj][m][1];
#pragma unroll
                        for (int e = 0; e < 4; ++e) { a[e] = geluf_(a[e]); b[e] = geluf_(b[e]); }
                        s += (a[0] + a[1]) + (a[2] + a[3]) + (b[0] + b[1]) + (b[2] + b[3]);
                        q += (a[0] * a[0] + a[1] * a[1]) + (a[2] * a[2] + a[3] * a[3]) + (b[0] * b[0] + b[1] * b[1]) + (b[2] * b[2] + b[3] * b[3]);
                        u32x4 w; w.x = cvt_pk_bf16(a[0], a[1]); w.y = cvt_pk_bf16(a[2], a[3]); w.z = cvt_pk_bf16(b[0], b[1]); w.w = cvt_pk_bf16(b[2], b[3]);
                        *(u32x4*)(base + (size_t)row * DM + col0 + bj * 128) = w;
                    }
                    s += __shfl_xor(s, 16); s += __shfl_xor(s, 32); q += __shfl_xor(q, 16); q += __shfl_xor(q, 32);
                    if (fq == 0) *(f32x2*)(stats + ((size_t)row * 32 + vt * 4 + wc) * 2) = (f32x2){s, q};
                }
        }
    }
};
struct EpiSWA {
    bf16_t *Q, *Kb, *Vb, *Z; const f32x2* rope;
    __device__ __forceinline__ void operator()(const Acc& acc, const Unit& u, int wr, int wc, int fr, int fq) const {
        const int pn = u.pn; bf16_t* base; int ld, colt; bool rp = false, act = false;
        if (pn < 8) { base = Q; ld = DM; colt = pn * 256; rp = true; }
        else if (pn == 8) { base = Kb; ld = 256; colt = 0; rp = true; }
        else if (pn == 9) { base = Vb; ld = 256; colt = 0; }
        else { base = Z; ld = DM; colt = (pn - 10) * 256; act = true; }
        const int row0 = u.pm * 256 + wr * 64 + fr, col0 = colt + wc * 32 + 8 * fq;
        const int f0 = 16 * (wc & 1) + 4 * fq;
#pragma unroll
        for (int ai = 0; ai < 2; ++ai)
#pragma unroll
            for (int m = 0; m < 4; ++m) {
                const int row = row0 + ai * 128 + m * 16;
                f32x4 cs0 = {1.f, 0.f, 1.f, 0.f}, cs1 = cs0;
                if (rp) { const f32x4* rr = (const f32x4*)(rope + (size_t)row * 32 + f0); cs0 = rr[0]; cs1 = rr[1]; }
#pragma unroll
                for (int bj = 0; bj < 2; ++bj) {
                    f32x4 a = acc[ai][bj][m][0], b = acc[ai][bj][m][1];
                    if (rp) {
                        const float c0 = cs0[0], s0 = cs0[1], c1 = cs0[2], s1 = cs0[3], c2 = cs1[0], s2 = cs1[1], c3 = cs1[2], s3 = cs1[3];
                        f32x4 o1, o2;
                        o1[0] = a[0] * c0 - b[0] * s0; o2[0] = b[0] * c0 + a[0] * s0;
                        o1[1] = a[1] * c1 - b[1] * s1; o2[1] = b[1] * c1 + a[1] * s1;
                        o1[2] = a[2] * c2 - b[2] * s2; o2[2] = b[2] * c2 + a[2] * s2;
                        o1[3] = a[3] * c3 - b[3] * s3; o2[3] = b[3] * c3 + a[3] * s3;
                        a = o1; b = o2;
                    }
                    if (act) {
#pragma unroll
                        for (int e = 0; e < 4; ++e) { a[e] = siluf_(a[e]); b[e] = siluf_(b[e]); }
                    }
                    u32x4 w; w.x = cvt_pk_bf16(a[0], a[1]); w.y = cvt_pk_bf16(a[2], a[3]); w.z = cvt_pk_bf16(b[0], b[1]); w.w = cvt_pk_bf16(b[2], b[3]);
                    *(u32x4*)(base + (size_t)row * ld + col0 + bj * 128) = w;
                }
            }
    }
};
struct EpiPlain {
    bf16_t* O; int ld;
    __device__ __forceinline__ void operator()(const Acc& acc, const Unit& u, int wr, int wc, int fr, int fq) const {
        const int row0 = u.pm * 256 + wr * 64 + fr, col0 = u.pn * 256 + wc * 32 + 8 * fq;
#pragma unroll
        for (int ai = 0; ai < 2; ++ai)
#pragma unroll
            for (int m = 0; m < 4; ++m) {
                const int row = row0 + ai * 128 + m * 16;
#pragma unroll
                for (int bj = 0; bj < 2; ++bj) {
                    const f32x4 a = acc[ai][bj][m][0], b = acc[ai][bj][m][1];
                    u32x4 w; w.x = cvt_pk_bf16(a[0], a[1]); w.y = cvt_pk_bf16(a[2], a[3]); w.z = cvt_pk_bf16(b[0], b[1]); w.w = cvt_pk_bf16(b[2], b[3]);
                    *(u32x4*)(O + (size_t)row * ld + col0 + bj * 128) = w;
                }
            }
    }
};
struct EpiOut {
    const float* xin; float* xout; const float* macc; const float* mb;
    bf16_t* xb; float* ssq; const float* g; const float* macc_sc; const float* mb_sc;
    __device__ __forceinline__ void operator()(const Acc& acc, const Unit& u, int wr, int wc, int fr, int fq) const {
        const int row0 = u.pm * 256 + wr * 64 + fr, col0 = u.pn * 256 + wc * 32 + 8 * fq;
        const int b = u.pm >> 4;
        float ss[2][4];
#pragma unroll
        for (int ai = 0; ai < 2; ++ai)
#pragma unroll
            for (int m = 0; m < 4; ++m) ss[ai][m] = 0.f;
#pragma unroll
        for (int bj = 0; bj < 2; ++bj) {
            const int cj = col0 + bj * 128;
            const f32x4 gt0 = *(const f32x4*)(macc + (size_t)b * N_SG + cj) + *(const f32x4*)(mb + cj), gt1 = *(const f32x4*)(macc + (size_t)b * N_SG + cj + 4) + *(const f32x4*)(mb + cj + 4);
            f32x4 gs0 = {0.f, 0.f, 0.f, 0.f}, gs1 = gs0;
            if (xb) { gs0 = *(const f32x4*)(g + cj) * (*(const f32x4*)(macc_sc + (size_t)b * N_SG + cj) + *(const f32x4*)(mb_sc + cj) + 1.0f);
                      gs1 = *(const f32x4*)(g + cj + 4) * (*(const f32x4*)(macc_sc + (size_t)b * N_SG + cj + 4) + *(const f32x4*)(mb_sc + cj + 4) + 1.0f); }
#pragma unroll
            for (int ai = 0; ai < 2; ++ai)
#pragma unroll
                for (int m = 0; m < 4; ++m) {
                    const size_t off = (size_t)(row0 + ai * 128 + m * 16) * DM + cj;
                    const f32x4 x0 = *(const f32x4*)(xin + off) + gt0 * acc[ai][bj][m][0];
                    const f32x4 x1 = *(const f32x4*)(xin + off + 4) + gt1 * acc[ai][bj][m][1];
                    *(f32x4*)(xout + off) = x0; *(f32x4*)(xout + off + 4) = x1;
                    if (xb) {
                        ss[ai][m] += (x0[0] * x0[0] + x0[1] * x0[1]) + (x0[2] * x0[2] + x0[3] * x0[3]) + (x1[0] * x1[0] + x1[1] * x1[1]) + (x1[2] * x1[2] + x1[3] * x1[3]);
                        const f32x4 h0 = x0 * gs0, h1 = x1 * gs1;
                        u32x4 w; w.x = cvt_pk_bf16(h0[0], h0[1]); w.y = cvt_pk_bf16(h0[2], h0[3]); w.z = cvt_pk_bf16(h1[0], h1[1]); w.w = cvt_pk_bf16(h1[2], h1[3]);
                        *(u32x4*)(xb + off) = w;
                    }
                    if (m & 1) asm volatile("" ::: "memory");
                }
        }
        if (xb) {
#pragma unroll
            for (int ai = 0; ai < 2; ++ai)
#pragma unroll
                for (int m = 0; m < 4; ++m) { float s = ss[ai][m]; s += __shfl_xor(s, 16); s += __shfl_xor(s, 32); if (fq == 0) atomicAdd(ssq + row0 + ai * 128 + m * 16, s); }
        }
    }
};
template <class Inner> struct EpiAdj {
    Inner in; const float* ssq; const float* bias;
    __device__ __forceinline__ void operator()(Acc& acc, const Unit& u, int wr, int wc, int fr, int fq) const {
        const int b = u.pm >> 4, colb = u.pn * 256 + wc * 32 + 8 * fq;
        f32x4 bs[2][2];
#pragma unroll
        for (int bj = 0; bj < 2; ++bj)
#pragma unroll
            for (int n = 0; n < 2; ++n) bs[bj][n] = *(const f32x4*)(bias + (size_t)b * N_RWP + colb + bj * 128 + 4 * n);
#pragma unroll
        for (int ai = 0; ai < 2; ++ai)
#pragma unroll
            for (int m = 0; m < 4; ++m) {
                const float rstd = rsqrtf(ssq[u.pm * 256 + ai * 128 + wr * 64 + m * 16 + fr] * (1.0f / DM) + 1e-6f);
#pragma unroll
                for (int bj = 0; bj < 2; ++bj)
#pragma unroll
                    for (int n = 0; n < 2; ++n) acc[ai][bj][m][n] = acc[ai][bj][m][n] * rstd + bs[bj][n];
            }
        in(acc, u, wr, wc, fr, fq);
    }
};

struct Params { const float* in[28]; float* out; unsigned char* ws; int ph_lo, ph_hi, use_cg, pad; };

struct Frame {
    LAS unsigned char* lds; int tid, lane, wave, gw, NGW;
    const Params* p;
};

#define XB_TMO      128
#define XB_XCNT(j)  (256  + 64 * (j))
#define XB_XSUB(j)  (1280 + 64 * (j))
#define XB_XGEN(j)  (2304 + 64 * (j))
#define XB_TOP      3328
#define XB_TOPGEN   3392
#define XB_SPIN_CAP (1u << 22)
__device__ __forceinline__ unsigned xb_ld(unsigned* p)              { return __hip_atomic_load(p, __ATOMIC_RELAXED, __HIP_MEMORY_SCOPE_AGENT); }
__device__ __forceinline__ unsigned xb_add(unsigned* p, unsigned v) { return __hip_atomic_fetch_add(p, v, __ATOMIC_RELAXED, __HIP_MEMORY_SCOPE_AGENT); }
__device__ __forceinline__ unsigned xb_xcc_id() { return (unsigned)__builtin_amdgcn_s_getreg((3 << 11) | 20) & 0xFu; }
#define XB_SPIN(cond, bar) do { unsigned _sp = 0; while (cond) { __builtin_amdgcn_s_sleep(1); \
    if ((++_sp & 255u) == 0u) { if (xb_ld(&(bar)[XB_TMO])) break; if (_sp > XB_SPIN_CAP) { atomicAdd(&(bar)[XB_TMO], 1u); break; } } } } while (0)
struct XcdBarrier { unsigned* bar; unsigned x; volatile LAS unsigned* st; };
__device__ __forceinline__ XcdBarrier xcd_barrier_post(unsigned* bar, volatile LAS unsigned* st) {
    XcdBarrier b; b.bar = bar; b.x = xb_xcc_id(); b.st = st;
    if (threadIdx.x == 0) (void)xb_add(&bar[XB_XCNT(b.x)], 1u);
    return b;
}
__device__ __forceinline__ void xcd_barrier_complete(unsigned* bar, unsigned x, unsigned& nloc, unsigned& nx) {
    const unsigned G = gridDim.x * gridDim.y * gridDim.z;
    unsigned sum, cnt, mine, sp = 0u;
    for (;;) {
        sum = 0u; cnt = 0u; mine = 0u;
#pragma unroll
        for (unsigned j = 0; j < 16; ++j) { const unsigned c = xb_ld(&bar[XB_XCNT(j)]); sum += c; cnt += (c > 0u) ? 1u : 0u; mine = (j == x) ? c : mine; }
        if (sum == G) break;
        __builtin_amdgcn_s_sleep(1);
        if ((++sp & 255u) == 0u) { if (xb_ld(&bar[XB_TMO])) break; if (sp > XB_SPIN_CAP) { atomicAdd(&bar[XB_TMO], 1u); break; } }
    }
    nloc = mine > 0u ? mine : 1u; nx = cnt > 0u ? cnt : 1u;
}
__device__ __forceinline__ void xcd_barrier(const XcdBarrier& b) {
    asm volatile("s_waitcnt vmcnt(0)" ::: "memory");
    __syncthreads();
    if (threadIdx.x == 0) {
        unsigned* bar = b.bar;
        __builtin_amdgcn_s_waitcnt(0);
        unsigned nloc = b.st[0], nx = b.st[1];
        if (nloc == 0u) { xcd_barrier_complete(bar, b.x, nloc, nx); b.st[0] = nloc; b.st[1] = nx; }
        const unsigned old = xb_add(&bar[XB_XSUB(b.x)], 1u);
        const unsigned gen = old / nloc;
        if (old + 1u == (gen + 1u) * nloc) {
            __builtin_amdgcn_fence(__ATOMIC_RELEASE, "agent");
            asm volatile("s_waitcnt vmcnt(0)" ::: "memory");
            const unsigned og = xb_add(&bar[XB_TOP], 1u);
            const unsigned tg = og / nx;
            if (og + 1u == (tg + 1u) * nx) xb_add(&bar[XB_TOPGEN], 1u);
            else XB_SPIN(xb_ld(&bar[XB_TOPGEN]) == tg, bar);
            __builtin_amdgcn_fence(__ATOMIC_ACQUIRE, "agent");
            xb_add(&bar[XB_XGEN(b.x)], 1u);
            asm volatile("s_waitcnt vmcnt(0)" ::: "memory");
        } else {
            XB_SPIN(xb_ld(&bar[XB_XGEN(b.x)]) == gen, bar);
            __builtin_amdgcn_fence(__ATOMIC_ACQUIRE, "agent");
            asm volatile("s_waitcnt vmcnt(0)" ::: "memory");
        }
    }
    __syncthreads();
}

__device__ const float ROPE_INVF[32] = {1.f, 0.749894202f, 0.562341332f, 0.421696514f, 0.316227764f, 0.237137377f, 0.177827939f, 0.133352146f, 0.100000001f, 0.0749894232f, 0.0562341325f, 0.0421696492f, 0.0316227749f, 0.0237137377f, 0.0177827943f, 0.013335214f, 0.00999999978f, 0.00749894232f, 0.00562341325f, 0.00421696482f, 0.00316227763f, 0.00237137382f, 0.00177827943f, 0.00133352145f, 0.00100000005f, 0.000749894185f, 0.000562341302f, 0.000421696517f, 0.000316227757f, 0.00023713737f, 0.00017782794f, 0.00013335215f};

__device__ __forceinline__ int sg_maprow(int n) {
    if (n < DM) return (n >> 7) * 256 + (n & 127);
    if (n >= 2 * DM) { const int c = n - 2 * DM; return (c >> 7) * 256 + 128 + (c & 127); }
    return 2 * DM + (n - DM);
}
__device__ __forceinline__ int swa_maprow(int n) {
    if (n >= 2304) return n;
    const int d = n & 63, half = d >> 5, dd = d & 31, j = dd >> 2, i = dd & 3;
    return (n & ~63) + 8 * j + 4 * half + i;
}
__device__ __forceinline__ void p0_transpose_item(const float* W, int N, bf16_t* WT, int mode, LAS float* scr, int item, int lane) {
    const int nblk = N / 32, kb = item / nblk, nb = item % nblk, k0 = 64 * kb, n0 = 32 * nb;
#pragma unroll 8
    for (int i = 0; i < 32; ++i) { const int kk = 2 * i + (lane >> 5); scr[kk * 33 + (lane & 31)] = W[(size_t)(k0 + kk) * N + n0 + (lane & 31)]; }
    asm volatile("s_waitcnt lgkmcnt(0)" ::: "memory");
    const int c = lane & 7;
#pragma unroll
    for (int j = 0; j < 4; ++j) { const int n = (lane >> 3) + 8 * j; const LAS float* s = scr + (8 * c) * 33 + n;
        u32x4 o; o.x = pk2(s[0 * 33], s[1 * 33]); o.y = pk2(s[2 * 33], s[3 * 33]); o.z = pk2(s[4 * 33], s[5 * 33]); o.w = pk2(s[6 * 33], s[7 * 33]);
        const int dn = mode == 1 ? swa_maprow(n0 + n) : (mode == 2 ? sg_maprow(n0 + n) : (n0 + n));
        *(u32x4*)(WT + (size_t)dn * DM + k0 + 8 * c) = o; }
    asm volatile("s_waitcnt lgkmcnt(0)" ::: "memory");
}
__device__ __forceinline__ void phase_p0(Frame& F) {
    const Params& P = *F.p; unsigned char* ws = P.ws;
    LAS float* scr = (LAS float*)(F.lds + F.wave * 16384);
    const int lane = F.lane;
    constexpr int I_SGIN = 32 * (N_SG / 32), I_OUT = 32 * (DM / 32), I_SWAIN = 32 * (N_SWA / 32), I_RWIN = 32 * (N_RW / 32);
    constexpr int NITEMS = 2 * I_SGIN + 2 * I_OUT + I_SWAIN + I_OUT + I_RWIN + I_OUT;
#ifndef P0REP
#define P0REP 1
#endif
    _Pragma("unroll 1") for (int rep_ = 0; rep_ < P0REP; ++rep_)
    for (int it = F.gw; it < NITEMS; it += F.NGW) {
        int r = it;
        if (r < I_SGIN) { p0_transpose_item(P.in[7], N_SG, (bf16_t*)(ws + W_SGIN0), 2, scr, r, lane); continue; } r -= I_SGIN;
        if (r < I_SGIN) { p0_transpose_item(P.in[7] + (size_t)DM * N_SG, N_SG, (bf16_t*)(ws + W_SGIN1), 2, scr, r, lane); continue; } r -= I_SGIN;
        if (r < I_OUT) { p0_transpose_item(P.in[8], DM, (bf16_t*)(ws + W_SGOUT0), 0, scr, r, lane); continue; } r -= I_OUT;
        if (r < I_OUT) { p0_transpose_item(P.in[8] + (size_t)DM * DM, DM, (bf16_t*)(ws + W_SGOUT1), 0, scr, r, lane); continue; } r -= I_OUT;
        if (r < I_SWAIN) { p0_transpose_item(P.in[13], N_SWA, (bf16_t*)(ws + W_SWAIN), 1, scr, r, lane); continue; } r -= I_SWAIN;
        if (r < I_OUT) { p0_transpose_item(P.in[14], DM, (bf16_t*)(ws + W_SWAOUT), 0, scr, r, lane); continue; } r -= I_OUT;
        if (r < I_RWIN) { p0_transpose_item(P.in[16], N_RW, (bf16_t*)(ws + W_RWIN), 0, scr, r, lane); continue; } r -= I_RWIN;
        p0_transpose_item(P.in[17], DM, (bf16_t*)(ws + W_RWOUT), 0, scr, r, lane);
    }
    { u32x4* z = (u32x4*)(ws + W_RWIN + (size_t)N_RW * DM * 2); const int n16 = (N_RWP - N_RW) * DM * 2 / 16;
      for (int i = blockIdx.x * NTHREADS + F.tid; i < n16; i += gridDim.x * NTHREADS) z[i] = (u32x4){0u, 0u, 0u, 0u}; }
    { float* macc = (float*)(ws + WS_CTL); const float* cin = P.in[1]; const float* mw = P.in[4];
      for (int task = F.gw; task < 4 * 24 * 64; task += F.NGW) {
          const int i = task / 1536, rem = task % 1536, cgp = rem / 64, ks = rem % 64, n0 = cgp * 256 + lane * 4, k0 = ks * 32;
          const float c0v = siluf_(cin[k0 + (lane & 31)]), c1v = siluf_(cin[DM + k0 + (lane & 31)]);
          f32x4 a0 = {0.f, 0.f, 0.f, 0.f}, a1 = a0;
          const float* wp = mw + ((size_t)i * DM + k0) * N_SG + n0;
#pragma unroll 8
          for (int kk = 0; kk < 32; ++kk) {
              const f32x4 w = *(const f32x4*)(wp + (size_t)kk * N_SG);
              const float s0 = __builtin_bit_cast(float, __builtin_amdgcn_readlane(__builtin_bit_cast(int, c0v), kk));
              const float s1 = __builtin_bit_cast(float, __builtin_amdgcn_readlane(__builtin_bit_cast(int, c1v), kk));
              a0 += w * s0; a1 += w * s1;
          }
          float* d0 = macc + ((size_t)i * 2 + 0) * N_SG + n0; float* d1 = macc + ((size_t)i * 2 + 1) * N_SG + n0;
#pragma unroll
          for (int e = 0; e < 4; ++e) { atomicAdd(d0 + e, a0[e]); atomicAdd(d1 + e, a1[e]); }
      } }
    { bf16_t* LWH = (bf16_t*)(ws + WS_LORA); bf16_t* LWL = LWH + 2048 * 96; bf16_t* LA = LWL + 2048 * 96; const float* wl = P.in[20]; const float* al = P.in[22];
      for (int idx = blockIdx.x * NTHREADS + F.tid; idx < 96 * DM; idx += gridDim.x * NTHREADS) {
          const int k = idx >> 11, c = idx & (DM - 1); const float w = wl[idx]; const unsigned hi = f2bf(w);
          LWH[c * 96 + k] = (bf16_t)hi; LWL[c * 96 + k] = (bf16_t)f2bf(w - __builtin_bit_cast(float, hi << 16)); LA[c * 96 + k] = (bf16_t)f2bf(al[idx]);
      } }
    { f32x2* tab = (f32x2*)(ws + WS_ROPE); const int* pos = (const int*)P.in[2];
      for (int idx = blockIdx.x * NTHREADS + F.tid; idx < M * 32; idx += gridDim.x * NTHREADS) {
          const int m = idx >> 5, f = idx & 31;
          const float ang = (float)pos[m] * ROPE_INVF[f];
          double rev = (double)ang * 0.15915494309189535; rev -= __builtin_rint(rev);
          const float rf = (float)rev;
          tab[idx] = (f32x2){__builtin_amdgcn_cosf(rf), __builtin_amdgcn_sinf(rf)};
      } }
}

__device__ __forceinline__ void phase_norm(Frame& F, const float* xin, int layer, bf16_t* XN) {
    const Params& P = *F.p; const float* macc = (const float*)(P.ws + WS_CTL); const float* mb = P.in[5] + (size_t)layer * N_SG; const float* g = P.in[3] + (size_t)layer * DM;
    for (int row = F.gw; row < M; row += F.NGW) {
        const int b = row >> 12; const float* ma = macc + ((size_t)layer * 2 + b) * N_SG;
        const f32x4* xr = (const f32x4*)(xin + (size_t)row * DM) + F.lane;
        f32x4 v[8]; float ss = 0.f;
#pragma unroll
        for (int j = 0; j < 8; ++j) { v[j] = xr[64 * j]; ss += (v[j].x * v[j].x + v[j].y * v[j].y) + (v[j].z * v[j].z + v[j].w * v[j].w); }
        const float rstd = rsqrtf(wave_sum(ss) * (1.0f / DM) + 1e-6f);
#pragma unroll
        for (int j = 0; j < 8; ++j) {
            const int c = 256 * j + 4 * F.lane;
            const f32x4 g4 = *(const f32x4*)(g + c);
            const f32x4 sh = *(const f32x4*)(ma + c) + *(const f32x4*)(mb + c);
            const f32x4 sc = *(const f32x4*)(ma + DM + c) + *(const f32x4*)(mb + DM + c);
            const f32x4 h = v[j] * rstd * g4 * (sc + 1.0f) + sh;
            u32x2 w; w.x = pk2(h.x, h.y); w.y = pk2(h.z, h.w);
            *(u32x2*)(XN + (size_t)row * DM + c) = w;
        }
    }
}
__device__ __forceinline__ void phase_bias(Frame& F) {
    const Params& P = *F.p; const float* macc = (const float*)(P.ws + WS_CTL); float* bias = (float*)(P.ws + WS_BIAS);
#pragma unroll 1
    for (int l = 1; l < 4; ++l) {
        const bf16_t* Wt = (const bf16_t*)(P.ws + (l == 1 ? W_SWAIN : (l == 2 ? W_RWIN : W_SGIN1))); const int N = l == 1 ? N_SWA : (l == 2 ? N_RWP : N_SG);
        f32x4 sh[2][4][2];
#pragma unroll
        for (int b = 0; b < 2; ++b)
#pragma unroll
            for (int j = 0; j < 4; ++j)
#pragma unroll
                for (int h = 0; h < 2; ++h) { const int k = 8 * F.lane + 512 * j + 4 * h; sh[b][j][h] = *(const f32x4*)(macc + ((size_t)l * 2 + b) * N_SG + k) + *(const f32x4*)(P.in[5] + (size_t)l * N_SG + k); }
        for (int n = F.gw; n < N; n += F.NGW) {
            float s0 = 0.f, s1 = 0.f;
#pragma unroll
            for (int j = 0; j < 4; ++j) {
                float w[8]; unpack8(*(const u32x4*)(Wt + (size_t)n * DM + 8 * F.lane + 512 * j), w);
#pragma unroll
                for (int e = 0; e < 8; ++e) { s0 += w[e] * sh[0][j][e >> 2][e & 3]; s1 += w[e] * sh[1][j][e >> 2][e & 3]; }
            }
            s0 = wave_sum(s0); s1 = wave_sum(s1);
            if (F.lane == 0) { bias[((size_t)(l - 1) * 2 + 0) * N_RWP + n] = s0; bias[((size_t)(l - 1) * 2 + 1) * N_RWP + n] = s1; }
        }
    }
}
__device__ __forceinline__ void phase_final(Frame& F, const float* xin) {
    const Params& P = *F.p; const float* g = P.in[6];
    for (int row = F.gw; row < M; row += F.NGW) {
        const f32x4* xr = (const f32x4*)(xin + (size_t)row * DM) + F.lane;
        f32x4 v[8]; float ss = 0.f;
#pragma unroll
        for (int j = 0; j < 8; ++j) { v[j] = xr[64 * j]; ss += (v[j].x * v[j].x + v[j].y * v[j].y) + (v[j].z * v[j].z + v[j].w * v[j].w); }
        const float rstd = rsqrtf(wave_sum(ss) * (1.0f / DM) + 1e-6f);
        f32x4* o = (f32x4*)(P.out + (size_t)row * DM) + F.lane;
#pragma unroll
        for (int j = 0; j < 8; ++j) { const f32x4 g4 = *(const f32x4*)(g + 256 * j + 4 * F.lane); o[64 * j] = v[j] * rstd * g4; }
    }
}

__device__ __forceinline__ void phase_sgmix(Frame& F, int j, const bf16_t* UZ, const bf16_t* GV, const float* stats, bf16_t* A2) {
    const Params& P = *F.p;
    const float* ln_g = P.in[9] + (size_t)j * DM; const float* ln_b = P.in[10] + (size_t)j * DM;
    const float* wsp = P.in[11] + (size_t)j * 16 * 128 * 128; const float* bsp = P.in[12] + (size_t)j * 16 * 128;
    LAS bf16_t* VT = (LAS bf16_t*)F.lds;
    LAS f32x2* rowstat = (LAS f32x2*)(F.lds + 128 * 136 * 2);
    const int tid = F.tid, lane = F.lane, w = F.wave, gq = lane >> 4, rho = lane & 15;
    for (int item = blockIdx.x; item < 1024; item += gridDim.x) {
        const int g = item & 15, chunk = item >> 4, t0 = chunk * 128, c0 = g * 128;
        const int t = 16 * w + rho, nks = (w >> 1) + 1;
        u32x4 raw[4];
#pragma unroll
        for (int jj = 0; jj < 4; ++jj) { const int q_ = tid + 512 * jj; raw[jj] = *(const u32x4*)(GV + (size_t)(t0 + (q_ >> 4)) * DM + c0 + (q_ & 15) * 8); }
        f32x4 wa[4], wb[4];
#pragma unroll
        for (int ks = 0; ks < 4; ++ks) {
            wa[ks] = (f32x4){0.f, 0.f, 0.f, 0.f}; wb[ks] = wa[ks];
            if (ks < nks) { const float* wp = wsp + ((size_t)(g * 128 + t)) * 128 + 32 * ks + 8 * gq; wa[ks] = *(const f32x4*)wp; wb[ks] = *(const f32x4*)(wp + 4); }
        }
        const float bias = bsp[g * 128 + t]; const size_t rowoff = (size_t)(t0 + t) * DM + c0;
        u32x4 ur[4];
#pragma unroll
        for (int ntp = 0; ntp < 4; ++ntp) ur[ntp] = *(const u32x4*)(UZ + rowoff + 32 * ntp + 8 * gq);
        float s_ = 0.f, q2_ = 0.f;
        if (tid < 128) {
            const f32x2* sp = (const f32x2*)(stats + (size_t)(t0 + tid) * 64);
#pragma unroll 8
            for (int p = 0; p < 32; ++p) { const f32x2 v = sp[p]; s_ += v.x; q2_ += v.y; }
        }
        __syncthreads();
        if (tid < 128) {
            const float mean = s_ * (1.0f / DM), var = q2_ * (1.0f / DM) - mean * mean;
            rowstat[tid] = (f32x2){mean, rsqrtf(var + 1e-5f)};
        }
        __syncthreads();
#pragma unroll
        for (int jj = 0; jj < 4; ++jj) {
            const int q_ = tid + 512 * jj, s = q_ >> 4, cc = (q_ & 15) * 8;
            const f32x2 st = rowstat[s];
            float v[8]; unpack8(raw[jj], v);
            const f32x4 g0 = *(const f32x4*)(ln_g + c0 + cc), g1 = *(const f32x4*)(ln_g + c0 + cc + 4);
            const f32x4 b0 = *(const f32x4*)(ln_b + c0 + cc), b1 = *(const f32x4*)(ln_b + c0 + cc + 4);
#pragma unroll
            for (int e = 0; e < 8; ++e) {
                const float gg = e < 4 ? g0[e & 3] : g1[e & 3], bb = e < 4 ? b0[e & 3] : b1[e & 3];
                VT[(cc + e) * 136 + (s ^ (cc & 120))] = (bf16_t)f2bf((v[e] - st.x) * st.y * gg + bb);
            }
        }
        __syncthreads();
        bf16x8 yf[4];
#pragma unroll
        for (int ks = 0; ks < 4; ++ks) {
            const int s0 = 32 * ks + 8 * gq; float v[8];
#pragma unroll
            for (int e = 0; e < 4; ++e) { v[e] = (s0 + e <= t) ? wa[ks][e] : 0.f; v[4 + e] = (s0 + 4 + e <= t) ? wb[ks][e] : 0.f; }
            const u32x4 pk = pack8(v); yf[ks] = __builtin_bit_cast(bf16x8, pk);
        }
        f32x4 acc[4][2];
#pragma unroll
        for (int ntp = 0; ntp < 4; ++ntp)
#pragma unroll
            for (int n = 0; n < 2; ++n) {
                acc[ntp][n] = (f32x4){0.f, 0.f, 0.f, 0.f};
                const int c = 32 * ntp + 8 * (rho >> 2) + 4 * n + (rho & 3);
#pragma unroll
                for (int ks = 0; ks < 4; ++ks)
                    if (ks < nks) {
                        const bf16x8 xf = *(const LAS bf16x8*)(VT + c * 136 + ((32 * ks + 8 * gq) ^ (c & 120)));
                        acc[ntp][n] = __builtin_amdgcn_mfma_f32_16x16x32_bf16(xf, yf[ks], acc[ntp][n], 0, 0, 0);
                    }
            }
#pragma unroll
        for (int ntp = 0; ntp < 4; ++ntp) {
            const int c = 32 * ntp + 8 * gq;
            float uf[8], o[8]; unpack8(ur[ntp], uf);
#pragma unroll
            for (int e = 0; e < 8; ++e) { const float f = (e < 4 ? acc[ntp][0][e & 3] : acc[ntp][1][e & 3]) + bias; o[e] = uf[e] * f; }
            *(u32x4*)(A2 + rowoff + c) = pack8(o);
        }
    }
}

__device__ __forceinline__ void phase_attn(Frame& F, const bf16_t* Qb, const bf16_t* Kb, const bf16_t* Vb, const bf16_t* Zb, bf16_t* A2) {
    const Params& P = *F.p; const float* sinks = P.in[15];
    LAS bf16_t* KS = (LAS bf16_t*)F.lds;
    LAS bf16_t* VT = (LAS bf16_t*)(F.lds + 36864);
    LAS bf16_t* PS = (LAS bf16_t*)(F.lds + 72704 + F.wave * 5376);
    const int tid = F.tid, lane = F.lane, w = F.wave, gq = lane >> 4, rho = lane & 15;
    for (int item = blockIdx.x; item < 256; item += gridDim.x) {
        const int g = item & 3, nb = (item >> 2) & 31, b = item >> 7;
        const int tq0 = b * SEQ + nb * 128;
        __syncthreads();
#pragma unroll
        for (int jj = 0; jj < 4; ++jj) {
            const int q_ = tid + 512 * jj, key = q_ >> 3, ch = q_ & 7; const bool valid = (nb > 0) || (key >= 128);
            const size_t go = (size_t)(tq0 - 128 + key) * 256 + g * 64 + ch * 8;
            u32x4 kv = {0u, 0u, 0u, 0u}, vv = kv;
            if (valid) { kv = *(const u32x4*)(Kb + go); vv = *(const u32x4*)(Vb + go); }
            *(LAS u32x4*)(KS + key * 72 + ch * 8) = kv;
            const unsigned ww[4] = {vv.x, vv.y, vv.z, vv.w};
#pragma unroll
            for (int e = 0; e < 4; ++e) { VT[(ch * 8 + 2 * e) * 280 + key] = (bf16_t)(ww[e] & 0xffffu); VT[(ch * 8 + 2 * e + 1) * 280 + key] = (bf16_t)(ww[e] >> 16); }
        }
        if (tid < 192) { const int row = tid / 3, part = tid % 3; *(LAS u32x4*)(VT + row * 280 + 256 + part * 8) = (u32x4){0u, 0u, 0u, 0u}; }
        __syncthreads();
        const bf16_t* qbase = Qb + (size_t)(tq0 + 16 * w + rho) * DM + g * 512 + 8 * gq;
        const size_t zbase = (size_t)(tq0 + 16 * w + rho) * DM + g * 512 + 4 * gq;
        bf16x8 qn0 = *(const bf16x8*)qbase, qn1 = *(const bf16x8*)(qbase + 32);
        u32x2 zn[4];
#pragma unroll
        for (int dt = 0; dt < 4; ++dt) zn[dt] = *(const u32x2*)(Zb + zbase + 16 * dt);
        for (int r = 0; r < 8; ++r) {
            const int hq = g * 8 + r; const float sink = sinks[hq];
            const bf16x8 qf0 = qn0, qf1 = qn1;
            u32x2 zc[4];
#pragma unroll
            for (int dt = 0; dt < 4; ++dt) zc[dt] = zn[dt];
            if (r < 7) {
                qn0 = *(const bf16x8*)(qbase + 64 * (r + 1)); qn1 = *(const bf16x8*)(qbase + 64 * (r + 1) + 32);
#pragma unroll
                for (int dt = 0; dt < 4; ++dt) zn[dt] = *(const u32x2*)(Zb + zbase + 64 * (r + 1) + 16 * dt);
            }
            f32x4 sc[9];
#pragma unroll
            for (int jt = 0; jt < 9; ++jt) {
                const int kt = w + jt; const LAS bf16_t* kp = KS + (16 * kt + rho) * 72 + 8 * gq;
                const bf16x8 k0 = *(const LAS bf16x8*)kp, k1 = *(const LAS bf16x8*)(kp + 32);
                f32x4 a = {0.f, 0.f, 0.f, 0.f};
                a = __builtin_amdgcn_mfma_f32_16x16x32_bf16(qf0, k0, a, 0, 0, 0);
                a = __builtin_amdgcn_mfma_f32_16x16x32_bf16(qf1, k1, a, 0, 0, 0);
                const int kj = 16 * kt + rho;
#pragma unroll
                for (int i = 0; i < 4; ++i) {
                    const int rel = 4 * gq + i + 128 - 16 * jt - rho;
                    bool ok = (jt == 0) ? (rel < 128) : ((jt == 8) ? (rel >= 0) : true);
                    if (nb == 0) ok = ok && (kt >= 8);
                    sc[jt][i] = ok ? a[i] * 0.125f : -INFINITY;
                }
            }
#pragma unroll
            for (int i = 0; i < 4; ++i) {
                float mx = sc[0][i];
#pragma unroll
                for (int jt = 1; jt < 9; ++jt) mx = fmaxf(mx, sc[jt][i]);
                mx = fmaxf(mx, __shfl_xor(mx, 1)); mx = fmaxf(mx, __shfl_xor(mx, 2)); mx = fmaxf(mx, __shfl_xor(mx, 4)); mx = fmaxf(mx, __shfl_xor(mx, 8));
                const float mm = fmaxf(mx, sink); float sum = 0.f;
#pragma unroll
                for (int jt = 0; jt < 9; ++jt) { const float e = __expf(sc[jt][i] - mm); sc[jt][i] = e; sum += e; }
                sum += __shfl_xor(sum, 1); sum += __shfl_xor(sum, 2); sum += __shfl_xor(sum, 4); sum += __shfl_xor(sum, 8);
                const float inv = frcp(sum + __expf(sink - mm));
#pragma unroll
                for (int jt = 0; jt < 9; ++jt) PS[(4 * gq + i) * 168 + 16 * jt + rho] = (bf16_t)f2bf(sc[jt][i] * inv);
                PS[(4 * gq + i) * 168 + 144 + rho] = 0;
            }
            asm volatile("s_waitcnt lgkmcnt(0)" ::: "memory");
            f32x4 o[4];
#pragma unroll
            for (int dt = 0; dt < 4; ++dt) o[dt] = (f32x4){0.f, 0.f, 0.f, 0.f};
#pragma unroll
            for (int ks = 0; ks < 5; ++ks) {
                const bf16x8 pf = *(const LAS bf16x8*)(PS + rho * 168 + 32 * ks + 8 * gq);
#pragma unroll
                for (int dt = 0; dt < 4; ++dt) {
                    const bf16x8 vf = *(const LAS bf16x8*)(VT + (16 * dt + rho) * 280 + 16 * w + 32 * ks + 8 * gq);
                    o[dt] = __builtin_amdgcn_mfma_f32_16x16x32_bf16(vf, pf, o[dt], 0, 0, 0);
                }
            }
            asm volatile("s_waitcnt lgkmcnt(0)" ::: "memory");
#pragma unroll
            for (int dt = 0; dt < 4; ++dt) {
                const size_t off = (size_t)(tq0 + 16 * w + rho) * DM + hq * 64 + 16 * dt + 4 * gq;
                const u32x2 zr = zc[dt];
                u32x2 pk; pk.x = pk2(o[dt][0] * bflo(zr.x), o[dt][1] * bfhi(zr.x)); pk.y = pk2(o[dt][2] * bflo(zr.y), o[dt][3] * bfhi(zr.y));
                *(u32x2*)(A2 + off) = pk;
            }
        }
    }
}

struct RwBufs { bf16_t *R, *K, *V, *KK, *B, *ZS; float *W, *bonus, *Y, *Pc, *Qc, *Sst; };
__device__ __forceinline__ RwBufs rw_bufs(unsigned char* ws) {
    RwBufs r; unsigned char* b = ws + WS_RW;
    r.R = (bf16_t*)b; r.K = (bf16_t*)(b + 32 * MiB); r.V = (bf16_t*)(b + 64 * MiB); r.KK = (bf16_t*)(b + 96 * MiB); r.B = (bf16_t*)(b + 128 * MiB);
    r.W = (float*)(b + 160 * MiB); r.ZS = (bf16_t*)(b + 224 * MiB); r.bonus = (float*)(ws + WS_BONUS);
    r.Y = (float*)(ws + WS_P); r.Pc = (float*)(ws + WS_P + 64 * MiB); r.Qc = (float*)(ws + WS_P + 96 * MiB); r.Sst = (float*)(ws + WS_XN);
    return r;
}
__device__ __forceinline__ void lerp8(const u32x4 cu4, const u32x4 pr4, const LAS float* m, float (&o)[8]) {
    float cu[8], pr[8]; unpack8(cu4, cu); unpack8(pr4, pr);
    const f32x4 m0 = *(const LAS f32x4*)m, m1 = *(const LAS f32x4*)(m + 4);
#pragma unroll
    for (int e = 0; e < 8; ++e) o[e] = cu[e] + (pr[e] - cu[e]) * (e < 4 ? m0[e & 3] : m1[e & 3]);
}
__device__ __forceinline__ void phase_rwprep(Frame& F, const bf16_t* Pb) {
    const Params& P = *F.p; const RwBufs rb = rw_bufs(P.ws);
    const float* mu = P.in[18];
    LAS bf16_t* YWH = (LAS bf16_t*)F.lds; LAS bf16_t* YWL = YWH + 32 * 104; LAS bf16_t* YA = YWL + 32 * 104;
    LAS float* PRM = (LAS float*)(F.lds + 20480);
    const bf16_t* LWH = (const bf16_t*)(P.ws + WS_LORA); const bf16_t* LWL = LWH + 2048 * 96; const bf16_t* LA = LWL + 2048 * 96;
    const int tid = F.tid, lane = F.lane, gq = lane >> 4, rho = lane & 15;
    int cur_hg = -1;
    for (int item = blockIdx.x; item < 1024; item += gridDim.x) {
        const int tt = item >> 2, hg = item & 3, t0 = tt * 32, head = hg * 8 + F.wave;
        __syncthreads();
        if (hg != cur_hg) {
            cur_hg = hg;
#pragma unroll
            for (int v = 0; v < 9; ++v) {
                const float* srcp = v < 4 ? mu + v * DM : P.in[v == 4 ? 19 : (v == 5 ? 21 : (v == 6 ? 23 : (v == 7 ? 24 : 25)))];
                PRM[v * 512 + tid] = srcp[hg * 512 + tid];
            }
        }
#pragma unroll
        for (int jj = 0; jj < 2; ++jj) {
            const int q_ = tid + 512 * jj;
            if (q_ < 768) {
                const int tok = q_ / 24, ch = q_ % 24, row = t0 + tok, col = 4 * DM + ch * 8;
                const u32x4 c4 = *(const u32x4*)(Pb + (size_t)row * N_RWP + col);
                u32x4 p4 = {0u, 0u, 0u, 0u};
                if (row & (SEQ - 1)) p4 = *(const u32x4*)(Pb + (size_t)(row - 1) * N_RWP + col);
                const f32x4 m0 = *(const f32x4*)(mu + col), m1 = *(const f32x4*)(mu + col + 4);
                float cu[8], pr[8], hi[8], lo[8]; unpack8(c4, cu); unpack8(p4, pr);
#pragma unroll
                for (int x = 0; x < 8; ++x) cu[x] = cu[x] + (pr[x] - cu[x]) * (x < 4 ? m0[x & 3] : m1[x & 3]);
                if (ch < 12) {
#pragma unroll
                    for (int x = 0; x < 8; ++x) { const float th = tanhf_(cu[x]); const unsigned h = f2bf(th); hi[x] = __builtin_bit_cast(float, h << 16); lo[x] = th - hi[x]; }
                    *(LAS u32x4*)(YWH + tok * 104 + ch * 8) = pack8(hi); *(LAS u32x4*)(YWL + tok * 104 + ch * 8) = pack8(lo);
                } else *(LAS u32x4*)(YA + tok * 104 + (ch - 12) * 8) = pack8(cu);
            }
        }
        __syncthreads();
        const int cb = head * 64 + 8 * (rho >> 2) + (rho & 3);
        float carry[2][8];
#pragma unroll
        for (int ntp = 0; ntp < 2; ++ntp)
#pragma unroll
            for (int e = 0; e < 8; ++e) carry[ntp][e] = 0.f;
#pragma unroll 1
        for (int mt = 0; mt < 2; ++mt) {
            const int row = t0 + 16 * mt + rho, t = row & (SEQ - 1), bh = (row >> 12) * 32 + head; const bool first = (t == 0);
            const size_t obase = ((size_t)bh * SEQ + t) * 64;
            const bf16_t* prow = Pb + (size_t)row * N_RWP + head * 64 + 8 * gq; const bf16_t* pprev = first ? prow : prow - N_RWP;
            const u32x4 kc0 = *(const u32x4*)(prow + DM), kc1 = *(const u32x4*)(prow + DM + 32);
            u32x4 kp0 = *(const u32x4*)(pprev + DM), kp1 = *(const u32x4*)(pprev + DM + 32);
            if (first) { kp0 = (u32x4){0u, 0u, 0u, 0u}; kp1 = kp0; }
            const u32x4 rc0 = *(const u32x4*)(prow), vc0 = *(const u32x4*)(prow + 2 * DM), zc0 = *(const u32x4*)(prow + 3 * DM);
            u32x4 rp0 = *(const u32x4*)(pprev), vp0 = *(const u32x4*)(pprev + 2 * DM), zp0 = *(const u32x4*)(pprev + 3 * DM);
            if (first) { rp0 = (u32x4){0u, 0u, 0u, 0u}; vp0 = rp0; zp0 = rp0; }
            f32x4 aw[2][2], aa[2][2];
            const int yo = (16 * mt + rho) * 104 + 8 * gq;
#pragma unroll
            for (int ntp = 0; ntp < 2; ++ntp)
#pragma unroll
                for (int n = 0; n < 2; ++n) {
                    aw[ntp][n] = (f32x4){0.f, 0.f, 0.f, 0.f}; aa[ntp][n] = aw[ntp][n];
                    const size_t xo = (size_t)(cb + 32 * ntp + 4 * n) * 96 + 8 * gq;
#pragma unroll
                    for (int k3 = 0; k3 < 3; ++k3) {
                        const bf16x8 xh = *(const bf16x8*)(LWH + xo + 32 * k3), xl = *(const bf16x8*)(LWL + xo + 32 * k3), xa = *(const bf16x8*)(LA + xo + 32 * k3);
                        const bf16x8 ywh = *(const LAS bf16x8*)(YWH + yo + 32 * k3), ywl = *(const LAS bf16x8*)(YWL + yo + 32 * k3), ya = *(const LAS bf16x8*)(YA + yo + 32 * k3);
                        aw[ntp][n] = __builtin_amdgcn_mfma_f32_16x16x32_bf16(xh, ywh, aw[ntp][n], 0, 0, 0);
                        aw[ntp][n] = __builtin_amdgcn_mfma_f32_16x16x32_bf16(xh, ywl, aw[ntp][n], 0, 0, 0);
                        aw[ntp][n] = __builtin_amdgcn_mfma_f32_16x16x32_bf16(xl, ywh, aw[ntp][n], 0, 0, 0);
                        aa[ntp][n] = __builtin_amdgcn_mfma_f32_16x16x32_bf16(xa, ya, aa[ntp][n], 0, 0, 0);
                    }
                    asm volatile("" ::: "memory");
                }
            const LAS float* prm = PRM + F.wave * 64 + 8 * gq;
            float kl[2][8]; float kkss = 0.f, bon = 0.f;
            lerp8(kc0, kp0, prm + 512, kl[0]); lerp8(kc1, kp1, prm + 512 + 32, kl[1]);
#pragma unroll
            for (int ntp = 0; ntp < 2; ++ntp) {
                const f32x4 q0 = *(const LAS f32x4*)(prm + 6 * 512 + 32 * ntp), q1 = *(const LAS f32x4*)(prm + 6 * 512 + 32 * ntp + 4);
#pragma unroll
                for (int e = 0; e < 8; ++e) { const float l = kl[ntp][e] * (e < 4 ? q0[e & 3] : q1[e & 3]); kkss += l * l; }
            }
            kkss += __shfl_xor(kkss, 16); kkss += __shfl_xor(kkss, 32);
            const float inv = 1.0f / fmaxf(sqrtf(kkss), 1e-12f);
#pragma unroll
            for (int ntp = 0; ntp < 2; ++ntp) {
                const int cl = 32 * ntp + 8 * gq;
                const f32x4 aa0 = aa[ntp][0], aa1 = aa[ntp][1];
                const LAS float* pq = prm + 32 * ntp;
                u32x4 rcx = rc0, vcx = vc0, zcx = zc0, rpx = rp0, vpx = vp0, zpx = zp0;
                if (ntp == 1) {
                    rcx = *(const u32x4*)(prow + 32); vcx = *(const u32x4*)(prow + 2 * DM + 32); zcx = *(const u32x4*)(prow + 3 * DM + 32);
                    rpx = *(const u32x4*)(pprev + 32); vpx = *(const u32x4*)(pprev + 2 * DM + 32); zpx = *(const u32x4*)(pprev + 3 * DM + 32);
                    if (first) { vpx = (u32x4){0u, 0u, 0u, 0u}; zpx = vpx; rpx = vpx; }
                }
                float lwv[8], G[8];
                { const f32x4 w0a = *(const LAS f32x4*)(pq + 4 * 512), w0b = *(const LAS f32x4*)(pq + 4 * 512 + 4);
#pragma unroll
                  for (int e = 0; e < 8; ++e) {
                    const float lw = (e < 4 ? aw[ntp][0][e & 3] + w0a[e & 3] : aw[ntp][1][e & 3] + w0b[e & 3]);
                    const float l = -DECAY_SCALE * sigmoidf_(lw); lwv[e] = l;
                    float x = l;
                    x += __builtin_bit_cast(float, __builtin_amdgcn_update_dpp(0, __builtin_bit_cast(int, x), 0x111, 0xF, 0xF, true));
                    x += __builtin_bit_cast(float, __builtin_amdgcn_update_dpp(0, __builtin_bit_cast(int, x), 0x112, 0xF, 0xF, true));
                    x += __builtin_bit_cast(float, __builtin_amdgcn_update_dpp(0, __builtin_bit_cast(int, x), 0x114, 0xF, 0xF, true));
                    x += __builtin_bit_cast(float, __builtin_amdgcn_update_dpp(0, __builtin_bit_cast(int, x), 0x118, 0xF, 0xF, true));
                    x += carry[ntp][e]; G[e] = x;
                    carry[ntp][e] = __shfl(x, (lane & 48) | 15);
                  } }
                float rl[8], vl[8], zl[8];
                lerp8(rcx, rpx, pq, rl); lerp8(vcx, vpx, pq + 2 * 512, vl); lerp8(zcx, zpx, pq + 3 * 512, zl);
#pragma unroll
                for (int e = 0; e < 8; ++e) zl[e] = siluf_(zl[e]);
                *(u32x4*)(rb.V + obase + cl) = pack8(vl);
                *(u32x4*)(rb.ZS + obase + cl) = pack8(zl);
                const f32x4 a0a = *(const LAS f32x4*)(pq + 5 * 512), a0b = *(const LAS f32x4*)(pq + 5 * 512 + 4);
                const f32x4 kka = *(const LAS f32x4*)(pq + 6 * 512), kkb = *(const LAS f32x4*)(pq + 6 * 512 + 4), kaa = *(const LAS f32x4*)(pq + 7 * 512), kab = *(const LAS f32x4*)(pq + 7 * 512 + 4);
                const f32x4 rka = *(const LAS f32x4*)(pq + 8 * 512), rkb = *(const LAS f32x4*)(pq + 8 * 512 + 4);
                float eg[8], rs[8], ks_[8], kkn[8], bbn[8];
#pragma unroll
                for (int e = 0; e < 8; ++e) {
                    const float la = (e < 4 ? aa0[e & 3] + a0a[e & 3] : aa1[e & 3] + a0b[e & 3]);
                    const float a = sigmoidf_(la);
                    const float g = G[e]; eg[e] = __expf(g); const float egn = __expf(-g), egp = __expf(g - lwv[e]);
                    const float kx = kl[ntp][e];
                    const float kk = kx * (e < 4 ? kka[e & 3] : kkb[e & 3]) * inv;
                    kkn[e] = kk * egp; bbn[e] = kk * a * egn;
                    const float kmod = kx * (1.0f + (a - 1.0f) * (e < 4 ? kaa[e & 3] : kab[e & 3]));
                    bon += rl[e] * kmod * (e < 4 ? rka[e & 3] : rkb[e & 3]);
                    ks_[e] = kmod * egn; rs[e] = rl[e] * eg[e];
                }
                *(u32x4*)(rb.KK + obase + cl) = pack8(kkn);
                *(u32x4*)(rb.B + obase + cl) = pack8(bbn);
                *(u32x4*)(rb.K + obase + cl) = pack8(ks_);
                *(u32x4*)(rb.R + obase + cl) = pack8(rs);
                if ((t & 31) == 31) {
                    float* gp = rb.W + ((size_t)bh * (SEQ / 32) + (t >> 5)) * 64 + cl;
                    *(f32x4*)gp = (f32x4){eg[0], eg[1], eg[2], eg[3]}; *(f32x4*)(gp + 4) = (f32x4){eg[4], eg[5], eg[6], eg[7]};
                }
            }
            bon += __shfl_xor(bon, 16); bon += __shfl_xor(bon, 32);
            if (gq == 0) rb.bonus[(size_t)bh * SEQ + t] = bon;
        }
    }
}

__device__ __forceinline__ float dpp_xor1(float v) { return __builtin_bit_cast(float, __builtin_amdgcn_mov_dpp(__builtin_bit_cast(int, v), 0xB1, 0xF, 0xF, true)); }
__device__ __forceinline__ float dpp_xor2(float v) { return __builtin_bit_cast(float, __builtin_amdgcn_mov_dpp(__builtin_bit_cast(int, v), 0x4E, 0xF, 0xF, true)); }

template <int MODE>
__device__ __forceinline__ void scan_task(LAS float* L, int lane, int bh, int chunk, const RwBufs& rb, const float* gn_g = nullptr, const float* gn_b = nullptr, bf16_t* A2 = nullptr) {
    const int rg = lane >> 2, ks = lane & 3;
    f32x2 s[4][8];
    const size_t mat = ((size_t)bh * NCH + chunk) * 4096;
#pragma unroll
    for (int j = 0; j < 4; ++j)
#pragma unroll
        for (int i = 0; i < 8; ++i) {
            if (MODE == 0) { const int v = 4 * rg + j, k = 16 * ks + 2 * i; s[j][i] = (f32x2){v == k ? 1.f : 0.f, v == k + 1 ? 1.f : 0.f}; }
            else if (MODE == 1) s[j][i] = (f32x2){0.f, 0.f};
            else s[j][i] = *(const f32x2*)(rb.Sst + mat + (4 * rg + j) * 64 + 16 * ks + 2 * i);
        }
    const size_t g0 = ((size_t)bh * SEQ + (size_t)chunk * CHL) * 64;
    const float* gam = rb.W + ((size_t)bh * (SEQ / 32) + (size_t)chunk * (CHL / 32)) * 64 + 16 * ks;
    u32x4 rkk, rbb, rk = {0u, 0u, 0u, 0u}, rr = rk, rv = rk;
    { const size_t go = g0 + lane * 8;
      rkk = *(const u32x4*)(rb.KK + go); rbb = *(const u32x4*)(rb.B + go);
      if (MODE != 0) { rk = *(const u32x4*)(rb.K + go); rv = *(const u32x4*)(rb.V + go); }
      if (MODE == 2) rr = *(const u32x4*)(rb.R + go); }
    f32x4 gm[4];
    const int sp = lane >> 3, ch = lane & 7, hh = bh & 31;
    f32x4 gg0 = {0.f, 0.f, 0.f, 0.f}, gg1 = gg0, gb0 = gg0, gb1 = gg0;
    if (MODE == 2) { gg0 = *(const f32x4*)(gn_g + hh * 64 + ch * 8); gg1 = *(const f32x4*)(gn_g + hh * 64 + ch * 8 + 4); gb0 = *(const f32x4*)(gn_b + hh * 64 + ch * 8); gb1 = *(const f32x4*)(gn_b + hh * 64 + ch * 8 + 4); }
    for (int blk = 0; blk < CHL / 8; ++blk) {
        LAS float* d = L + lane * 8;
        u32x4 zs4 = {0u, 0u, 0u, 0u}; float bon = 0.f;
        if (MODE == 2) { const size_t pr = (size_t)bh * SEQ + (size_t)chunk * CHL + blk * 8 + sp; zs4 = *(const u32x4*)(rb.ZS + pr * 64 + ch * 8); bon = rb.bonus[pr]; }
        { float f[8]; unpack8(rkk, f); *(LAS f32x4*)(d) = (f32x4){f[0], f[1], f[2], f[3]}; *(LAS f32x4*)(d + 4) = (f32x4){f[4], f[5], f[6], f[7]}; }
        { float f[8]; unpack8(rbb, f); *(LAS f32x4*)(d + 512) = (f32x4){f[0], f[1], f[2], f[3]}; *(LAS f32x4*)(d + 516) = (f32x4){f[4], f[5], f[6], f[7]}; }
        if (MODE != 0) {
            { float f[8]; unpack8(rk, f); *(LAS f32x4*)(d + 1024) = (f32x4){f[0], f[1], f[2], f[3]}; *(LAS f32x4*)(d + 1028) = (f32x4){f[4], f[5], f[6], f[7]}; }
            { float f[8]; unpack8(rv, f); *(LAS f32x4*)(d + 2048) = (f32x4){f[0], f[1], f[2], f[3]}; *(LAS f32x4*)(d + 2052) = (f32x4){f[4], f[5], f[6], f[7]}; }
        }
        if (MODE == 2) { float f[8]; unpack8(rr, f); *(LAS f32x4*)(d + 1536) = (f32x4){f[0], f[1], f[2], f[3]}; *(LAS f32x4*)(d + 1540) = (f32x4){f[4], f[5], f[6], f[7]}; }
        if (blk + 1 < CHL / 8) {
            const size_t go = g0 + (size_t)(blk + 1) * 512 + lane * 8;
            rkk = *(const u32x4*)(rb.KK + go); rbb = *(const u32x4*)(rb.B + go);
            if (MODE != 0) { rk = *(const u32x4*)(rb.K + go); rv = *(const u32x4*)(rb.V + go); }
            if (MODE == 2) rr = *(const u32x4*)(rb.R + go);
        }
        if ((blk & 3) == 0) {
            const float* gp = gam + (size_t)(blk >> 2) * 64;
            gm[0] = *(const f32x4*)gp; gm[1] = *(const f32x4*)(gp + 4); gm[2] = *(const f32x4*)(gp + 8); gm[3] = *(const f32x4*)(gp + 12);
        }
        asm volatile("s_waitcnt lgkmcnt(0)" ::: "memory");
#pragma unroll 1
        for (int st = 0; st < 8; ++st) {
            const LAS float* q = L + st * 64 + 16 * ks;
            f32x2 kk2[8], b2[8], k2[8], r2[8];
#pragma unroll
            for (int i4 = 0; i4 < 4; ++i4) {
                const f32x4 b = *(const LAS f32x4*)(q + 4 * i4); kk2[2 * i4] = (f32x2){b.x, b.y}; kk2[2 * i4 + 1] = (f32x2){b.z, b.w};
                const f32x4 c = *(const LAS f32x4*)(q + 512 + 4 * i4); b2[2 * i4] = (f32x2){c.x, c.y}; b2[2 * i4 + 1] = (f32x2){c.z, c.w};
                if (MODE != 0) { const f32x4 dd = *(const LAS f32x4*)(q + 1024 + 4 * i4); k2[2 * i4] = (f32x2){dd.x, dd.y}; k2[2 * i4 + 1] = (f32x2){dd.z, dd.w}; }
                if (MODE == 2) { const f32x4 e = *(const LAS f32x4*)(q + 1536 + 4 * i4); r2[2 * i4] = (f32x2){e.x, e.y}; r2[2 * i4 + 1] = (f32x2){e.z, e.w}; }
            }
            f32x4 vv = {0.f, 0.f, 0.f, 0.f};
            if (MODE != 0) vv = *(const LAS f32x4*)(L + 2048 + st * 64 + 4 * rg);
            float yv[4], sa[4];
#pragma unroll
            for (int j = 0; j < 4; ++j) {
                f32x2 a0 = s[j][0] * kk2[0], a1 = s[j][1] * kk2[1];
#pragma unroll
                for (int i = 2; i < 8; i += 2) { a0 += s[j][i] * kk2[i]; a1 += s[j][i + 1] * kk2[i + 1]; }
                const f32x2 a = a0 + a1; sa[j] = a.x + a.y;
            }
#pragma unroll
            for (int j = 0; j < 4; ++j) sa[j] += dpp_xor1(sa[j]);
#pragma unroll
            for (int j = 0; j < 4; ++j) sa[j] += dpp_xor2(sa[j]);
            if (MODE != 0) {
#pragma unroll
                for (int j = 0; j < 4; ++j) {
                    const f32x2 vj = (f32x2){vv[j], vv[j]};
#pragma unroll
                    for (int i = 0; i < 8; ++i) s[j][i] = __builtin_elementwise_fma(vj, k2[i], s[j][i]);
                }
            }
#pragma unroll
            for (int j = 0; j < 4; ++j) {
                const f32x2 nsa = (f32x2){-sa[j], -sa[j]};
#pragma unroll
                for (int i = 0; i < 8; ++i) s[j][i] = __builtin_elementwise_fma(nsa, b2[i], s[j][i]);
            }
            if (MODE == 2) {
#pragma unroll
                for (int j = 0; j < 4; ++j) {
                    f32x2 y0 = s[j][0] * r2[0], y1 = s[j][1] * r2[1];
#pragma unroll
                    for (int i = 2; i < 8; i += 2) { y0 += s[j][i] * r2[i]; y1 += s[j][i + 1] * r2[i + 1]; }
                    const f32x2 y = y0 + y1; yv[j] = y.x + y.y;
                }
#pragma unroll
                for (int j = 0; j < 4; ++j) yv[j] += dpp_xor1(yv[j]);
#pragma unroll
                for (int j = 0; j < 4; ++j) yv[j] += dpp_xor2(yv[j]);
            }
            if (MODE == 2) { if (ks == 0) *(LAS f32x4*)(L + 2560 + st * 64 + 4 * rg) = (f32x4){yv[0], yv[1], yv[2], yv[3]}; }
        }
        if (MODE == 2) {
            asm volatile("s_waitcnt lgkmcnt(0)" ::: "memory");
            const f32x4 y0 = *(const LAS f32x4*)(L + 2560 + sp * 64 + ch * 8), y1 = *(const LAS f32x4*)(L + 2560 + sp * 64 + ch * 8 + 4);
            const f32x4 v0 = *(const LAS f32x4*)(L + 2048 + sp * 64 + ch * 8), v1 = *(const LAS f32x4*)(L + 2048 + sp * 64 + ch * 8 + 4);
            float y[8] = {y0.x, y0.y, y0.z, y0.w, y1.x, y1.y, y1.z, y1.w};
            const float vf[8] = {v0.x, v0.y, v0.z, v0.w, v1.x, v1.y, v1.z, v1.w};
            float sm = 0.f;
#pragma unroll
            for (int e = 0; e < 8; ++e) sm += y[e];
            sm += __shfl_xor(sm, 1); sm += __shfl_xor(sm, 2); sm += __shfl_xor(sm, 4);
            const float mean = sm * (1.0f / 64.0f); float qq = 0.f;
#pragma unroll
            for (int e = 0; e < 8; ++e) { y[e] -= mean; qq += y[e] * y[e]; }
            qq += __shfl_xor(qq, 1); qq += __shfl_xor(qq, 2); qq += __shfl_xor(qq, 4);
            const float rstd = rsqrtf(qq * (1.0f / 64.0f) + 64e-5f);
            float zf[8], o[8]; unpack8(zs4, zf);
#pragma unroll
            for (int e = 0; e < 8; ++e) o[e] = (y[e] * rstd * (e < 4 ? gg0[e & 3] : gg1[e & 3]) + (e < 4 ? gb0[e & 3] : gb1[e & 3]) + bon * vf[e]) * zf[e];
            const size_t tok = (size_t)(bh >> 5) * SEQ + (size_t)chunk * CHL + blk * 8 + sp;
            *(u32x4*)(A2 + tok * DM + hh * 64 + ch * 8) = pack8(o);
        }
        if ((blk & 3) == 3) {
#pragma unroll
            for (int j = 0; j < 4; ++j)
#pragma unroll
                for (int i4 = 0; i4 < 4; ++i4) { s[j][2 * i4] *= (f32x2){gm[i4].x, gm[i4].y}; s[j][2 * i4 + 1] *= (f32x2){gm[i4].z, gm[i4].w}; }
        }
        asm volatile("s_waitcnt lgkmcnt(0)" ::: "memory");
    }
    if (MODE != 2) {
        float* dst = (MODE == 0 ? rb.Pc : rb.Qc) + mat;
#pragma unroll
        for (int j = 0; j < 4; ++j)
#pragma unroll
            for (int i = 0; i < 8; ++i) *(f32x2*)(dst + (4 * rg + j) * 64 + 16 * ks + 2 * i) = s[j][i];
    }
}
__device__ __forceinline__ void phase_scanA(Frame& F) {
    const RwBufs rb = rw_bufs(F.p->ws); LAS float* L = (LAS float*)(F.lds + F.wave * 12288);
    const int part = F.wave >> 2, npair = gridDim.x * 4;
    for (int bc = blockIdx.x * 4 + (F.wave & 3); bc < 64 * NCH; bc += npair) {
        const int bh = bc / NCH, chunk = bc % NCH;
        if (part == 0) scan_task<0>(L, F.lane, bh, chunk, rb); else scan_task<1>(L, F.lane, bh, chunk, rb);
    }
}
__device__ __forceinline__ void phase_scanC(Frame& F) {
    const RwBufs rb = rw_bufs(F.p->ws); LAS float* L = (LAS float*)(F.lds + F.wave * 12288);
    for (int task = F.gw; task < 64 * NCH; task += F.NGW) scan_task<2>(L, F.lane, task / NCH, task % NCH, rb, F.p->in[26], F.p->in[27], (bf16_t*)(F.p->ws + WS_A2));
}
__device__ __forceinline__ void phase_scanB(Frame& F) {
    const RwBufs rb = rw_bufs(F.p->ws);
    LAS float* SL = (LAS float*)F.lds;
    LAS float* PL = SL + 16 * 68;
    const int tid = F.tid, lane = F.lane, w = F.wave, g = lane >> 4, rho = lane & 15;
    for (int unit = blockIdx.x; unit < 256; unit += gridDim.x) {
        const int bh = unit >> 2, vq = unit & 3;
        f32x4 acc = {0.f, 0.f, 0.f, 0.f};
        const size_t rowoff = (size_t)(16 * vq + 4 * g) * 64 + 16 * (w & 3) + rho;
        if (w < 4) {
            float* d = rb.Sst + ((size_t)bh * NCH) * 4096 + rowoff;
#pragma unroll
            for (int i = 0; i < 4; ++i) d[64 * i] = 0.f;
        }
        f32x4 pa, pb; float qv[4];
        { const size_t mat = ((size_t)bh * NCH) * 4096;
          pa = *(const f32x4*)(rb.Pc + mat + tid * 8); pb = *(const f32x4*)(rb.Pc + mat + tid * 8 + 4);
#pragma unroll
          for (int i = 0; i < 4; ++i) qv[i] = rb.Qc[mat + rowoff + 64 * i]; }
        for (int c = 0; c < NCH - 1; ++c) {
            const size_t mat = ((size_t)bh * NCH + c) * 4096;
            __syncthreads();
            { const int r = tid >> 3, cc = (tid & 7) * 8; *(LAS f32x4*)(PL + r * 68 + cc) = pa; *(LAS f32x4*)(PL + r * 68 + cc + 4) = pb; }
            if (w < 4) {
#pragma unroll
                for (int i = 0; i < 4; ++i) SL[(4 * g + i) * 68 + 16 * w + rho] = acc[i];
            }
            f32x4 a0 = {qv[0], qv[1], qv[2], qv[3]};
            if (c + 1 < NCH - 1) {
                pa = *(const f32x4*)(rb.Pc + mat + 4096 + tid * 8); pb = *(const f32x4*)(rb.Pc + mat + 4096 + tid * 8 + 4);
#pragma unroll
                for (int i = 0; i < 4; ++i) qv[i] = rb.Qc[mat + 4096 + rowoff + 64 * i];
            }
            __syncthreads();
            if (w < 4) {
                f32x4 a1 = {0.f, 0.f, 0.f, 0.f};
#pragma unroll
                for (int ks = 0; ks < 16; ks += 2) {
                    const float s0 = SL[rho * 68 + 4 * ks + g], p0 = PL[(4 * ks + g) * 68 + 16 * w + rho];
                    const float s1 = SL[rho * 68 + 4 * ks + 4 + g], p1 = PL[(4 * ks + 4 + g) * 68 + 16 * w + rho];
                    a0 = __builtin_amdgcn_mfma_f32_16x16x4f32(s0, p0, a0, 0, 0, 0);
                    a1 = __builtin_amdgcn_mfma_f32_16x16x4f32(s1, p1, a1, 0, 0, 0);
                }
                acc = a0 + a1;
                float* d = rb.Sst + mat + 4096 + rowoff;
#pragma unroll
                for (int i = 0; i < 4; ++i) d[64 * i] = acc[i];
            }
        }
    }
}
__device__ __forceinline__ void phase_rwpost(Frame& F, bf16_t* A2) {
    const Params& P = *F.p; const RwBufs rb = rw_bufs(P.ws); const float* gn_g = P.in[26]; const float* gn_b = P.in[27];
    const int lane = F.lane, ch = lane & 7;
    for (int it = F.gw; it < 64 * SEQ / 8; it += F.NGW) {
        const int pair = it * 8 + (lane >> 3), bh = pair >> 12, t = pair & (SEQ - 1), h = bh & 31, b = bh >> 5, c = h * 64 + ch * 8;
        const size_t go = (size_t)pair * 64 + ch * 8;
        const f32x4 y0 = *(const f32x4*)(rb.Y + go), y1 = *(const f32x4*)(rb.Y + go + 4);
        float y[8] = {y0.x, y0.y, y0.z, y0.w, y1.x, y1.y, y1.z, y1.w};
        float s = 0.f;
#pragma unroll
        for (int e = 0; e < 8; ++e) s += y[e];
        s += __shfl_xor(s, 1); s += __shfl_xor(s, 2); s += __shfl_xor(s, 4);
        const float mean = s * (1.0f / 64.0f); float q = 0.f;
#pragma unroll
        for (int e = 0; e < 8; ++e) { y[e] -= mean; q += y[e] * y[e]; }
        q += __shfl_xor(q, 1); q += __shfl_xor(q, 2); q += __shfl_xor(q, 4);
        const float rstd = rsqrtf(q * (1.0f / 64.0f) + 64e-5f), bon = rb.bonus[pair];
        float vf[8], zf[8], o[8]; unpack8(*(const u32x4*)(rb.V + go), vf); unpack8(*(const u32x4*)(rb.ZS + go), zf);
        const f32x4 g0 = *(const f32x4*)(gn_g + c), g1 = *(const f32x4*)(gn_g + c + 4), b0 = *(const f32x4*)(gn_b + c), b1 = *(const f32x4*)(gn_b + c + 4);
#pragma unroll
        for (int e = 0; e < 8; ++e) o[e] = (y[e] * rstd * (e < 4 ? g0[e & 3] : g1[e & 3]) + (e < 4 ? b0[e & 3] : b1[e & 3]) + bon * vf[e]) * zf[e];
        *(u32x4*)(A2 + ((size_t)b * SEQ + t) * DM + c) = pack8(o);
    }
}

constexpr int LDS_BYTES = 147456;
constexpr int NPHASE = 22;
__global__ void __launch_bounds__(NTHREADS, 2) fwd(Params prm) {
    extern __shared__ __attribute__((aligned(16))) unsigned char lds_raw[];
    Frame F; F.lds = (LAS unsigned char*)lds_raw; F.tid = threadIdx.x; F.lane = F.tid & 63; F.wave = __builtin_amdgcn_readfirstlane(F.tid >> 6);
    F.gw = blockIdx.x * NWAVES + F.wave; F.NGW = gridDim.x * NWAVES; F.p = &prm;
    unsigned char* ws = prm.ws;
    volatile LAS unsigned* MISC = (volatile LAS unsigned*)(F.lds + 131072 + 8192);
    if (F.tid < 16) MISC[F.tid] = 0u;
    __syncthreads();
    XcdBarrier bar; bar.bar = (unsigned*)(ws + WS_BAR); bar.x = 0; bar.st = MISC;
#if SINGLE_LAUNCH
    bar = xcd_barrier_post((unsigned*)(ws + WS_BAR), MISC);
    if (prm.use_cg) cg::this_grid().sync();
#endif
    const int lo = prm.ph_lo, hi = prm.ph_hi;
    float* X = (float*)(ws + WS_X); bf16_t* XN = (bf16_t*)(ws + WS_XN); bf16_t* A2 = (bf16_t*)(ws + WS_A2);
    bf16_t* PB = (bf16_t*)(ws + WS_P); float* stats = (float*)(ws + WS_STATS);
    const float* macc = (const float*)(ws + WS_CTL); float* ssq = (float*)(ws + WS_SSQ); const float* biasb = (const float*)(ws + WS_BIAS);
#ifndef PHMASK
#define PHMASK 0x3fffff
#endif
#define IN(k) ((((PHMASK) >> (k)) & 1) && lo <= (k) && (k) < hi)
#ifndef REPMASK
#define REPMASK 0
#endif
#define RP(k) _Pragma("unroll 1") for (int rp_ = 0; rp_ < 1 + (((REPMASK) >> (k)) & 1); ++rp_)
#if SINGLE_LAUNCH
#define SEAM(k) do { if (IN(k) && IN((k) + 1)) xcd_barrier(bar); } while (0)
#else
#define SEAM(k) do { } while (0)
#endif
#define GEMM_IN(EPI, Wt, N_) do { pg8::Gemm g{XN, (const bf16_t*)(ws + (Wt)), M, (N_), DM}; pg8::StaticOrder S; S.init(M, (N_), gridDim.x, blockIdx.x); pg8::gemm_phase(F.lds, g, S, EPI); } while (0)
#define GEMM_OUT(layer, Wt, xin_, fuse_) do { pg8::Gemm g{A2, (const bf16_t*)(ws + (Wt)), M, DM, DM}; pg8::StaticOrder S; S.init(M, DM, gridDim.x, blockIdx.x); \
        EpiOut E{(xin_), X, macc + (size_t)(layer) * 2 * N_SG + 2 * DM, prm.in[5] + (size_t)(layer) * N_SG + 2 * DM, \
                 (fuse_) ? XN : (bf16_t*)nullptr, ssq + (size_t)((layer) + 1) * M, prm.in[3] + (size_t)((layer) + 1) * DM, macc + (size_t)((layer) + 1) * 2 * N_SG + DM, prm.in[5] + (size_t)((layer) + 1) * N_SG + DM}; \
        pg8::gemm_phase(F.lds, g, S, E); } while (0)

    if (IN(0)) RP(0) { phase_p0(F); } SEAM(0);
    if (IN(1)) RP(1) { phase_norm(F, prm.in[0], 0, XN); phase_bias(F); } SEAM(1);
    if (IN(2)) RP(2) { EpiSG E{PB, stats}; GEMM_IN(E, W_SGIN0, N_SG); } SEAM(2);
    if (IN(3)) RP(3) { phase_sgmix(F, 0, PB, PB + (size_t)M * DM, stats, A2); } SEAM(3);
    if (IN(4)) RP(4) { GEMM_OUT(0, W_SGOUT0, prm.in[0], true); } SEAM(4);
    if (IN(6)) RP(6) { EpiAdj<EpiSWA> E{{PB, PB + (size_t)M * DM, PB + (size_t)M * DM + (size_t)M * 256, PB + (size_t)2 * M * DM, (const f32x2*)(ws + WS_ROPE)}, ssq + (size_t)1 * M, biasb}; GEMM_IN(E, W_SWAIN, N_SWA); } SEAM(6);
    if (IN(7)) RP(7) { phase_attn(F, PB, PB + (size_t)M * DM, PB + (size_t)M * DM + (size_t)M * 256, PB + (size_t)2 * M * DM, A2); } SEAM(7);
    if (IN(8)) RP(8) { GEMM_OUT(1, W_SWAOUT, X, true); } SEAM(8);
    if (IN(10)) RP(10) { EpiAdj<EpiPlain> E{{PB, N_RWP}, ssq + (size_t)2 * M, biasb + (size_t)2 * N_RWP}; GEMM_IN(E, W_RWIN, N_RWP); } SEAM(10);
    if (IN(11)) RP(11) { phase_rwprep(F, PB); } SEAM(11);
    if (IN(12)) RP(12) { phase_scanA(F); } SEAM(12);
    if (IN(13)) RP(13) { phase_scanB(F); } SEAM(13);
    if (IN(14)) RP(14) { phase_scanC(F); } SEAM(14);
    if (IN(16)) RP(16) { GEMM_OUT(2, W_RWOUT, X, true); } SEAM(16);
    if (IN(18)) RP(18) { EpiAdj<EpiSG> E{{PB, stats}, ssq + (size_t)3 * M, biasb + (size_t)4 * N_RWP}; GEMM_IN(E, W_SGIN1, N_SG); } SEAM(18);
    if (IN(19)) RP(19) { phase_sgmix(F, 1, PB, PB + (size_t)M * DM, stats, A2); } SEAM(19);
    if (IN(20)) RP(20) { GEMM_OUT(3, W_SGOUT1, X, false); } SEAM(20);
    if (IN(21)) RP(21) { phase_final(F, X); }
}

extern "C" void kernel_launch(void* const* d_in, const int* in_sizes, int n_in, void* d_out, int out_size, void* d_ws, size_t ws_size, hipStream_t stream) {
    static int grid = 0;
    if (grid == 0) {
        if (n_in != 28 || out_size != M * DM || ws_size < WS_END) { fprintf(stderr, "kernel_launch: unexpected shapes (n_in %d out %d ws %zu)\n", n_in, out_size, ws_size); grid = -1; return; }
        int dev = 0, cus = 0, per_cu = 0;
        hipGetDevice(&dev); hipDeviceGetAttribute(&cus, hipDeviceAttributeMultiprocessorCount, dev);
        hipFuncSetAttribute((const void*)fwd, hipFuncAttributeMaxDynamicSharedMemorySize, LDS_BYTES);
        hipOccupancyMaxActiveBlocksPerMultiprocessor(&per_cu, (const void*)fwd, NTHREADS, LDS_BYTES);
        (void)hipGetLastError();
        if (per_cu < 1) per_cu = 1;
        grid = cus;
        if (grid > 256) grid = 256;
    }
    if (grid < 0) return;
    hipMemsetAsync((char*)d_ws + WS_CTL, 0, CTL_BYTES, stream);
    Params p{};
    for (int i = 0; i < 28; ++i) p.in[i] = (const float*)d_in[i];
    p.out = (float*)d_out; p.ws = (unsigned char*)d_ws; p.use_cg = 0; p.pad = 0;
#if SINGLE_LAUNCH
    p.ph_lo = 0; p.ph_hi = NPHASE;
    void* args[] = {&p};
    hipError_t e = hipLaunchCooperativeKernel((const void*)fwd, dim3(grid), dim3(NTHREADS), args, LDS_BYTES, stream);
    if (e != hipSuccess) fprintf(stderr, "cooperative launch failed: %s (grid %d)\n", hipGetErrorString(e), grid);
#else
    for (int ph = 0; ph < NPHASE; ++ph) {
        p.ph_lo = ph; p.ph_hi = ph + 1;
        hipLaunchKernelGGL(fwd, dim3(grid), dim3(NTHREADS), LDS_BYTES, stream, p);
    }
#endif
}
```

```cpp
#include <hip/hip_runtime.h>
#include <hip/hip_cooperative_groups.h>
#include <cstdio>
#include <cstdint>
namespace cg = cooperative_groups;

#ifndef SINGLE_LAUNCH
#define SINGLE_LAUNCH 1
#endif

#define LAS __attribute__((address_space(3)))
typedef unsigned short bf16_t;
typedef short bf16x8 __attribute__((ext_vector_type(8)));
typedef float f32x4 __attribute__((ext_vector_type(4)));
typedef float f32x2 __attribute__((ext_vector_type(2)));
typedef unsigned u32x4 __attribute__((ext_vector_type(4)));
typedef unsigned u32x2 __attribute__((ext_vector_type(2)));

constexpr int BATCH = 2, SEQ = 4096, DM = 2048, M = BATCH * SEQ;
constexpr int N_SG = 6144, N_SWA = 4608, N_RW = 8384, N_RWP = 8448;
constexpr int NWAVES = 8, NTHREADS = 512;
constexpr int NCH = 32, CHL = 128;
constexpr float DECAY_SCALE = 0.6065306597126334f;

constexpr size_t MiB = 1u << 20;
constexpr size_t WS_CTL = 0, CTL_BYTES = 1 * MiB;
constexpr size_t WS_BAR = 512 * 1024;
constexpr size_t WS_SSQ = 256 * 1024;
constexpr size_t WS_BIAS = 7 * MiB + 512 * 1024;
constexpr size_t WS_ROPE = 1 * MiB;
constexpr size_t WS_STATS = 3 * MiB;
constexpr size_t WS_BONUS = 5 * MiB;
constexpr size_t WS_LORA = 6 * MiB;
constexpr size_t WS_W = 8 * MiB;
constexpr size_t W_SGIN0 = WS_W, W_SGIN1 = W_SGIN0 + 24 * MiB, W_SGOUT0 = W_SGIN1 + 24 * MiB, W_SGOUT1 = W_SGOUT0 + 8 * MiB;
constexpr size_t W_SWAIN = W_SGOUT1 + 8 * MiB, W_SWAOUT = W_SWAIN + 18 * MiB, W_RWIN = W_SWAOUT + 8 * MiB, W_RWOUT = W_RWIN + 33 * MiB;
constexpr size_t WS_X = 140 * MiB;
constexpr size_t WS_XN = 204 * MiB;
constexpr size_t WS_A2 = 236 * MiB;
constexpr size_t WS_P = 268 * MiB;
constexpr size_t WS_RW = 400 * MiB;
constexpr size_t WS_END = 656 * MiB;
static_assert(W_RWOUT + 8 * MiB <= WS_X, "ws map");

__device__ __forceinline__ unsigned pk2(float lo, float hi) { unsigned r; asm("v_cvt_pk_bf16_f32 %0, %1, %2" : "=v"(r) : "v"(lo), "v"(hi)); return r; }
__device__ __forceinline__ unsigned f2bf(float f) { return pk2(f, 0.f) & 0xffffu; }
__device__ __forceinline__ float bflo(unsigned w) { return __builtin_bit_cast(float, w << 16); }
__device__ __forceinline__ float bfhi(unsigned w) { return __builtin_bit_cast(float, w & 0xffff0000u); }
__device__ __forceinline__ float bf2f(bf16_t h) { return __builtin_bit_cast(float, (unsigned)h << 16); }
__device__ __forceinline__ unsigned cvt_pk_bf16(float lo, float hi) { unsigned r; asm volatile("v_cvt_pk_bf16_f32 %0, %1, %2" : "=v"(r) : "v"(lo), "v"(hi)); return r; }
__device__ __forceinline__ float frcp(float x) { return __builtin_amdgcn_rcpf(x); }
__device__ __forceinline__ float sigmoidf_(float x) { return frcp(1.0f + __expf(-x)); }
__device__ __forceinline__ float siluf_(float x) { return x * frcp(1.0f + __expf(-x)); }
__device__ __forceinline__ float geluf_(float x) { return x * frcp(1.0f + __expf(-1.5957691216057308f * (x + 0.044715f * x * x * x))); }
__device__ __forceinline__ float tanhf_(float x) { return 1.0f - 2.0f * frcp(__expf(2.0f * x) + 1.0f); }
__device__ __forceinline__ float wave_sum(float v) {
#pragma unroll
    for (int o = 1; o < 64; o <<= 1) v += __shfl_xor(v, o);
    return v;
}
__device__ __forceinline__ void unpack8(u32x4 w, float (&f)[8]) {
    f[0] = bflo(w.x); f[1] = bfhi(w.x); f[2] = bflo(w.y); f[3] = bfhi(w.y); f[4] = bflo(w.z); f[5] = bfhi(w.z); f[6] = bflo(w.w); f[7] = bfhi(w.w);
}
__device__ __forceinline__ u32x4 pack8(const float (&f)[8]) {
    u32x4 w; w.x = pk2(f[0], f[1]); w.y = pk2(f[2], f[3]); w.z = pk2(f[4], f[5]); w.w = pk2(f[6], f[7]); return w;
}

namespace pg8 {
constexpr int BM = 256, BK = 64, HALF = 128, HTB = HALF * BK * 2, STAGE_BYTES = 8 * HTB, NXCD = 8, WGM = 8;
__host__ __device__ __forceinline__ int lds_byte(int r, int c) { const int st = (r >> 4) * 2 + (c >> 5), rr = r & 15, cc = c & 31, ob = rr * 64 + cc * 2; return st * 1024 + (ob ^ (((ob >> 9) & 1) << 5)); }
__host__ __device__ __forceinline__ void stage_rc(int b, int& R, int& C) { const int st = b / 1024, sb = b % 1024, swz = sb ^ (((sb >> 9) & 1) << 5); R = (st >> 1) * 16 + swz / 64; C = (st & 1) * 32 + (swz % 64) / 2; }
__host__ __device__ __forceinline__ int perm32(int rho) { const int n = rho >> 4, i = rho & 15; return 8 * (i >> 2) + 4 * n + (i & 3); }
struct Unit { int pm, pn; };
struct Gemm { const bf16_t* A; const bf16_t* Bt; int M, N, K; };
struct StaticOrder {
    int nM, nN, nwg, G, c;
    __device__ void init(int M_, int N_, int G_, int c_) { nM = M_ / BM; nN = N_ / BM; nwg = nM * nN; G = G_; c = c_; }
    __device__ bool next(int i, Unit& u) const {
        const long L = (long)i * G + c; if (L >= nwg) return false;
        int wgid = (int)L; { const int q = nwg / NXCD, r = nwg % NXCD, xcd = wgid % NXCD, off = wgid / NXCD; wgid = (xcd < r ? xcd * (q + 1) : r * (q + 1) + (xcd - r) * q) + off; }
        const int nig = WGM * nN, gid = wgid / nig, fm = gid * WGM, gsz = (nM - fm) < WGM ? (nM - fm) : WGM;
        u.pm = fm + ((wgid % nig) % gsz); u.pn = (wgid % nig) / gsz; return true;
    }
};
template <class Epi>
__device__ __forceinline__ void gemm_phase(LAS unsigned char* lds, const Gemm g, const StaticOrder& S, const Epi& E) {
    const int tid = threadIdx.x, wid = __builtin_amdgcn_readfirstlane(tid >> 6), lane = tid & 63, wr = wid >> 2, wc = wid & 3, fr = lane & 15, fq = lane >> 4;
    const int K = g.K, nt = K / BK;
    unsigned voffA[2], voffB[2];
#pragma unroll
    for (int i = 0; i < 2; ++i) { int R, C; stage_rc(tid * 16 + i * 8192, R, C); const int Rb = (R & ~31) + perm32(R & 31);
        voffA[i] = (unsigned)(R * K + C) * 2u; voffB[i] = (unsigned)(Rb * K + C) * 2u; }
    const size_t kstep = (size_t)(BK * 2);
    const size_t hstep = (size_t)HALF * K * 2;
    const size_t tstep = 2 * hstep;
    const unsigned ldsw = (unsigned)wid * 1024u;
    const int aoff = lds_byte(wr * 64 + fr, fq * 8), boff = lds_byte(wc * 32 + fr, fq * 8);
#define PG8_SA(b, h) (((b) * 2 + (h)) * HTB)
#define PG8_SB(b, h) ((4 + (b) * 2 + (h)) * HTB)
#define PG8_STAGE(bufoff, gbase, voff) do { _Pragma("unroll") for (int _i = 0; _i < 2; ++_i) \
        __builtin_amdgcn_global_load_lds((const unsigned*)((const char*)(gbase) + (voff)[_i]), (LAS unsigned*)(lds + (bufoff) + ldsw + _i * 8192), 16, 0, 0); } while (0)
#define PG8_LDA(dst, b, h) do { _Pragma("unroll") for (int m = 0; m < 4; ++m) _Pragma("unroll") for (int k = 0; k < 2; ++k) dst[m][k] = *(const LAS bf16x8*)(lds + PG8_SA(b, h) + aoff + m * 2048 + k * 1024); } while (0)
#define PG8_LDB(dst, b, h) do { _Pragma("unroll") for (int n = 0; n < 2; ++n) _Pragma("unroll") for (int k = 0; k < 2; ++k) dst[n][k] = *(const LAS bf16x8*)(lds + PG8_SB(b, h) + boff + n * 2048 + k * 1024); } while (0)
#define PG8_MMA(ai, bj, At, Bt) do { __builtin_amdgcn_s_setprio(1); _Pragma("unroll") for (int m = 0; m < 4; ++m) _Pragma("unroll") for (int n = 0; n < 2; ++n) _Pragma("unroll") for (int k = 0; k < 2; ++k) \
        acc[ai][bj][m][n] = __builtin_amdgcn_mfma_f32_16x16x32_bf16(Bt[n][k], At[m][k], acc[ai][bj][m][n], 0, 0, 0); __builtin_amdgcn_s_setprio(0); } while (0)
#define PG8_WAIT_V(n) asm volatile("s_waitcnt vmcnt(" #n ")" ::: "memory")
#define PG8_WAIT_L(n) asm volatile("s_waitcnt lgkmcnt(" #n ")" ::: "memory")
#define PG8_BAR __builtin_amdgcn_s_barrier()
#define PG8_SCHED __builtin_amdgcn_sched_barrier(0)
    Unit cur, nxt; int ui = 0;
    if (!S.next(0, cur)) return;
    f32x4 acc[2][2][4][2];
#pragma unroll
    for (int a = 0; a < 2; ++a)
#pragma unroll
        for (int b = 0; b < 2; ++b)
#pragma unroll
            for (int m = 0; m < 4; ++m)
#pragma unroll
                for (int n = 0; n < 2; ++n) acc[a][b][m][n] = (f32x4){0.f, 0.f, 0.f, 0.f};
    bf16x8 At[4][2], B0[2][2], B1[2][2];
    const char* cA = (const char*)g.A + (size_t)cur.pm * tstep; const char* cB = (const char*)g.Bt + (size_t)cur.pn * tstep;
    PG8_STAGE(PG8_SB(0, 0), cB, voffB); PG8_STAGE(PG8_SB(0, 1), cB + hstep, voffB); PG8_STAGE(PG8_SA(0, 0), cA, voffA); PG8_STAGE(PG8_SA(0, 1), cA + hstep, voffA);
    if (wr == 1) PG8_BAR;
    PG8_WAIT_V(2); PG8_BAR;
    PG8_STAGE(PG8_SB(1, 0), cB + kstep, voffB); PG8_STAGE(PG8_SA(1, 0), cA + kstep, voffA); PG8_STAGE(PG8_SB(1, 1), cB + hstep + kstep, voffB);
    PG8_WAIT_V(6); PG8_BAR;
    for (;;) {
        const bool has_next = S.next(ui + 1, nxt);
        const char* nA = has_next ? (const char*)g.A + (size_t)nxt.pm * tstep : cA; const char* nB = has_next ? (const char*)g.Bt + (size_t)nxt.pn * tstep : cB;
        asm volatile(".p2align 8" ::: "memory");
        for (int t = 0; t < nt; t += 2) {
            const bool last = (t == nt - 2);
            const char* a1 = cA + (size_t)(t + 1) * kstep;
            const char* a2 = last ? nA : cA + (size_t)(t + 2) * kstep; const char* b2 = last ? nB : cB + (size_t)(t + 2) * kstep;
            const char* a3 = a2 + kstep; const char* b3 = b2 + kstep;
            PG8_LDB(B0, 0, 0); PG8_LDB(B1, 0, 1); PG8_SCHED; PG8_LDA(At, 0, 0); PG8_STAGE(PG8_SA(1, 1), a1 + hstep, voffA);
            PG8_WAIT_V(8); PG8_WAIT_L(0); PG8_BAR; PG8_MMA(0, 0, At, B0); PG8_MMA(0, 1, At, B1); PG8_BAR; PG8_SCHED;
            PG8_LDA(At, 0, 1); PG8_STAGE(PG8_SB(0, 0), b2, voffB); PG8_STAGE(PG8_SB(0, 1), b2 + hstep, voffB); PG8_STAGE(PG8_SA(0, 0), a2, voffA);
            PG8_WAIT_V(8); PG8_WAIT_L(0); PG8_BAR; PG8_MMA(1, 0, At, B0); PG8_MMA(1, 1, At, B1); PG8_BAR; PG8_SCHED;
            PG8_LDB(B0, 1, 0); PG8_LDB(B1, 1, 1); PG8_SCHED; PG8_LDA(At, 1, 0); PG8_STAGE(PG8_SA(0, 1), a2 + hstep, voffA);
            PG8_WAIT_V(8); PG8_WAIT_L(0); PG8_BAR; PG8_MMA(0, 0, At, B0); PG8_MMA(0, 1, At, B1); PG8_BAR; PG8_SCHED;
            PG8_LDA(At, 1, 1); PG8_STAGE(PG8_SB(1, 0), b3, voffB); PG8_STAGE(PG8_SB(1, 1), b3 + hstep, voffB); PG8_STAGE(PG8_SA(1, 0), a3, voffA);
            PG8_WAIT_V(8); PG8_WAIT_L(0); PG8_BAR; PG8_MMA(1, 0, At, B0); PG8_MMA(1, 1, At, B1); PG8_BAR; PG8_SCHED;
        }
        if (wr == 0) PG8_BAR;
        E(acc, cur, wr, wc, fr, fq);
        if (!has_next) break;
#pragma unroll
        for (int a = 0; a < 2; ++a)
#pragma unroll
            for (int b = 0; b < 2; ++b)
#pragma unroll
                for (int m = 0; m < 4; ++m)
#pragma unroll
                    for (int n = 0; n < 2; ++n) acc[a][b][m][n] = (f32x4){0.f, 0.f, 0.f, 0.f};
        cur = nxt; cA = nA; cB = nB; ++ui;
        if (wr == 1) PG8_BAR;
    }
    PG8_WAIT_V(0);
    PG8_BAR;
#undef PG8_SA
#undef PG8_SB
#undef PG8_STAGE
#undef PG8_LDA
#undef PG8_LDB
#undef PG8_MMA
#undef PG8_WAIT_V
#undef PG8_WAIT_L
#undef PG8_BAR
#undef PG8_SCHED
}
}
using pg8::Unit;
typedef f32x4 Acc[2][2][4][2];

struct EpiSG {
    bf16_t* P0; float* stats;
    __device__ __forceinline__ void operator()(const Acc& acc, const Unit& u, int wr, int wc, int fr, int fq) const {
        const int row0 = u.pm * 256 + wr * 64 + fr;
        if (u.pn < 16) {
            const int col0 = u.pn * 128 + wc * 32 + 8 * fq;
#pragma unroll
            for (int ai = 0; ai < 2; ++ai)
#pragma unroll
                for (int m = 0; m < 4; ++m) {
                    const int row = row0 + ai * 128 + m * 16;
                    f32x4 a = acc[ai][0][m][0], b = acc[ai][0][m][1]; const f32x4 za = acc[ai][1][m][0], zb = acc[ai][1][m][1];
#pragma unroll
                    for (int e = 0; e < 4; ++e) { a[e] = geluf_(a[e]) * siluf_(za[e]); b[e] = geluf_(b[e]) * siluf_(zb[e]); }
                    u32x4 w; w.x = cvt_pk_bf16(a[0], a[1]); w.y = cvt_pk_bf16(a[2], a[3]); w.z = cvt_pk_bf16(b[0], b[1]); w.w = cvt_pk_bf16(b[2], b[3]);
                    *(u32x4*)(P0 + (size_t)row * DM + col0) = w;
                }
        } else {
            const int vt = u.pn - 16, col0 = vt * 256 + wc * 32 + 8 * fq;
            bf16_t* base = P0 + (size_t)M * DM;
#pragma unroll
            for (int ai = 0; ai < 2; ++ai)
#pragma unroll
                for (int m = 0; m < 4; ++m) {
                    const int row = row0 + ai * 128 + m * 16; float s = 0.f, q = 0.f;
#pragma unroll
                    for (int bj = 0; bj < 2; ++bj) {
                        f32x4 a = acc[ai][bj][m][0], b = acc[ai][bj][m][1];
#pragma unroll
                        for (int e = 0; e < 4; ++e) { a[e] = geluf_(a[e]); b[e] = geluf_(b[e]); }
                        s += (a[0] + a[1]) + (a[2] + a[3]) + (b[0] + b[1]) + (b[2] + b[3]);
                        q += (a[0] * a[0] + a[1] * a[1]) + (a[2] * a[2] + a[3] * a[3]) + (b[0] * b[0] + b[1] * b[1]) + (b[2] * b[2] + b[3] * b[3]);
                        u32x4 w; w.x = cvt_pk_bf16(a[0], a[1]); w.y = cvt_pk_bf16(a[2], a[3]); w.z = cvt_pk_bf16(b[0], b[1]); w.w = cvt_pk_bf16(b[2], b[3]);
                        *(u32x4*)(base + (size_t)row * DM + col0 + bj * 128) = w;
                    }
                    s += __shfl_xor(s, 16); s += __shfl_xor(s, 32); q += __shfl_xor(q, 16); q += __shfl_xor(q, 32);
                    if (fq == 0) *(f32x2*)(stats + ((size_t)row * 32 + vt * 4 + wc) * 2) = (f32x2){s, q};
                }
        }
    }
};
struct EpiSWA {
    bf16_t *Q, *Kb, *Vb, *Z; const f32x2* rope;
    __device__ __forceinline__ void operator()(const Acc& acc, const Unit& u, int wr, int wc, int fr, int fq) const {
        const int pn = u.pn; bf16_t* base; int ld, colt; bool rp = false, act = false;
        if (pn < 8) { base = Q; ld = DM; colt = pn * 256; rp = true; }
        else if (pn == 8) { base = Kb; ld = 256; colt = 0; rp = true; }
        else if (pn == 9) { base = Vb; ld = 256; colt = 0; }
        else { base = Z; ld = DM; colt = (pn - 10) * 256; act = true; }
        const int row0 = u.pm * 256 + wr * 64 + fr, col0 = colt + wc * 32 + 8 * fq;
        const int f0 = 16 * (wc & 1) + 4 * fq;
#pragma unroll
        for (int ai = 0; ai < 2; ++ai)
#pragma unroll
            for (int m = 0; m < 4; ++m) {
                const int row = row0 + ai * 128 + m * 16;
                f32x4 cs0 = {1.f, 0.f, 1.f, 0.f}, cs1 = cs0;
                if (rp) { const f32x4* rr = (const f32x4*)(rope + (size_t)row * 32 + f0); cs0 = rr[0]; cs1 = rr[1]; }
#pragma unroll
                for (int bj = 0; bj < 2; ++bj) {
                    f32x4 a = acc[ai][bj][m][0], b = acc[ai][bj][m][1];
                    if (rp) {
                        const float c0 = cs0[0], s0 = cs0[1], c1 = cs0[2], s1 = cs0[3], c2 = cs1[0], s2 = cs1[1], c3 = cs1[2], s3 = cs1[3];
                        f32x4 o1, o2;
                        o1[0] = a[0] * c0 - b[0] * s0; o2[0] = b[0] * c0 + a[0] * s0;
                        o1[1] = a[1] * c1 - b[1] * s1; o2[1] = b[1] * c1 + a[1] * s1;
                        o1[2] = a[2] * c2 - b[2] * s2; o2[2] = b[2] * c2 + a[2] * s2;
                        o1[3] = a[3] * c3 - b[3] * s3; o2[3] = b[3] * c3 + a[3] * s3;
                        a = o1; b = o2;
                    }
                    if (act) {
#pragma unroll
                        for (int e = 0; e < 4; ++e) { a[e] = siluf_(a[e]); b[e] = siluf_(b[e]); }
                    }
                    u32x4 w; w.x = cvt_pk_bf16(a[0], a[1]); w.y = cvt_pk_bf16(a[2], a[3]); w.z = cvt_pk_bf16(b[0], b[1]); w.w = cvt_pk_bf16(b[2], b[3]);
                    *(u32x4*)(base + (size_t)row * ld + col0 + bj * 128) = w;
                }
            }
    }
};
struct EpiPlain {
    bf16_t* O; int ld;
    __device__ __forceinline__ void operator()(const Acc& acc, const Unit& u, int wr, int wc, int fr, int fq) const {
        const int row0 = u.pm * 256 + wr * 64 + fr, col0 = u.pn * 256 + wc * 32 + 8 * fq;
#pragma unroll
        for (int ai = 0; ai < 2; ++ai)
#pragma unroll
            for (int m = 0; m < 4; ++m) {
                const int row = row0 + ai * 128 + m * 16;
#pragma unroll
                for (int bj = 0; bj < 2; ++bj) {
                    const f32x4 a = acc[ai][bj][m][0], b = acc[ai][bj][m][1];
                    u32x4 w; w.x = cvt_pk_bf16(a[0], a[1]); w.y = cvt_pk_bf16(a[2], a[3]); w.z = cvt_pk_bf16(b[0], b[1]); w.w = cvt_pk_bf16(b[2], b[3]);
                    *(u32x4*)(O + (size_t)row * ld + col0 + bj * 128) = w;
                }
            }
    }
};
struct EpiOut {
    const float* xin; float* xout; const float* macc; const float* mb;
    bf16_t* xb; float* ssq; const float* g; const float* macc_sc; const float* mb_sc;
    __device__ __forceinline__ void operator()(const Acc& acc, const Unit& u, int wr, int wc, int fr, int fq) const {
        const int row0 = u.pm * 256 + wr * 64 + fr, col0 = u.pn * 256 + wc * 32 + 8 * fq;
        const int b = u.pm >> 4;
        float ss[2][4];
#pragma unroll
        for (int ai = 0; ai < 2; ++ai)
#pragma unroll
            for (int m = 0; m < 4; ++m) ss[ai][m] = 0.f;
#pragma unroll
        for (int bj = 0; bj < 2; ++bj) {
            const int cj = col0 + bj * 128;
            const f32x4 gt0 = *(const f32x4*)(macc + (size_t)b * N_SG + cj) + *(const f32x4*)(mb + cj), gt1 = *(const f32x4*)(macc + (size_t)b * N_SG + cj + 4) + *(const f32x4*)(mb + cj + 4);
            f32x4 gs0 = {0.f, 0.f, 0.f, 0.f}, gs1 = gs0;
            if (xb) { gs0 = *(const f32x4*)(g + cj) * (*(const f32x4*)(macc_sc + (size_t)b * N_SG + cj) + *(const f32x4*)(mb_sc + cj) + 1.0f);
                      gs1 = *(const f32x4*)(g + cj + 4) * (*(const f32x4*)(macc_sc + (size_t)b * N_SG + cj + 4) + *(const f32x4*)(mb_sc + cj + 4) + 1.0f); }
#pragma unroll
            for (int ai = 0; ai < 2; ++ai)
#pragma unroll
                for (int m = 0; m < 4; ++m) {
                    const size_t off = (size_t)(row0 + ai * 128 + m * 16) * DM + cj;
                    const f32x4 x0 = *(const f32x4*)(xin + off) + gt0 * acc[ai][bj][m][0];
                    const f32x4 x1 = *(const f32x4*)(xin + off + 4) + gt1 * acc[ai][bj][m][1];
                    *(f32x4*)(xout + off) = x0; *(f32x4*)(xout + off + 4) = x1;
                    if (xb) {
                        ss[ai][m] += (x0[0] * x0[0] + x0[1] * x0[1]) + (x0[2] * x0[2] + x0[3] * x0[3]) + (x1[0] * x1[0] + x1[1] * x1[1]) + (x1[2] * x1[2] + x1[3] * x1[3]);
                        const f32x4 h0 = x0 * gs0, h1 = x1 * gs1;
                        u32x4 w; w.x = cvt_pk_bf16(h0[0], h0[1]); w.y = cvt_pk_bf16(h0[2], h0[3]); w.z = cvt_pk_bf16(h1[0], h1[1]); w.w = cvt_pk_bf16(h1[2], h1[3]);
                        *(u32x4*)(xb + off) = w;
                    }
                    if (m & 1) asm volatile("" ::: "memory");
                }
        }
        if (xb) {
#pragma unroll
            for (int ai = 0; ai < 2; ++ai)
#pragma unroll
                for (int m = 0; m < 4; ++m) { float s = ss[ai][m]; s += __shfl_xor(s, 16); s += __shfl_xor(s, 32); if (fq == 0) atomicAdd(ssq + row0 + ai * 128 + m * 16, s); }
        }
    }
};
template <class Inner> struct EpiAdj {
    Inner in; const float* ssq; const float* bias;
    __device__ __forceinline__ void operator()(Acc& acc, const Unit& u, int wr, int wc, int fr, int fq) const {
        const int b = u.pm >> 4, colb = u.pn * 256 + wc * 32 + 8 * fq;
        f32x4 bs[2][2];
#pragma unroll
        for (int bj = 0; bj < 2; ++bj)
#pragma unroll
            for (int n = 0; n < 2; ++n) bs[bj][n] = *(const f32x4*)(bias + (size_t)b * N_RWP + colb + bj * 128 + 4 * n);
#pragma unroll
        for (int ai = 0; ai < 2; ++ai)
#pragma unroll
            for (int m = 0; m < 4; ++m) {
                const float rstd = rsqrtf(ssq[u.pm * 256 + ai * 128 + wr * 64 + m * 16 + fr] * (1.0f / DM) + 1e-6f);
#pragma unroll
                for (int bj = 0; bj < 2; ++bj)
#pragma unroll
                    for (int n = 0; n < 2; ++n) acc[ai][bj][m][n] = acc[ai][bj][m][n] * rstd + bs[bj][n];
            }
        in(acc, u, wr, wc, fr, fq);
    }
};

struct Params { const float* in[28]; float* out; unsigned char* ws; int ph_lo, ph_hi, use_cg, pad; };

struct Frame {
    LAS unsigned char* lds; int tid, lane, wave, gw, NGW;
    const Params* p;
};

#define XB_TMO      128
#define XB_XCNT(j)  (256  + 64 * (j))
#define XB_XSUB(j)  (1280 + 64 * (j))
#define XB_XGEN(j)  (2304 + 64 * (j))
#define XB_TOP      3328
#define XB_TOPGEN   3392
#define XB_SPIN_CAP (1u << 22)
__device__ __forceinline__ unsigned xb_ld(unsigned* p)              { return __hip_atomic_load(p, __ATOMIC_RELAXED, __HIP_MEMORY_SCOPE_AGENT); }
__device__ __forceinline__ unsigned xb_add(unsigned* p, unsigned v) { return __hip_atomic_fetch_add(p, v, __ATOMIC_RELAXED, __HIP_MEMORY_SCOPE_AGENT); }
__device__ __forceinline__ unsigned xb_xcc_id() { return (unsigned)__builtin_amdgcn_s_getreg((3 << 11) | 20) & 0xFu; }
#define XB_SPIN(cond, bar) do { unsigned _sp = 0; while (cond) { __builtin_amdgcn_s_sleep(1); \
    if ((++_sp & 255u) == 0u) { if (xb_ld(&(bar)[XB_TMO])) break; if (_sp > XB_SPIN_CAP) { atomicAdd(&(bar)[XB_TMO], 1u); break; } } } } while (0)
struct XcdBarrier { unsigned* bar; unsigned x; volatile LAS unsigned* st; };
__device__ __forceinline__ XcdBarrier xcd_barrier_post(unsigned* bar, volatile LAS unsigned* st) {
    XcdBarrier b; b.bar = bar; b.x = xb_xcc_id(); b.st = st;
    if (threadIdx.x == 0) (void)xb_add(&bar[XB_XCNT(b.x)], 1u);
    return b;
}
__device__ __forceinline__ void xcd_barrier_complete(unsigned* bar, unsigned x, unsigned& nloc, unsigned& nx) {
    const unsigned G = gridDim.x * gridDim.y * gridDim.z;
    unsigned sum, cnt, mine, sp = 0u;
    for (;;) {
        sum = 0u; cnt = 0u; mine = 0u;
#pragma unroll
        for (unsigned j = 0; j < 16; ++j) { const unsigned c = xb_ld(&bar[XB_XCNT(j)]); sum += c; cnt += (c > 0u) ? 1u : 0u; mine = (j == x) ? c : mine; }
        if (sum == G) break;
        __builtin_amdgcn_s_sleep(1);
        if ((++sp & 255u) == 0u) { if (xb_ld(&bar[XB_TMO])) break; if (sp > XB_SPIN_CAP) { atomicAdd(&bar[XB_TMO], 1u); break; } }
    }
    nloc = mine > 0u ? mine : 1u; nx = cnt > 0u ? cnt : 1u;
}
__device__ __forceinline__ void xcd_barrier(const XcdBarrier& b) {
    asm volatile("s_waitcnt vmcnt(0)" ::: "memory");
    __syncthreads();
    if (threadIdx.x == 0) {
        unsigned* bar = b.bar;
        __builtin_amdgcn_s_waitcnt(0);
        unsigned nloc = b.st[0], nx = b.st[1];
        if (nloc == 0u) { xcd_barrier_complete(bar, b.x, nloc, nx); b.st[0] = nloc; b.st[1] = nx; }
        const unsigned old = xb_add(&bar[XB_XSUB(b.x)], 1u);
        const unsigned gen = old / nloc;
        if (old + 1u == (gen + 1u) * nloc) {
            __builtin_amdgcn_fence(__ATOMIC_RELEASE, "agent");
            asm volatile("s_waitcnt vmcnt(0)" ::: "memory");
            const unsigned og = xb_add(&bar[XB_TOP], 1u);
            const unsigned tg = og / nx;
            if (og + 1u == (tg + 1u) * nx) xb_add(&bar[XB_TOPGEN], 1u);
            else XB_SPIN(xb_ld(&bar[XB_TOPGEN]) == tg, bar);
            __builtin_amdgcn_fence(__ATOMIC_ACQUIRE, "agent");
            xb_add(&bar[XB_XGEN(b.x)], 1u);
            asm volatile("s_waitcnt vmcnt(0)" ::: "memory");
        } else {
            XB_SPIN(xb_ld(&bar[XB_XGEN(b.x)]) == gen, bar);
            __builtin_amdgcn_fence(__ATOMIC_ACQUIRE, "agent");
            asm volatile("s_waitcnt vmcnt(0)" ::: "memory");
        }
    }
    __syncthreads();
}

__device__ const float ROPE_INVF[32] = {1.f, 0.749894202f, 0.562341332f, 0.421696514f, 0.316227764f, 0.237137377f, 0.177827939f, 0.133352146f, 0.100000001f, 0.0749894232f, 0.0562341325f, 0.0421696492f, 0.0316227749f, 0.0237137377f, 0.0177827943f, 0.013335214f, 0.00999999978f, 0.00749894232f, 0.00562341325f, 0.00421696482f, 0.00316227763f, 0.00237137382f, 0.00177827943f, 0.00133352145f, 0.00100000005f, 0.000749894185f, 0.000562341302f, 0.000421696517f, 0.000316227757f, 0.00023713737f, 0.00017782794f, 0.00013335215f};

__device__ __forceinline__ int sg_maprow(int n) {
    if (n < DM) return (n >> 7) * 256 + (n & 127);
    if (n >= 2 * DM) { const int c = n - 2 * DM; return (c >> 7) * 256 + 128 + (c & 127); }
    return 2 * DM + (n - DM);
}
__device__ __forceinline__ int swa_maprow(int n) {
    if (n >= 2304) return n;
    const int d = n & 63, half = d >> 5, dd = d & 31, j = dd >> 2, i = dd & 3;
    return (n & ~63) + 8 * j + 4 * half + i;
}
__device__ __forceinline__ void p0_transpose_item(const float* W, int N, bf16_t* WT, int mode, LAS float* scr, int item, int lane) {
    const int nblk = N / 32, kb = item / nblk, nb = item % nblk, k0 = 64 * kb, n0 = 32 * nb;
#pragma unroll 8
    for (int i = 0; i < 32; ++i) { const int kk = 2 * i + (lane >> 5); scr[kk * 33 + (lane & 31)] = W[(size_t)(k0 + kk) * N + n0 + (lane & 31)]; }
    asm volatile("s_waitcnt lgkmcnt(0)" ::: "memory");
    const int c = lane & 7;
#pragma unroll
    for (int j = 0; j < 4; ++j) { const int n = (lane >> 3) + 8 * j; const LAS float* s = scr + (8 * c) * 33 + n;
        u32x4 o; o.x = pk2(s[0 * 33], s[1 * 33]); o.y = pk2(s[2 * 33], s[3 * 33]); o.z = pk2(s[4 * 33], s[5 * 33]); o.w = pk2(s[6 * 33], s[7 * 33]);
        const int dn = mode == 1 ? swa_maprow(n0 + n) : (mode == 2 ? sg_maprow(n0 + n) : (n0 + n));
        *(u32x4*)(WT + (size_t)dn * DM + k0 + 8 * c) = o; }
    asm volatile("s_waitcnt lgkmcnt(0)" ::: "memory");
}
__device__ __forceinline__ void phase_p0(Frame& F) {
    const Params& P = *F.p; unsigned char* ws = P.ws;
    LAS float* scr = (LAS float*)(F.lds + F.wave * 16384);
    const int lane = F.lane;
    constexpr int I_SGIN = 32 * (N_SG / 32), I_OUT = 32 * (DM / 32), I_SWAIN = 32 * (N_SWA / 32), I_RWIN = 32 * (N_RW / 32);
    constexpr int NITEMS = 2 * I_SGIN + 2 * I_OUT + I_SWAIN + I_OUT + I_RWIN + I_OUT;
#ifndef P0REP
#define P0REP 1
#endif
    _Pragma("unroll 1") for (int rep_ = 0; rep_ < P0REP; ++rep_)
    for (int it = F.gw; it < NITEMS; it += F.NGW) {
        int r = it;
        if (r < I_SGIN) { p0_transpose_item(P.in[7], N_SG, (bf16_t*)(ws + W_SGIN0), 2, scr, r, lane); continue; } r -= I_SGIN;
        if (r < I_SGIN) { p0_transpose_item(P.in[7] + (size_t)DM * N_SG, N_SG, (bf16_t*)(ws + W_SGIN1), 2, scr, r, lane); continue; } r -= I_SGIN;
        if (r < I_OUT) { p0_transpose_item(P.in[8], DM, (bf16_t*)(ws + W_SGOUT0), 0, scr, r, lane); continue; } r -= I_OUT;
        if (r < I_OUT) { p0_transpose_item(P.in[8] + (size_t)DM * DM, DM, (bf16_t*)(ws + W_SGOUT1), 0, scr, r, lane); continue; } r -= I_OUT;
        if (r < I_SWAIN) { p0_transpose_item(P.in[13], N_SWA, (bf16_t*)(ws + W_SWAIN), 1, scr, r, lane); continue; } r -= I_SWAIN;
        if (r < I_OUT) { p0_transpose_item(P.in[14], DM, (bf16_t*)(ws + W_SWAOUT), 0, scr, r, lane); continue; } r -= I_OUT;
        if (r < I_RWIN) { p0_transpose_item(P.in[16], N_RW, (bf16_t*)(ws + W_RWIN), 0, scr, r, lane); continue; } r -= I_RWIN;
        p0_transpose_item(P.in[17], DM, (bf16_t*)(ws + W_RWOUT), 0, scr, r, lane);
    }
    { u32x4* z = (u32x4*)(ws + W_RWIN + (size_t)N_RW * DM * 2); const int n16 = (N_RWP - N_RW) * DM * 2 / 16;
      for (int i = blockIdx.x * NTHREADS + F.tid; i < n16; i += gridDim.x * NTHREADS) z[i] = (u32x4){0u, 0u, 0u, 0u}; }
    { float* macc = (float*)(ws + WS_CTL); const float* cin = P.in[1]; const float* mw = P.in[4];
      for (int task = F.gw; task < 4 * 24 * 64; task += F.NGW) {
          const int i = task / 1536, rem = task % 1536, cgp = rem / 64, ks = rem % 64, n0 = cgp * 256 + lane * 4, k0 = ks * 32;
          const float c0v = siluf_(cin[k0 + (lane & 31)]), c1v = siluf_(cin[DM + k0 + (lane & 31)]);
          f32x4 a0 = {0.f, 0.f, 0.f, 0.f}, a1 = a0;
          const float* wp = mw + ((size_t)i * DM + k0) * N_SG + n0;
#pragma unroll 8
          for (int kk = 0; kk < 32; ++kk) {
              const f32x4 w = *(const f32x4*)(wp + (size_t)kk * N_SG);
              const float s0 = __builtin_bit_cast(float, __builtin_amdgcn_readlane(__builtin_bit_cast(int, c0v), kk));
              const float s1 = __builtin_bit_cast(float, __builtin_amdgcn_readlane(__builtin_bit_cast(int, c1v), kk));
              a0 += w * s0; a1 += w * s1;
          }
          float* d0 = macc + ((size_t)i * 2 + 0) * N_SG + n0; float* d1 = macc + ((size_t)i * 2 + 1) * N_SG + n0;
#pragma unroll
          for (int e = 0; e < 4; ++e) { atomicAdd(d0 + e, a0[e]); atomicAdd(d1 + e, a1[e]); }
      } }
    { bf16_t* LWH = (bf16_t*)(ws + WS_LORA); bf16_t* LWL = LWH + 2048 * 96; bf16_t* LA = LWL + 2048 * 96; const float* wl = P.in[20]; const float* al = P.in[22];
      for (int idx = blockIdx.x * NTHREADS + F.tid; idx < 96 * DM; idx += gridDim.x * NTHREADS) {
          const int k = idx >> 11, c = idx & (DM - 1); const float w = wl[idx]; const unsigned hi = f2bf(w);
          LWH[c * 96 + k] = (bf16_t)hi; LWL[c * 96 + k] = (bf16_t)f2bf(w - __builtin_bit_cast(float, hi << 16)); LA[c * 96 + k] = (bf16_t)f2bf(al[idx]);
      } }
    { f32x2* tab = (f32x2*)(ws + WS_ROPE); const int* pos = (const int*)P.in[2];
      for (int idx = blockIdx.x * NTHREADS + F.tid; idx < M * 32; idx += gridDim.x * NTHREADS) {
          const int m = idx >> 5, f = idx & 31;
          const float ang = (float)pos[m] * ROPE_INVF[f];
          double rev = (double)ang * 0.15915494309189535; rev -= __builtin_rint(rev);
          const float rf = (float)rev;
          tab[idx] = (f32x2){__builtin_amdgcn_cosf(rf), __builtin_amdgcn_sinf(rf)};
      } }
}

__device__ __forceinline__ void phase_norm(Frame& F, const float* xin, int layer, bf16_t* XN) {
    const Params& P = *F.p; const float* macc = (const float*)(P.ws + WS_CTL); const float* mb = P.in[5] + (size_t)layer * N_SG; const float* g = P.in[3] + (size_t)layer * DM;
    for (int row = F.gw; row < M; row += F.NGW) {
        const int b = row >> 12; const float* ma = macc + ((size_t)layer * 2 + b) * N_SG;
        const f32x4* xr = (const f32x4*)(xin + (size_t)row * DM) + F.lane;
        f32x4 v[8]; float ss = 0.f;
#pragma unroll
        for (int j = 0; j < 8; ++j) { v[j] = xr[64 * j]; ss += (v[j].x * v[j].x + v[j].y * v[j].y) + (v[j].z * v[j].z + v[j].w * v[j].w); }
        const float rstd = rsqrtf(wave_sum(ss) * (1.0f / DM) + 1e-6f);
#pragma unroll
        for (int j = 0; j < 8; ++j) {
            const int c = 256 * j + 4 * F.lane;
            const f32x4 g4 = *(const f32x4*)(g + c);
            const f32x4 sh = *(const f32x4*)(ma + c) + *(const f32x4*)(mb + c);
            const f32x4 sc = *(const f32x4*)(ma + DM + c) + *(const f32x4*)(mb + DM + c);
            const f32x4 h = v[j] * rstd * g4 * (sc + 1.0f) + sh;
            u32x2 w; w.x = pk2(h.x, h.y); w.y = pk2(h.z, h.w);
            *(u32x2*)(XN + (size_t)row * DM + c) = w;
        }
    }
}
__device__ __forceinline__ void phase_bias(Frame& F) {
    const Params& P = *F.p; const float* macc = (const float*)(P.ws + WS_CTL); float* bias = (float*)(P.ws + WS_BIAS);
#pragma unroll 1
    for (int l = 1; l < 4; ++l) {
        const bf16_t* Wt = (const bf16_t*)(P.ws + (l == 1 ? W_SWAIN : (l == 2 ? W_RWIN : W_SGIN1))); const int N = l == 1 ? N_SWA : (l == 2 ? N_RWP : N_SG);
        f32x4 sh[2][4][2];
#pragma unroll
        for (int b = 0; b < 2; ++b)
#pragma unroll
            for (int j = 0; j < 4; ++j)
#pragma unroll
                for (int h = 0; h < 2; ++h) { const int k = 8 * F.lane + 512 * j + 4 * h; sh[b][j][h] = *(const f32x4*)(macc + ((size_t)l * 2 + b) * N_SG + k) + *(const f32x4*)(P.in[5] + (size_t)l * N_SG + k); }
        for (int n = F.gw; n < N; n += F.NGW) {
            float s0 = 0.f, s1 = 0.f;
#pragma unroll
            for (int j = 0; j < 4; ++j) {
                float w[8]; unpack8(*(const u32x4*)(Wt + (size_t)n * DM + 8 * F.lane + 512 * j), w);
#pragma unroll
                for (int e = 0; e < 8; ++e) { s0 += w[e] * sh[0][j][e >> 2][e & 3]; s1 += w[e] * sh[1][j][e >> 2][e & 3]; }
            }
            s0 = wave_sum(s0); s1 = wave_sum(s1);
            if (F.lane == 0) { bias[((size_t)(l - 1) * 2 + 0) * N_RWP + n] = s0; bias[((size_t)(l - 1) * 2 + 1) * N_RWP + n] = s1; }
        }
    }
}
__device__ __forceinline__ void phase_final(Frame& F, const float* xin) {
    const Params& P = *F.p; const float* g = P.in[6];
    for (int row = F.gw; row < M; row += F.NGW) {
        const f32x4* xr = (const f32x4*)(xin + (size_t)row * DM) + F.lane;
        f32x4 v[8]; float ss = 0.f;
#pragma unroll
        for (int j = 0; j < 8; ++j) { v[j] = xr[64 * j]; ss += (v[j].x * v[j].x + v[j].y * v[j].y) + (v[j].z * v[j].z + v[j].w * v[j].w); }
        const float rstd = rsqrtf(wave_sum(ss) * (1.0f / DM) + 1e-6f);
        f32x4* o = (f32x4*)(P.out + (size_t)row * DM) + F.lane;
#pragma unroll
        for (int j = 0; j < 8; ++j) { const f32x4 g4 = *(const f32x4*)(g + 256 * j + 4 * F.lane); o[64 * j] = v[j] * rstd * g4; }
    }
}

__device__ __forceinline__ void phase_sgmix(Frame& F, int j, const bf16_t* UZ, const bf16_t* GV, const float* stats, bf16_t* A2) {
    const Params& P = *F.p;
    const float* ln_g = P.in[9] + (size_t)j * DM; const float* ln_b = P.in[10] + (size_t)j * DM;
    const float* wsp = P.in[11] + (size_t)j * 16 * 128 * 128; const float* bsp = P.in[12] + (size_t)j * 16 * 128;
    LAS bf16_t* VT = (LAS bf16_t*)F.lds;
    LAS f32x2* rowstat = (LAS f32x2*)(F.lds + 128 * 136 * 2);
    const int tid = F.tid, lane = F.lane, w = F.wave, gq = lane >> 4, rho = lane & 15;
    for (int item = blockIdx.x; item < 1024; item += gridDim.x) {
        const int g = item & 15, chunk = item >> 4, t0 = chunk * 128, c0 = g * 128;
        const int t = 16 * w + rho, nks = (w >> 1) + 1;
        u32x4 raw[4];
#pragma unroll
        for (int jj = 0; jj < 4; ++jj) { const int q_ = tid + 512 * jj; raw[jj] = *(const u32x4*)(GV + (size_t)(t0 + (q_ >> 4)) * DM + c0 + (q_ & 15) * 8); }
        f32x4 wa[4], wb[4];
#pragma unroll
        for (int ks = 0; ks < 4; ++ks) {
            wa[ks] = (f32x4){0.f, 0.f, 0.f, 0.f}; wb[ks] = wa[ks];
            if (ks < nks) { const float* wp = wsp + ((size_t)(g * 128 + t)) * 128 + 32 * ks + 8 * gq; wa[ks] = *(const f32x4*)wp; wb[ks] = *(const f32x4*)(wp + 4); }
        }
        const float bias = bsp[g * 128 + t]; const size_t rowoff = (size_t)(t0 + t) * DM + c0;
        u32x4 ur[4];
#pragma unroll
        for (int ntp = 0; ntp < 4; ++ntp) ur[ntp] = *(const u32x4*)(UZ + rowoff + 32 * ntp + 8 * gq);
        float s_ = 0.f, q2_ = 0.f;
        if (tid < 128) {
            const f32x2* sp = (const f32x2*)(stats + (size_t)(t0 + tid) * 64);
#pragma unroll 8
            for (int p = 0; p < 32; ++p) { const f32x2 v = sp[p]; s_ += v.x; q2_ += v.y; }
        }
        __syncthreads();
        if (tid < 128) {
            const float mean = s_ * (1.0f / DM), var = q2_ * (1.0f / DM) - mean * mean;
            rowstat[tid] = (f32x2){mean, rsqrtf(var + 1e-5f)};
        }
        __syncthreads();
#pragma unroll
        for (int jj = 0; jj < 4; ++jj) {
            const int q_ = tid + 512 * jj, s = q_ >> 4, cc = (q_ & 15) * 8;
            const f32x2 st = rowstat[s];
            float v[8]; unpack8(raw[jj], v);
            const f32x4 g0 = *(const f32x4*)(ln_g + c0 + cc), g1 = *(const f32x4*)(ln_g + c0 + cc + 4);
            const f32x4 b0 = *(const f32x4*)(ln_b + c0 + cc), b1 = *(const f32x4*)(ln_b + c0 + cc + 4);
#pragma unroll
            for (int e = 0; e < 8; ++e) {
                const float gg = e < 4 ? g0[e & 3] : g1[e & 3], bb = e < 4 ? b0[e & 3] : b1[e & 3];
                VT[(cc + e) * 136 + (s ^ (cc & 120))] = (bf16_t)f2bf((v[e] - st.x) * st.y * gg + bb);
            }
        }
        __syncthreads();
        bf16x8 yf[4];
#pragma unroll
        for (int ks = 0; ks < 4; ++ks) {
            const int s0 = 32 * ks + 8 * gq; float v[8];
#pragma unroll
            for (int e = 0; e < 4; ++e) { v[e] = (s0 + e <= t) ? wa[ks][e] : 0.f; v[4 + e] = (s0 + 4 + e <= t) ? wb[ks][e] : 0.f; }
            const u32x4 pk = pack8(v); yf[ks] = __builtin_bit_cast(bf16x8, pk);
        }
        f32x4 acc[4][2];
#pragma unroll
        for (int ntp = 0; ntp < 4; ++ntp)
#pragma unroll
            for (int n = 0; n < 2; ++n) {
                acc[ntp][n] = (f32x4){0.f, 0.f, 0.f, 0.f};
                const int c = 32 * ntp + 8 * (rho >> 2) + 4 * n + (rho & 3);
#pragma unroll
                for (int ks = 0; ks < 4; ++ks)
                    if (ks < nks) {
                        const bf16x8 xf = *(const LAS bf16x8*)(VT + c * 136 + ((32 * ks + 8 * gq) ^ (c & 120)));
                        acc[ntp][n] = __builtin_amdgcn_mfma_f32_16x16x32_bf16(xf, yf[ks], acc[ntp][n], 0, 0, 0);
                    }
            }
#pragma unroll
        for (int ntp = 0; ntp < 4; ++ntp) {
            const int c = 32 * ntp + 8 * gq;
            float uf[8], o[8]; unpack8(ur[ntp], uf);
#pragma unroll
            for (int e = 0; e < 8; ++e) { const float f = (e < 4 ? acc[ntp][0][e & 3] : acc[ntp][1][e & 3]) + bias; o[e] = uf[e] * f; }
            *(u32x4*)(A2 + rowoff + c) = pack8(o);
        }
    }
}

__device__ __forceinline__ void phase_attn(Frame& F, const bf16_t* Qb, const bf16_t* Kb, const bf16_t* Vb, const bf16_t* Zb, bf16_t* A2) {
    const Params& P = *F.p; const float* sinks = P.in[15];
    LAS bf16_t* KS = (LAS bf16_t*)F.lds;
    LAS bf16_t* VT = (LAS bf16_t*)(F.lds + 36864);
    LAS bf16_t* PS = (LAS bf16_t*)(F.lds + 72704 + F.wave * 5376);
    const int tid = F.tid, lane = F.lane, w = F.wave, gq = lane >> 4, rho = lane & 15;
    for (int item = blockIdx.x; item < 256; item += gridDim.x) {
        const int g = item & 3, nb = (item >> 2) & 31, b = item >> 7;
        const int tq0 = b * SEQ + nb * 128;
        __syncthreads();
#pragma unroll
        for (int jj = 0; jj < 4; ++jj) {
            const int q_ = tid + 512 * jj, key = q_ >> 3, ch = q_ & 7; const bool valid = (nb > 0) || (key >= 128);
            const size_t go = (size_t)(tq0 - 128 + key) * 256 + g * 64 + ch * 8;
            u32x4 kv = {0u, 0u, 0u, 0u}, vv = kv;
            if (valid) { kv = *(const u32x4*)(Kb + go); vv = *(const u32x4*)(Vb + go); }
            *(LAS u32x4*)(KS + key * 72 + ch * 8) = kv;
            const unsigned ww[4] = {vv.x, vv.y, vv.z, vv.w};
#pragma unroll
            for (int e = 0; e < 4; ++e) { VT[(ch * 8 + 2 * e) * 280 + key] = (bf16_t)(ww[e] & 0xffffu); VT[(ch * 8 + 2 * e + 1) * 280 + key] = (bf16_t)(ww[e] >> 16); }
        }
        if (tid < 192) { const int row = tid / 3, part = tid % 3; *(LAS u32x4*)(VT + row * 280 + 256 + part * 8) = (u32x4){0u, 0u, 0u, 0u}; }
        __syncthreads();
        const bf16_t* qbase = Qb + (size_t)(tq0 + 16 * w + rho) * DM + g * 512 + 8 * gq;
        const size_t zbase = (size_t)(tq0 + 16 * w + rho) * DM + g * 512 + 4 * gq;
        bf16x8 qn0 = *(const bf16x8*)qbase, qn1 = *(const bf16x8*)(qbase + 32);
        u32x2 zn[4];
#pragma unroll
        for (int dt = 0; dt < 4; ++dt) zn[dt] = *(const u32x2*)(Zb + zbase + 16 * dt);
        for (int r = 0; r < 8; ++r) {
            const int hq = g * 8 + r; const float sink = sinks[hq];
            const bf16x8 qf0 = qn0, qf1 = qn1;
            u32x2 zc[4];
#pragma unroll
            for (int dt = 0; dt < 4; ++dt) zc[dt] = zn[dt];
            if (r < 7) {
                qn0 = *(const bf16x8*)(qbase + 64 * (r + 1)); qn1 = *(const bf16x8*)(qbase + 64 * (r + 1) + 32);
#pragma unroll
                for (int dt = 0; dt < 4; ++dt) zn[dt] = *(const u32x2*)(Zb + zbase + 64 * (r + 1) + 16 * dt);
            }
            f32x4 sc[9];
#pragma unroll
            for (int jt = 0; jt < 9; ++jt) {
                const int kt = w + jt; const LAS bf16_t* kp = KS + (16 * kt + rho) * 72 + 8 * gq;
                const bf16x8 k0 = *(const LAS bf16x8*)kp, k1 = *(const LAS bf16x8*)(kp + 32);
                f32x4 a = {0.f, 0.f, 0.f, 0.f};
                a = __builtin_amdgcn_mfma_f32_16x16x32_bf16(qf0, k0, a, 0, 0, 0);
                a = __builtin_amdgcn_mfma_f32_16x16x32_bf16(qf1, k1, a, 0, 0, 0);
                const int kj = 16 * kt + rho;
#pragma unroll
                for (int i = 0; i < 4; ++i) { const int rel = 16 * w + 4 * gq + i + 128 - kj; const bool ok = (rel >= 0) && (rel < 128) && ((nb > 0) || (kj >= 128)); sc[jt][i] = ok ? a[i] * 0.125f : -INFINITY; }
            }
#pragma unroll
            for (int i = 0; i < 4; ++i) {
                float mx = sc[0][i];
#pragma unroll
                for (int jt = 1; jt < 9; ++jt) mx = fmaxf(mx, sc[jt][i]);
                mx = fmaxf(mx, __shfl_xor(mx, 1)); mx = fmaxf(mx, __shfl_xor(mx, 2)); mx = fmaxf(mx, __shfl_xor(mx, 4)); mx = fmaxf(mx, __shfl_xor(mx, 8));
                const float mm = fmaxf(mx, sink); float sum = 0.f;
#pragma unroll
                for (int jt = 0; jt < 9; ++jt) { const float e = __expf(sc[jt][i] - mm); sc[jt][i] = e; sum += e; }
                sum += __shfl_xor(sum, 1); sum += __shfl_xor(sum, 2); sum += __shfl_xor(sum, 4); sum += __shfl_xor(sum, 8);
                const float inv = frcp(sum + __expf(sink - mm));
#pragma unroll
                for (int jt = 0; jt < 9; ++jt) PS[(4 * gq + i) * 168 + 16 * jt + rho] = (bf16_t)f2bf(sc[jt][i] * inv);
                PS[(4 * gq + i) * 168 + 144 + rho] = 0;
            }
            asm volatile("s_waitcnt lgkmcnt(0)" ::: "memory");
            f32x4 o[4];
#pragma unroll
            for (int dt = 0; dt < 4; ++dt) o[dt] = (f32x4){0.f, 0.f, 0.f, 0.f};
#pragma unroll
            for (int ks = 0; ks < 5; ++ks) {
                const bf16x8 pf = *(const LAS bf16x8*)(PS + rho * 168 + 32 * ks + 8 * gq);
#pragma unroll
                for (int dt = 0; dt < 4; ++dt) {
                    const bf16x8 vf = *(const LAS bf16x8*)(VT + (16 * dt + rho) * 280 + 16 * w + 32 * ks + 8 * gq);
                    o[dt] = __builtin_amdgcn_mfma_f32_16x16x32_bf16(vf, pf, o[dt], 0, 0, 0);
                }
            }
            asm volatile("s_waitcnt lgkmcnt(0)" ::: "memory");
#pragma unroll
            for (int dt = 0; dt < 4; ++dt) {
                const size_t off = (size_t)(tq0 + 16 * w + rho) * DM + hq * 64 + 16 * dt + 4 * gq;
                const u32x2 zr = zc[dt];
                u32x2 pk; pk.x = pk2(o[dt][0] * bflo(zr.x), o[dt][1] * bfhi(zr.x)); pk.y = pk2(o[dt][2] * bflo(zr.y), o[dt][3] * bfhi(zr.y));
                *(u32x2*)(A2 + off) = pk;
            }
        }
    }
}

struct RwBufs { bf16_t *R, *K, *V, *KK, *B, *ZS; float *W, *bonus, *Y, *Pc, *Qc, *Sst; };
__device__ __forceinline__ RwBufs rw_bufs(unsigned char* ws) {
    RwBufs r; unsigned char* b = ws + WS_RW;
    r.R = (bf16_t*)b; r.K = (bf16_t*)(b + 32 * MiB); r.V = (bf16_t*)(b + 64 * MiB); r.KK = (bf16_t*)(b + 96 * MiB); r.B = (bf16_t*)(b + 128 * MiB);
    r.W = (float*)(b + 160 * MiB); r.ZS = (bf16_t*)(b + 224 * MiB); r.bonus = (float*)(ws + WS_BONUS);
    r.Y = (float*)(ws + WS_P); r.Pc = (float*)(ws + WS_P + 64 * MiB); r.Qc = (float*)(ws + WS_P + 96 * MiB); r.Sst = (float*)(ws + WS_XN);
    return r;
}
__device__ __forceinline__ void lerp8(const u32x4 cu4, const u32x4 pr4, const LAS float* m, float (&o)[8]) {
    float cu[8], pr[8]; unpack8(cu4, cu); unpack8(pr4, pr);
    const f32x4 m0 = *(const LAS f32x4*)m, m1 = *(const LAS f32x4*)(m + 4);
#pragma unroll
    for (int e = 0; e < 8; ++e) o[e] = cu[e] + (pr[e] - cu[e]) * (e < 4 ? m0[e & 3] : m1[e & 3]);
}
__device__ __forceinline__ void phase_rwprep(Frame& F, const bf16_t* Pb) {
    const Params& P = *F.p; const RwBufs rb = rw_bufs(P.ws);
    const float* mu = P.in[18];
    LAS bf16_t* YWH = (LAS bf16_t*)F.lds; LAS bf16_t* YWL = YWH + 32 * 104; LAS bf16_t* YA = YWL + 32 * 104;
    LAS float* PRM = (LAS float*)(F.lds + 20480);
    const bf16_t* LWH = (const bf16_t*)(P.ws + WS_LORA); const bf16_t* LWL = LWH + 2048 * 96; const bf16_t* LA = LWL + 2048 * 96;
    const int tid = F.tid, lane = F.lane, gq = lane >> 4, rho = lane & 15;
    int cur_hg = -1;
    for (int item = blockIdx.x; item < 1024; item += gridDim.x) {
        const int tt = item >> 2, hg = item & 3, t0 = tt * 32, head = hg * 8 + F.wave;
        __syncthreads();
        if (hg != cur_hg) {
            cur_hg = hg;
#pragma unroll
            for (int v = 0; v < 9; ++v) {
                const float* srcp = v < 4 ? mu + v * DM : P.in[v == 4 ? 19 : (v == 5 ? 21 : (v == 6 ? 23 : (v == 7 ? 24 : 25)))];
                PRM[v * 512 + tid] = srcp[hg * 512 + tid];
            }
        }
#pragma unroll
        for (int jj = 0; jj < 2; ++jj) {
            const int q_ = tid + 512 * jj;
            if (q_ < 768) {
                const int tok = q_ / 24, ch = q_ % 24, row = t0 + tok, col = 4 * DM + ch * 8;
                const u32x4 c4 = *(const u32x4*)(Pb + (size_t)row * N_RWP + col);
                u32x4 p4 = {0u, 0u, 0u, 0u};
                if (row & (SEQ - 1)) p4 = *(const u32x4*)(Pb + (size_t)(row - 1) * N_RWP + col);
                const f32x4 m0 = *(const f32x4*)(mu + col), m1 = *(const f32x4*)(mu + col + 4);
                float cu[8], pr[8], hi[8], lo[8]; unpack8(c4, cu); unpack8(p4, pr);
#pragma unroll
                for (int x = 0; x < 8; ++x) cu[x] = cu[x] + (pr[x] - cu[x]) * (x < 4 ? m0[x & 3] : m1[x & 3]);
                if (ch < 12) {
#pragma unroll
                    for (int x = 0; x < 8; ++x) { const float th = tanhf_(cu[x]); const unsigned h = f2bf(th); hi[x] = __builtin_bit_cast(float, h << 16); lo[x] = th - hi[x]; }
                    *(LAS u32x4*)(YWH + tok * 104 + ch * 8) = pack8(hi); *(LAS u32x4*)(YWL + tok * 104 + ch * 8) = pack8(lo);
                } else *(LAS u32x4*)(YA + tok * 104 + (ch - 12) * 8) = pack8(cu);
            }
        }
        __syncthreads();
        const int cb = head * 64 + 8 * (rho >> 2) + (rho & 3);
        float carry[2][8];
#pragma unroll
        for (int ntp = 0; ntp < 2; ++ntp)
#pragma unroll
            for (int e = 0; e < 8; ++e) carry[ntp][e] = 0.f;
#pragma unroll 1
        for (int mt = 0; mt < 2; ++mt) {
            const int row = t0 + 16 * mt + rho, t = row & (SEQ - 1), bh = (row >> 12) * 32 + head; const bool first = (t == 0);
            const size_t obase = ((size_t)bh * SEQ + t) * 64;
            const bf16_t* prow = Pb + (size_t)row * N_RWP + head * 64 + 8 * gq; const bf16_t* pprev = first ? prow : prow - N_RWP;
            const u32x4 kc0 = *(const u32x4*)(prow + DM), kc1 = *(const u32x4*)(prow + DM + 32);
            u32x4 kp0 = *(const u32x4*)(pprev + DM), kp1 = *(const u32x4*)(pprev + DM + 32);
            if (first) { kp0 = (u32x4){0u, 0u, 0u, 0u}; kp1 = kp0; }
            const u32x4 rc0 = *(const u32x4*)(prow), vc0 = *(const u32x4*)(prow + 2 * DM), zc0 = *(const u32x4*)(prow + 3 * DM);
            u32x4 rp0 = *(const u32x4*)(pprev), vp0 = *(const u32x4*)(pprev + 2 * DM), zp0 = *(const u32x4*)(pprev + 3 * DM);
            if (first) { rp0 = (u32x4){0u, 0u, 0u, 0u}; vp0 = rp0; zp0 = rp0; }
            f32x4 aw[2][2], aa[2][2];
            const int yo = (16 * mt + rho) * 104 + 8 * gq;
#pragma unroll
            for (int ntp = 0; ntp < 2; ++ntp)
#pragma unroll
                for (int n = 0; n < 2; ++n) {
                    aw[ntp][n] = (f32x4){0.f, 0.f, 0.f, 0.f}; aa[ntp][n] = aw[ntp][n];
                    const size_t xo = (size_t)(cb + 32 * ntp + 4 * n) * 96 + 8 * gq;
#pragma unroll
                    for (int k3 = 0; k3 < 3; ++k3) {
                        const bf16x8 xh = *(const bf16x8*)(LWH + xo + 32 * k3), xl = *(const bf16x8*)(LWL + xo + 32 * k3), xa = *(const bf16x8*)(LA + xo + 32 * k3);
                        const bf16x8 ywh = *(const LAS bf16x8*)(YWH + yo + 32 * k3), ywl = *(const LAS bf16x8*)(YWL + yo + 32 * k3), ya = *(const LAS bf16x8*)(YA + yo + 32 * k3);
                        aw[ntp][n] = __builtin_amdgcn_mfma_f32_16x16x32_bf16(xh, ywh, aw[ntp][n], 0, 0, 0);
                        aw[ntp][n] = __builtin_amdgcn_mfma_f32_16x16x32_bf16(xh, ywl, aw[ntp][n], 0, 0, 0);
                        aw[ntp][n] = __builtin_amdgcn_mfma_f32_16x16x32_bf16(xl, ywh, aw[ntp][n], 0, 0, 0);
                        aa[ntp][n] = __builtin_amdgcn_mfma_f32_16x16x32_bf16(xa, ya, aa[ntp][n], 0, 0, 0);
                    }
                    asm volatile("" ::: "memory");
                }
            const LAS float* prm = PRM + F.wave * 64 + 8 * gq;
            float kl[2][8]; float kkss = 0.f, bon = 0.f;
            lerp8(kc0, kp0, prm + 512, kl[0]); lerp8(kc1, kp1, prm + 512 + 32, kl[1]);
#pragma unroll
            for (int ntp = 0; ntp < 2; ++ntp) {
                const f32x4 q0 = *(const LAS f32x4*)(prm + 6 * 512 + 32 * ntp), q1 = *(const LAS f32x4*)(prm + 6 * 512 + 32 * ntp + 4);
#pragma unroll
                for (int e = 0; e < 8; ++e) { const float l = kl[ntp][e] * (e < 4 ? q0[e & 3] : q1[e & 3]); kkss += l * l; }
            }
            kkss += __shfl_xor(kkss, 16); kkss += __shfl_xor(kkss, 32);
            const float inv = 1.0f / fmaxf(sqrtf(kkss), 1e-12f);
#pragma unroll
            for (int ntp = 0; ntp < 2; ++ntp) {
                const int cl = 32 * ntp + 8 * gq;
                const f32x4 aa0 = aa[ntp][0], aa1 = aa[ntp][1];
                const LAS float* pq = prm + 32 * ntp;
                u32x4 rcx = rc0, vcx = vc0, zcx = zc0, rpx = rp0, vpx = vp0, zpx = zp0;
                if (ntp == 1) {
                    rcx = *(const u32x4*)(prow + 32); vcx = *(const u32x4*)(prow + 2 * DM + 32); zcx = *(const u32x4*)(prow + 3 * DM + 32);
                    rpx = *(const u32x4*)(pprev + 32); vpx = *(const u32x4*)(pprev + 2 * DM + 32); zpx = *(const u32x4*)(pprev + 3 * DM + 32);
                    if (first) { vpx = (u32x4){0u, 0u, 0u, 0u}; zpx = vpx; rpx = vpx; }
                }
                float lwv[8], G[8];
                { const f32x4 w0a = *(const LAS f32x4*)(pq + 4 * 512), w0b = *(const LAS f32x4*)(pq + 4 * 512 + 4);
#pragma unroll
                  for (int e = 0; e < 8; ++e) {
                    const float lw = (e < 4 ? aw[ntp][0][e & 3] + w0a[e & 3] : aw[ntp][1][e & 3] + w0b[e & 3]);
                    const float l = -DECAY_SCALE * sigmoidf_(lw); lwv[e] = l;
                    float x = l;
                    x += __builtin_bit_cast(float, __builtin_amdgcn_update_dpp(0, __builtin_bit_cast(int, x), 0x111, 0xF, 0xF, true));
                    x += __builtin_bit_cast(float, __builtin_amdgcn_update_dpp(0, __builtin_bit_cast(int, x), 0x112, 0xF, 0xF, true));
                    x += __builtin_bit_cast(float, __builtin_amdgcn_update_dpp(0, __builtin_bit_cast(int, x), 0x114, 0xF, 0xF, true));
                    x += __builtin_bit_cast(float, __builtin_amdgcn_update_dpp(0, __builtin_bit_cast(int, x), 0x118, 0xF, 0xF, true));
                    x += carry[ntp][e]; G[e] = x;
                    carry[ntp][e] = __shfl(x, (lane & 48) | 15);
                  } }
                float rl[8], vl[8], zl[8];
                lerp8(rcx, rpx, pq, rl); lerp8(vcx, vpx, pq + 2 * 512, vl); lerp8(zcx, zpx, pq + 3 * 512, zl);
#pragma unroll
                for (int e = 0; e < 8; ++e) zl[e] = siluf_(zl[e]);
                *(u32x4*)(rb.V + obase + cl) = pack8(vl);
                *(u32x4*)(rb.ZS + obase + cl) = pack8(zl);
                const f32x4 a0a = *(const LAS f32x4*)(pq + 5 * 512), a0b = *(const LAS f32x4*)(pq + 5 * 512 + 4);
                const f32x4 kka = *(const LAS f32x4*)(pq + 6 * 512), kkb = *(const LAS f32x4*)(pq + 6 * 512 + 4), kaa = *(const LAS f32x4*)(pq + 7 * 512), kab = *(const LAS f32x4*)(pq + 7 * 512 + 4);
                const f32x4 rka = *(const LAS f32x4*)(pq + 8 * 512), rkb = *(const LAS f32x4*)(pq + 8 * 512 + 4);
                float eg[8], rs[8], ks_[8], kkn[8], bbn[8];
#pragma unroll
                for (int e = 0; e < 8; ++e) {
                    const float la = (e < 4 ? aa0[e & 3] + a0a[e & 3] : aa1[e & 3] + a0b[e & 3]);
                    const float a = sigmoidf_(la);
                    const float g = G[e]; eg[e] = __expf(g); const float egn = __expf(-g), egp = __expf(g - lwv[e]);
                    const float kx = kl[ntp][e];
                    const float kk = kx * (e < 4 ? kka[e & 3] : kkb[e & 3]) * inv;
                    kkn[e] = kk * egp; bbn[e] = kk * a * egn;
                    const float kmod = kx * (1.0f + (a - 1.0f) * (e < 4 ? kaa[e & 3] : kab[e & 3]));
                    bon += rl[e] * kmod * (e < 4 ? rka[e & 3] : rkb[e & 3]);
                    ks_[e] = kmod * egn; rs[e] = rl[e] * eg[e];
                }
                *(u32x4*)(rb.KK + obase + cl) = pack8(kkn);
                *(u32x4*)(rb.B + obase + cl) = pack8(bbn);
                *(u32x4*)(rb.K + obase + cl) = pack8(ks_);
                *(u32x4*)(rb.R + obase + cl) = pack8(rs);
                if ((t & 31) == 31) {
                    float* gp = rb.W + ((size_t)bh * (SEQ / 32) + (t >> 5)) * 64 + cl;
                    *(f32x4*)gp = (f32x4){eg[0], eg[1], eg[2], eg[3]}; *(f32x4*)(gp + 4) = (f32x4){eg[4], eg[5], eg[6], eg[7]};
                }
            }
            bon += __shfl_xor(bon, 16); bon += __shfl_xor(bon, 32);
            if (gq == 0) rb.bonus[(size_t)bh * SEQ + t] = bon;
        }
    }
}

__device__ __forceinline__ float dpp_xor1(float v) { return __builtin_bit_cast(float, __builtin_amdgcn_mov_dpp(__builtin_bit_cast(int, v), 0xB1, 0xF, 0xF, true)); }
__device__ __forceinline__ float dpp_xor2(float v) { return __builtin_bit_cast(float, __builtin_amdgcn_mov_dpp(__builtin_bit_cast(int, v), 0x4E, 0xF, 0xF, true)); }

template <int MODE>
__device__ __forceinline__ void scan_task(LAS float* L, int lane, int bh, int chunk, const RwBufs& rb, const float* gn_g = nullptr, const float* gn_b = nullptr, bf16_t* A2 = nullptr) {
    const int rg = lane >> 2, ks = lane & 3;
    f32x2 s[4][8];
    const size_t mat = ((size_t)bh * NCH + chunk) * 4096;
#pragma unroll
    for (int j = 0; j < 4; ++j)
#pragma unroll
        for (int i = 0; i < 8; ++i) {
            if (MODE == 0) { const int v = 4 * rg + j, k = 16 * ks + 2 * i; s[j][i] = (f32x2){v == k ? 1.f : 0.f, v == k + 1 ? 1.f : 0.f}; }
            else if (MODE == 1) s[j][i] = (f32x2){0.f, 0.f};
            else s[j][i] = *(const f32x2*)(rb.Sst + mat + (4 * rg + j) * 64 + 16 * ks + 2 * i);
        }
    const size_t g0 = ((size_t)bh * SEQ + (size_t)chunk * CHL) * 64;
    const float* gam = rb.W + ((size_t)bh * (SEQ / 32) + (size_t)chunk * (CHL / 32)) * 64 + 16 * ks;
    u32x4 rkk, rbb, rk = {0u, 0u, 0u, 0u}, rr = rk, rv = rk;
    { const size_t go = g0 + lane * 8;
      rkk = *(const u32x4*)(rb.KK + go); rbb = *(const u32x4*)(rb.B + go);
      if (MODE != 0) { rk = *(const u32x4*)(rb.K + go); rv = *(const u32x4*)(rb.V + go); }
      if (MODE == 2) rr = *(const u32x4*)(rb.R + go); }
    f32x4 gm[4];
    const int sp = lane >> 3, ch = lane & 7, hh = bh & 31;
    f32x4 gg0 = {0.f, 0.f, 0.f, 0.f}, gg1 = gg0, gb0 = gg0, gb1 = gg0;
    if (MODE == 2) { gg0 = *(const f32x4*)(gn_g + hh * 64 + ch * 8); gg1 = *(const f32x4*)(gn_g + hh * 64 + ch * 8 + 4); gb0 = *(const f32x4*)(gn_b + hh * 64 + ch * 8); gb1 = *(const f32x4*)(gn_b + hh * 64 + ch * 8 + 4); }
    for (int blk = 0; blk < CHL / 8; ++blk) {
        LAS float* d = L + lane * 8;
        u32x4 zs4 = {0u, 0u, 0u, 0u}; float bon = 0.f;
        if (MODE == 2) { const size_t pr = (size_t)bh * SEQ + (size_t)chunk * CHL + blk * 8 + sp; zs4 = *(const u32x4*)(rb.ZS + pr * 64 + ch * 8); bon = rb.bonus[pr]; }
        { float f[8]; unpack8(rkk, f); *(LAS f32x4*)(d) = (f32x4){f[0], f[1], f[2], f[3]}; *(LAS f32x4*)(d + 4) = (f32x4){f[4], f[5], f[6], f[7]}; }
        { float f[8]; unpack8(rbb, f); *(LAS f32x4*)(d + 512) = (f32x4){f[0], f[1], f[2], f[3]}; *(LAS f32x4*)(d + 516) = (f32x4){f[4], f[5], f[6], f[7]}; }
        if (MODE != 0) {
            { float f[8]; unpack8(rk, f); *(LAS f32x4*)(d + 1024) = (f32x4){f[0], f[1], f[2], f[3]}; *(LAS f32x4*)(d + 1028) = (f32x4){f[4], f[5], f[6], f[7]}; }
            { float f[8]; unpack8(rv, f); *(LAS f32x4*)(d + 2048) = (f32x4){f[0], f[1], f[2], f[3]}; *(LAS f32x4*)(d + 2052) = (f32x4){f[4], f[5], f[6], f[7]}; }
        }
        if (MODE == 2) { float f[8]; unpack8(rr, f); *(LAS f32x4*)(d + 1536) = (f32x4){f[0], f[1], f[2], f[3]}; *(LAS f32x4*)(d + 1540) = (f32x4){f[4], f[5], f[6], f[7]}; }
        if (blk + 1 < CHL / 8) {
            const size_t go = g0 + (size_t)(blk + 1) * 512 + lane * 8;
            rkk = *(const u32x4*)(rb.KK + go); rbb = *(const u32x4*)(rb.B + go);
            if (MODE != 0) { rk = *(const u32x4*)(rb.K + go); rv = *(const u32x4*)(rb.V + go); }
            if (MODE == 2) rr = *(const u32x4*)(rb.R + go);
        }
        if ((blk & 3) == 0) {
            const float* gp = gam + (size_t)(blk >> 2) * 64;
            gm[0] = *(const f32x4*)gp; gm[1] = *(const f32x4*)(gp + 4); gm[2] = *(const f32x4*)(gp + 8); gm[3] = *(const f32x4*)(gp + 12);
        }
        asm volatile("s_waitcnt lgkmcnt(0)" ::: "memory");
#pragma unroll 1
        for (int st = 0; st < 8; ++st) {
            const LAS float* q = L + st * 64 + 16 * ks;
            f32x2 kk2[8], b2[8], k2[8], r2[8];
#pragma unroll
            for (int i4 = 0; i4 < 4; ++i4) {
                const f32x4 b = *(const LAS f32x4*)(q + 4 * i4); kk2[2 * i4] = (f32x2){b.x, b.y}; kk2[2 * i4 + 1] = (f32x2){b.z, b.w};
                const f32x4 c = *(const LAS f32x4*)(q + 512 + 4 * i4); b2[2 * i4] = (f32x2){c.x, c.y}; b2[2 * i4 + 1] = (f32x2){c.z, c.w};
                if (MODE != 0) { const f32x4 dd = *(const LAS f32x4*)(q + 1024 + 4 * i4); k2[2 * i4] = (f32x2){dd.x, dd.y}; k2[2 * i4 + 1] = (f32x2){dd.z, dd.w}; }
                if (MODE == 2) { const f32x4 e = *(const LAS f32x4*)(q + 1536 + 4 * i4); r2[2 * i4] = (f32x2){e.x, e.y}; r2[2 * i4 + 1] = (f32x2){e.z, e.w}; }
            }
            f32x4 vv = {0.f, 0.f, 0.f, 0.f};
            if (MODE != 0) vv = *(const LAS f32x4*)(L + 2048 + st * 64 + 4 * rg);
            float yv[4], sa[4];
#pragma unroll
            for (int j = 0; j < 4; ++j) {
                f32x2 a0 = s[j][0] * kk2[0], a1 = s[j][1] * kk2[1];
#pragma unroll
                for (int i = 2; i < 8; i += 2) { a0 += s[j][i] * kk2[i]; a1 += s[j][i + 1] * kk2[i + 1]; }
                const f32x2 a = a0 + a1; sa[j] = a.x + a.y;
            }
#pragma unroll
            for (int j = 0; j < 4; ++j) sa[j] += dpp_xor1(sa[j]);
#pragma unroll
            for (int j = 0; j < 4; ++j) sa[j] += dpp_xor2(sa[j]);
            if (MODE != 0) {
#pragma unroll
                for (int j = 0; j < 4; ++j) {
                    const f32x2 vj = (f32x2){vv[j], vv[j]};
#pragma unroll
                    for (int i = 0; i < 8; ++i) s[j][i] = __builtin_elementwise_fma(vj, k2[i], s[j][i]);
                }
            }
#pragma unroll
            for (int j = 0; j < 4; ++j) {
                const f32x2 nsa = (f32x2){-sa[j], -sa[j]};
#pragma unroll
                for (int i = 0; i < 8; ++i) s[j][i] = __builtin_elementwise_fma(nsa, b2[i], s[j][i]);
            }
            if (MODE == 2) {
#pragma unroll
                for (int j = 0; j < 4; ++j) {
                    f32x2 y0 = s[j][0] * r2[0], y1 = s[j][1] * r2[1];
#pragma unroll
                    for (int i = 2; i < 8; i += 2) { y0 += s[j][i] * r2[i]; y1 += s[j][i + 1] * r2[i + 1]; }
                    const f32x2 y = y0 + y1; yv[j] = y.x + y.y;
                }
#pragma unroll
                for (int j = 0; j < 4; ++j) yv[j] += dpp_xor1(yv[j]);
#pragma unroll
                for (int j = 0; j < 4; ++j) yv[j] += dpp_xor2(yv[j]);
            }
            if (MODE == 2) { if (ks == 0) *(LAS f32x4*)(L + 2560 + st * 64 + 4 * rg) = (f32x4){yv[0], yv[1], yv[2], yv[3]}; }
        }
        if (MODE == 2) {
            asm volatile("s_waitcnt lgkmcnt(0)" ::: "memory");
            const f32x4 y0 = *(const LAS f32x4*)(L + 2560 + sp * 64 + ch * 8), y1 = *(const LAS f32x4*)(L + 2560 + sp * 64 + ch * 8 + 4);
            const f32x4 v0 = *(const LAS f32x4*)(L + 2048 + sp * 64 + ch * 8), v1 = *(const LAS f32x4*)(L + 2048 + sp * 64 + ch * 8 + 4);
            float y[8] = {y0.x, y0.y, y0.z, y0.w, y1.x, y1.y, y1.z, y1.w};
            const float vf[8] = {v0.x, v0.y, v0.z, v0.w, v1.x, v1.y, v1.z, v1.w};
            float sm = 0.f;
#pragma unroll
            for (int e = 0; e < 8; ++e) sm += y[e];
            sm += __shfl_xor(sm, 1); sm += __shfl_xor(sm, 2); sm += __shfl_xor(sm, 4);
            const float mean = sm * (1.0f / 64.0f); float qq = 0.f;
#pragma unroll
            for (int e = 0; e < 8; ++e) { y[e] -= mean; qq += y[e] * y[e]; }
            qq += __shfl_xor(qq, 1); qq += __shfl_xor(qq, 2); qq += __shfl_xor(qq, 4);
            const float rstd = rsqrtf(qq * (1.0f / 64.0f) + 64e-5f);
            float zf[8], o[8]; unpack8(zs4, zf);
#pragma unroll
            for (int e = 0; e < 8; ++e) o[e] = (y[e] * rstd * (e < 4 ? gg0[e & 3] : gg1[e & 3]) + (e < 4 ? gb0[e & 3] : gb1[e & 3]) + bon * vf[e]) * zf[e];
            const size_t tok = (size_t)(bh >> 5) * SEQ + (size_t)chunk * CHL + blk * 8 + sp;
            *(u32x4*)(A2 + tok * DM + hh * 64 + ch * 8) = pack8(o);
        }
        if ((blk & 3) == 3) {
#pragma unroll
            for (int j = 0; j < 4; ++j)
#pragma unroll
                for (int i4 = 0; i4 < 4; ++i4) { s[j][2 * i4] *= (f32x2){gm[i4].x, gm[i4].y}; s[j][2 * i4 + 1] *= (f32x2){gm[i4].z, gm[i4].w}; }
        }
        asm volatile("s_waitcnt lgkmcnt(0)" ::: "memory");
    }
    if (MODE != 2) {
        float* dst = (MODE == 0 ? rb.Pc : rb.Qc) + mat;
#pragma unroll
        for (int j = 0; j < 4; ++j)
#pragma unroll
            for (int i = 0; i < 8; ++i) *(f32x2*)(dst + (4 * rg + j) * 64 + 16 * ks + 2 * i) = s[j][i];
    }
}
__device__ __forceinline__ void phase_scanA(Frame& F) {
    const RwBufs rb = rw_bufs(F.p->ws); LAS float* L = (LAS float*)(F.lds + F.wave * 12288);
    const int part = F.wave >> 2, npair = gridDim.x * 4;
    for (int bc = blockIdx.x * 4 + (F.wave & 3); bc < 64 * NCH; bc += npair) {
        const int bh = bc / NCH, chunk = bc % NCH;
        if (part == 0) scan_task<0>(L, F.lane, bh, chunk, rb); else scan_task<1>(L, F.lane, bh, chunk, rb);
    }
}
__device__ __forceinline__ void phase_scanC(Frame& F) {
    const RwBufs rb = rw_bufs(F.p->ws); LAS float* L = (LAS float*)(F.lds + F.wave * 12288);
    for (int task = F.gw; task < 64 * NCH; task += F.NGW) scan_task<2>(L, F.lane, task / NCH, task % NCH, rb, F.p->in[26], F.p->in[27], (bf16_t*)(F.p->ws + WS_A2));
}
__device__ __forceinline__ void phase_scanB(Frame& F) {
    const RwBufs rb = rw_bufs(F.p->ws);
    LAS float* SL = (LAS float*)F.lds;
    LAS float* PL = SL + 16 * 68;
    const int tid = F.tid, lane = F.lane, w = F.wave, g = lane >> 4, rho = lane & 15;
    for (int unit = blockIdx.x; unit < 256; unit += gridDim.x) {
        const int bh = unit >> 2, vq = unit & 3;
        f32x4 acc = {0.f, 0.f, 0.f, 0.f};
        const size_t rowoff = (size_t)(16 * vq + 4 * g) * 64 + 16 * (w & 3) + rho;
        if (w < 4) {
            float* d = rb.Sst + ((size_t)bh * NCH) * 4096 + rowoff;
#pragma unroll
            for (int i = 0; i < 4; ++i) d[64 * i] = 0.f;
        }
        f32x4 pa, pb; float qv[4];
        { const size_t mat = ((size_t)bh * NCH) * 4096;
          pa = *(const f32x4*)(rb.Pc + mat + tid * 8); pb = *(const f32x4*)(rb.Pc + mat + tid * 8 + 4);
#pragma unroll
          for (int i = 0; i < 4; ++i) qv[i] = rb.Qc[mat + rowoff + 64 * i]; }
        for (int c = 0; c < NCH - 1; ++c) {
            const size_t mat = ((size_t)bh * NCH + c) * 4096;
            __syncthreads();
            { const int r = tid >> 3, cc = (tid & 7) * 8; *(LAS f32x4*)(PL + r * 68 + cc) = pa; *(LAS f32x4*)(PL + r * 68 + cc + 4) = pb; }
            if (w < 4) {
#pragma unroll
                for (int i = 0; i < 4; ++i) SL[(4 * g + i) * 68 + 16 * w + rho] = acc[i];
            }
            f32x4 a0 = {qv[0], qv[1], qv[2], qv[3]};
            if (c + 1 < NCH - 1) {
                pa = *(const f32x4*)(rb.Pc + mat + 4096 + tid * 8); pb = *(const f32x4*)(rb.Pc + mat + 4096 + tid * 8 + 4);
#pragma unroll
                for (int i = 0; i < 4; ++i) qv[i] = rb.Qc[mat + 4096 + rowoff + 64 * i];
            }
            __syncthreads();
            if (w < 4) {
                f32x4 a1 = {0.f, 0.f, 0.f, 0.f};
#pragma unroll
                for (int ks = 0; ks < 16; ks += 2) {
                    const float s0 = SL[rho * 68 + 4 * ks + g], p0 = PL[(4 * ks + g) * 68 + 16 * w + rho];
                    const float s1 = SL[rho * 68 + 4 * ks + 4 + g], p1 = PL[(4 * ks + 4 + g) * 68 + 16 * w + rho];
                    a0 = __builtin_amdgcn_mfma_f32_16x16x4f32(s0, p0, a0, 0, 0, 0);
                    a1 = __builtin_amdgcn_mfma_f32_16x16x4f32(s1, p1, a1, 0, 0, 0);
                }
                acc = a0 + a1;
                float* d = rb.Sst + mat + 4096 + rowoff;
#pragma unroll
                for (int i = 0; i < 4; ++i) d[64 * i] = acc[i];
            }
        }
    }
}
__device__ __forceinline__ void phase_rwpost(Frame& F, bf16_t* A2) {
    const Params& P = *F.p; const RwBufs rb = rw_bufs(P.ws); const float* gn_g = P.in[26]; const float* gn_b = P.in[27];
    const int lane = F.lane, ch = lane & 7;
    for (int it = F.gw; it < 64 * SEQ / 8; it += F.NGW) {
        const int pair = it * 8 + (lane >> 3), bh = pair >> 12, t = pair & (SEQ - 1), h = bh & 31, b = bh >> 5, c = h * 64 + ch * 8;
        const size_t go = (size_t)pair * 64 + ch * 8;
        const f32x4 y0 = *(const f32x4*)(rb.Y + go), y1 = *(const f32x4*)(rb.Y + go + 4);
        float y[8] = {y0.x, y0.y, y0.z, y0.w, y1.x, y1.y, y1.z, y1.w};
        float s = 0.f;
#pragma unroll
        for (int e = 0; e < 8; ++e) s += y[e];
        s += __shfl_xor(s, 1); s += __shfl_xor(s, 2); s += __shfl_xor(s, 4);
        const float mean = s * (1.0f / 64.0f); float q = 0.f;
#pragma unroll
        for (int e = 0; e < 8; ++e) { y[e] -= mean; q += y[e] * y[e]; }
        q += __shfl_xor(q, 1); q += __shfl_xor(q, 2); q += __shfl_xor(q, 4);
        const float rstd = rsqrtf(q * (1.0f / 64.0f) + 64e-5f), bon = rb.bonus[pair];
        float vf[8], zf[8], o[8]; unpack8(*(const u32x4*)(rb.V + go), vf); unpack8(*(const u32x4*)(rb.ZS + go), zf);
        const f32x4 g0 = *(const f32x4*)(gn_g + c), g1 = *(const f32x4*)(gn_g + c + 4), b0 = *(const f32x4*)(gn_b + c), b1 = *(const f32x4*)(gn_b + c + 4);
#pragma unroll
        for (int e = 0; e < 8; ++e) o[e] = (y[e] * rstd * (e < 4 ? g0[e & 3] : g1[e & 3]) + (e < 4 ? b0[e & 3] : b1[e & 3]) + bon * vf[e]) * zf[e];
        *(u32x4*)(A2 + ((size_t)b * SEQ + t) * DM + c) = pack8(o);
    }
}

constexpr int LDS_BYTES = 147456;
constexpr int NPHASE = 22;
__global__ void __launch_bounds__(NTHREADS, 2) fwd(Params prm) {
    extern __shared__ __attribute__((aligned(16))) unsigned char lds_raw[];
    Frame F; F.lds = (LAS unsigned char*)lds_raw; F.tid = threadIdx.x; F.lane = F.tid & 63; F.wave = __builtin_amdgcn_readfirstlane(F.tid >> 6);
    F.gw = blockIdx.x * NWAVES + F.wave; F.NGW = gridDim.x * NWAVES; F.p = &prm;
    unsigned char* ws = prm.ws;
    volatile LAS unsigned* MISC = (volatile LAS unsigned*)(F.lds + 131072 + 8192);
    if (F.tid < 16) MISC[F.tid] = 0u;
    __syncthreads();
    XcdBarrier bar; bar.bar = (unsigned*)(ws + WS_BAR); bar.x = 0; bar.st = MISC;
#if SINGLE_LAUNCH
    bar = xcd_barrier_post((unsigned*)(ws + WS_BAR), MISC);
    if (prm.use_cg) cg::this_grid().sync();
#endif
    const int lo = prm.ph_lo, hi = prm.ph_hi;
    float* X = (float*)(ws + WS_X); bf16_t* XN = (bf16_t*)(ws + WS_XN); bf16_t* A2 = (bf16_t*)(ws + WS_A2);
    bf16_t* PB = (bf16_t*)(ws + WS_P); float* stats = (float*)(ws + WS_STATS);
    const float* macc = (const float*)(ws + WS_CTL); float* ssq = (float*)(ws + WS_SSQ); const float* biasb = (const float*)(ws + WS_BIAS);
#ifndef PHMASK
#define PHMASK 0x3fffff
#endif
#define IN(k) ((((PHMASK) >> (k)) & 1) && lo <= (k) && (k) < hi)
#ifndef REPMASK
#define REPMASK 0
#endif
#define RP(k) _Pragma("unroll 1") for (int rp_ = 0; rp_ < 1 + (((REPMASK) >> (k)) & 1); ++rp_)
#if SINGLE_LAUNCH
#define SEAM(k) do { if (IN(k) && IN((k) + 1)) xcd_barrier(bar); } while (0)
#else
#define SEAM(k) do { } while (0)
#endif
#define GEMM_IN(EPI, Wt, N_) do { pg8::Gemm g{XN, (const bf16_t*)(ws + (Wt)), M, (N_), DM}; pg8::StaticOrder S; S.init(M, (N_), gridDim.x, blockIdx.x); pg8::gemm_phase(F.lds, g, S, EPI); } while (0)
#define GEMM_OUT(layer, Wt, xin_, fuse_) do { pg8::Gemm g{A2, (const bf16_t*)(ws + (Wt)), M, DM, DM}; pg8::StaticOrder S; S.init(M, DM, gridDim.x, blockIdx.x); \
        EpiOut E{(xin_), X, macc + (size_t)(layer) * 2 * N_SG + 2 * DM, prm.in[5] + (size_t)(layer) * N_SG + 2 * DM, \
                 (fuse_) ? XN : (bf16_t*)nullptr, ssq + (size_t)((layer) + 1) * M, prm.in[3] + (size_t)((layer) + 1) * DM, macc + (size_t)((layer) + 1) * 2 * N_SG + DM, prm.in[5] + (size_t)((layer) + 1) * N_SG + DM}; \
        pg8::gemm_phase(F.lds, g, S, E); } while (0)

    if (IN(0)) RP(0) { phase_p0(F); } SEAM(0);
    if (IN(1)) RP(1) { phase_norm(F, prm.in[0], 0, XN); phase_bias(F); } SEAM(1);
    if (IN(2)) RP(2) { EpiSG E{PB, stats}; GEMM_IN(E, W_SGIN0, N_SG); } SEAM(2);
    if (IN(3)) RP(3) { phase_sgmix(F, 0, PB, PB + (size_t)M * DM, stats, A2); } SEAM(3);
    if (IN(4)) RP(4) { GEMM_OUT(0, W_SGOUT0, prm.in[0], true); } SEAM(4);
    if (IN(6)) RP(6) { EpiAdj<EpiSWA> E{{PB, PB + (size_t)M * DM, PB + (size_t)M * DM + (size_t)M * 256, PB + (size_t)2 * M * DM, (const f32x2*)(ws + WS_ROPE)}, ssq + (size_t)1 * M, biasb}; GEMM_IN(E, W_SWAIN, N_SWA); } SEAM(6);
    if (IN(7)) RP(7) { phase_attn(F, PB, PB + (size_t)M * DM, PB + (size_t)M * DM + (size_t)M * 256, PB + (size_t)2 * M * DM, A2); } SEAM(7);
    if (IN(8)) RP(8) { GEMM_OUT(1, W_SWAOUT, X, true); } SEAM(8);
    if (IN(10)) RP(10) { EpiAdj<EpiPlain> E{{PB, N_RWP}, ssq + (size_t)2 * M, biasb + (size_t)2 * N_RWP}; GEMM_IN(E, W_RWIN, N_RWP); } SEAM(10);
    if (IN(11)) RP(11) { phase_rwprep(F, PB); } SEAM(11);
    if (IN(12)) RP(12) { phase_scanA(F); } SEAM(12);
    if (IN(13)) RP(13) { phase_scanB(F); } SEAM(13);
    if (IN(14)) RP(14) { phase_scanC(F); } SEAM(14);
    if (IN(16)) RP(16) { GEMM_OUT(2, W_RWOUT, X, true); } SEAM(16);
    if (IN(18)) RP(18) { EpiAdj<EpiSG> E{{PB, stats}, ssq + (size_t)3 * M, biasb + (size_t)4 * N_RWP}; GEMM_IN(E, W_SGIN1, N_SG); } SEAM(18);
    if (IN(19)) RP(19) { phase_sgmix(F, 1, PB, PB + (size_t)M * DM, stats, A2); } SEAM(19);
    if (IN(20)) RP(20) { GEMM_OUT(3, W_SGOUT1, X, false); } SEAM(20);
    if (IN(21)) RP(21) { phase_final(F, X); }
}

extern "C" void kernel_launch(void* const* d_in, const int* in_sizes, int n_in, void* d_out, int out_size, void* d_ws, size_t ws_size, hipStream_t stream) {
    static int grid = 0;
    if (grid == 0) {
        if (n_in != 28 || out_size != M * DM || ws_size < WS_END) { fprintf(stderr, "kernel_launch: unexpected shapes (n_in %d out %d ws %zu)\n", n_in, out_size, ws_size); grid = -1; return; }
        int dev = 0, cus = 0, per_cu = 0;
        hipGetDevice(&dev); hipDeviceGetAttribute(&cus, hipDeviceAttributeMultiprocessorCount, dev);
        hipFuncSetAttribute((const void*)fwd, hipFuncAttributeMaxDynamicSharedMemorySize, LDS_BYTES);
        hipOccupancyMaxActiveBlocksPerMultiprocessor(&per_cu, (const void*)fwd, NTHREADS, LDS_BYTES);
        (void)hipGetLastError();
        if (per_cu < 1) per_cu = 1;
        grid = cus;
        if (grid > 256) grid = 256;
    }
    if (grid < 0) return;
    hipMemsetAsync((char*)d_ws + WS_CTL, 0, CTL_BYTES, stream);
    Params p{};
    for (int i = 0; i < 28; ++i) p.in[i] = (const float*)d_in[i];
    p.out = (float*)d_out; p.ws = (unsigned char*)d_ws; p.use_cg = 0; p.pad = 0;
#if SINGLE_LAUNCH
    p.ph_lo = 0; p.ph_hi = NPHASE;
    void* args[] = {&p};
    hipError_t e = hipLaunchCooperativeKernel((const void*)fwd, dim3(grid), dim3(NTHREADS), args, LDS_BYTES, stream);
    if (e != hipSuccess) fprintf(stderr, "cooperative launch failed: %s (grid %d)\n", hipGetErrorString(e), grid);
#else
    for (int ph = 0; ph < NPHASE; ++ph) {
        p.ph_lo = ph; p.ph_hi = ph + 1;
        hipLaunchKernelGGL(fwd, dim3(grid), dim3(NTHREADS), LDS_BYTES, stream, p);
    }
#endif
}
```

```cpp
#include <hip/hip_runtime.h>
#include <hip/hip_cooperative_groups.h>
#include <cstdio>
#include <cstdint>
namespace cg = cooperative_groups;

#ifndef SINGLE_LAUNCH
#define SINGLE_LAUNCH 1
#endif

#define LAS __attribute__((address_space(3)))
typedef unsigned short bf16_t;
typedef short bf16x8 __attribute__((ext_vector_type(8)));
typedef float f32x4 __attribute__((ext_vector_type(4)));
typedef float f32x2 __attribute__((ext_vector_type(2)));
typedef unsigned u32x4 __attribute__((ext_vector_type(4)));
typedef unsigned u32x2 __attribute__((ext_vector_type(2)));

constexpr int BATCH = 2, SEQ = 4096, DM = 2048, M = BATCH * SEQ;
constexpr int N_SG = 6144, N_SWA = 4608, N_RW = 8384, N_RWP = 8448;
constexpr int NWAVES = 8, NTHREADS = 512;
constexpr int NCH = 32, CHL = 128;
constexpr float DECAY_SCALE = 0.6065306597126334f;

constexpr size_t MiB = 1u << 20;
constexpr size_t WS_CTL = 0, CTL_BYTES = 1 * MiB;
constexpr size_t WS_BAR = 512 * 1024;
constexpr size_t WS_SSQ = 256 * 1024;
constexpr size_t WS_BIAS = 7 * MiB + 512 * 1024;
constexpr size_t WS_ROPE = 1 * MiB;
constexpr size_t WS_STATS = 3 * MiB;
constexpr size_t WS_BONUS = 5 * MiB;
constexpr size_t WS_LORA = 6 * MiB;
constexpr size_t WS_W = 8 * MiB;
constexpr size_t W_SGIN0 = WS_W, W_SGIN1 = W_SGIN0 + 24 * MiB, W_SGOUT0 = W_SGIN1 + 24 * MiB, W_SGOUT1 = W_SGOUT0 + 8 * MiB;
constexpr size_t W_SWAIN = W_SGOUT1 + 8 * MiB, W_SWAOUT = W_SWAIN + 18 * MiB, W_RWIN = W_SWAOUT + 8 * MiB, W_RWOUT = W_RWIN + 33 * MiB;
constexpr size_t WS_X = 140 * MiB;
constexpr size_t WS_XN = 204 * MiB;
constexpr size_t WS_A2 = 236 * MiB;
constexpr size_t WS_P = 268 * MiB;
constexpr size_t WS_RW = 400 * MiB;
constexpr size_t WS_END = 656 * MiB;
static_assert(W_RWOUT + 8 * MiB <= WS_X, "ws map");

__device__ __forceinline__ unsigned pk2(float lo, float hi) { unsigned r; asm("v_cvt_pk_bf16_f32 %0, %1, %2" : "=v"(r) : "v"(lo), "v"(hi)); return r; }
__device__ __forceinline__ unsigned f2bf(float f) { return pk2(f, 0.f) & 0xffffu; }
__device__ __forceinline__ float bflo(unsigned w) { return __builtin_bit_cast(float, w << 16); }
__device__ __forceinline__ float bfhi(unsigned w) { return __builtin_bit_cast(float, w & 0xffff0000u); }
__device__ __forceinline__ float bf2f(bf16_t h) { return __builtin_bit_cast(float, (unsigned)h << 16); }
__device__ __forceinline__ unsigned cvt_pk_bf16(float lo, float hi) { unsigned r; asm volatile("v_cvt_pk_bf16_f32 %0, %1, %2" : "=v"(r) : "v"(lo), "v"(hi)); return r; }
__device__ __forceinline__ float frcp(float x) { return __builtin_amdgcn_rcpf(x); }
__device__ __forceinline__ float sigmoidf_(float x) { return frcp(1.0f + __expf(-x)); }
__device__ __forceinline__ float siluf_(float x) { return x * frcp(1.0f + __expf(-x)); }
__device__ __forceinline__ float geluf_(float x) { return x * frcp(1.0f + __expf(-1.5957691216057308f * (x + 0.044715f * x * x * x))); }
__device__ __forceinline__ float tanhf_(float x) { return 1.0f - 2.0f * frcp(__expf(2.0f * x) + 1.0f); }
__device__ __forceinline__ float wave_sum(float v) {
#pragma unroll
    for (int o = 1; o < 64; o <<= 1) v += __shfl_xor(v, o);
    return v;
}
__device__ __forceinline__ void unpack8(u32x4 w, float (&f)[8]) {
    f[0] = bflo(w.x); f[1] = bfhi(w.x); f[2] = bflo(w.y); f[3] = bfhi(w.y); f[4] = bflo(w.z); f[5] = bfhi(w.z); f[6] = bflo(w.w); f[7] = bfhi(w.w);
}
__device__ __forceinline__ u32x4 pack8(const float (&f)[8]) {
    u32x4 w; w.x = pk2(f[0], f[1]); w.y = pk2(f[2], f[3]); w.z = pk2(f[4], f[5]); w.w = pk2(f[6], f[7]); return w;
}

namespace pg8 {
constexpr int BM = 256, BK = 64, HALF = 128, HTB = HALF * BK * 2, STAGE_BYTES = 8 * HTB, NXCD = 8, WGM = 8;
__host__ __device__ __forceinline__ int lds_byte(int r, int c) { const int st = (r >> 4) * 2 + (c >> 5), rr = r & 15, cc = c & 31, ob = rr * 64 + cc * 2; return st * 1024 + (ob ^ (((ob >> 9) & 1) << 5)); }
__host__ __device__ __forceinline__ void stage_rc(int b, int& R, int& C) { const int st = b / 1024, sb = b % 1024, swz = sb ^ (((sb >> 9) & 1) << 5); R = (st >> 1) * 16 + swz / 64; C = (st & 1) * 32 + (swz % 64) / 2; }
__host__ __device__ __forceinline__ int perm32(int rho) { const int n = rho >> 4, i = rho & 15; return 8 * (i >> 2) + 4 * n + (i & 3); }
struct Unit { int pm, pn; };
struct Gemm { const bf16_t* A; const bf16_t* Bt; int M, N, K; };
struct StaticOrder {
    int nM, nN, nwg, G, c;
    __device__ void init(int M_, int N_, int G_, int c_) { nM = M_ / BM; nN = N_ / BM; nwg = nM * nN; G = G_; c = c_; }
    __device__ bool next(int i, Unit& u) const {
        const long L = (long)i * G + c; if (L >= nwg) return false;
        int wgid = (int)L; { const int q = nwg / NXCD, r = nwg % NXCD, xcd = wgid % NXCD, off = wgid / NXCD; wgid = (xcd < r ? xcd * (q + 1) : r * (q + 1) + (xcd - r) * q) + off; }
        const int nig = WGM * nN, gid = wgid / nig, fm = gid * WGM, gsz = (nM - fm) < WGM ? (nM - fm) : WGM;
        u.pm = fm + ((wgid % nig) % gsz); u.pn = (wgid % nig) / gsz; return true;
    }
};
template <class Epi>
__device__ __forceinline__ void gemm_phase(LAS unsigned char* lds, const Gemm g, const StaticOrder& S, const Epi& E) {
    const int tid = threadIdx.x, wid = __builtin_amdgcn_readfirstlane(tid >> 6), lane = tid & 63, wr = wid >> 2, wc = wid & 3, fr = lane & 15, fq = lane >> 4;
    const int K = g.K, nt = K / BK;
    unsigned voffA[2], voffB[2];
#pragma unroll
    for (int i = 0; i < 2; ++i) { int R, C; stage_rc(tid * 16 + i * 8192, R, C); const int Rb = (R & ~31) + perm32(R & 31);
        voffA[i] = (unsigned)(R * K + C) * 2u; voffB[i] = (unsigned)(Rb * K + C) * 2u; }
    const size_t kstep = (size_t)(BK * 2);
    const size_t hstep = (size_t)HALF * K * 2;
    const size_t tstep = 2 * hstep;
    const unsigned ldsw = (unsigned)wid * 1024u;
    const int aoff = lds_byte(wr * 64 + fr, fq * 8), boff = lds_byte(wc * 32 + fr, fq * 8);
#define PG8_SA(b, h) (((b) * 2 + (h)) * HTB)
#define PG8_SB(b, h) ((4 + (b) * 2 + (h)) * HTB)
#define PG8_STAGE(bufoff, gbase, voff) do { _Pragma("unroll") for (int _i = 0; _i < 2; ++_i) \
        __builtin_amdgcn_global_load_lds((const unsigned*)((const char*)(gbase) + (voff)[_i]), (LAS unsigned*)(lds + (bufoff) + ldsw + _i * 8192), 16, 0, 0); } while (0)
#define PG8_LDA(dst, b, h) do { _Pragma("unroll") for (int m = 0; m < 4; ++m) _Pragma("unroll") for (int k = 0; k < 2; ++k) dst[m][k] = *(const LAS bf16x8*)(lds + PG8_SA(b, h) + aoff + m * 2048 + k * 1024); } while (0)
#define PG8_LDB(dst, b, h) do { _Pragma("unroll") for (int n = 0; n < 2; ++n) _Pragma("unroll") for (int k = 0; k < 2; ++k) dst[n][k] = *(const LAS bf16x8*)(lds + PG8_SB(b, h) + boff + n * 2048 + k * 1024); } while (0)
#define PG8_MMA(ai, bj, At, Bt) do { __builtin_amdgcn_s_setprio(1); _Pragma("unroll") for (int m = 0; m < 4; ++m) _Pragma("unroll") for (int n = 0; n < 2; ++n) _Pragma("unroll") for (int k = 0; k < 2; ++k) \
        acc[ai][bj][m][n] = __builtin_amdgcn_mfma_f32_16x16x32_bf16(Bt[n][k], At[m][k], acc[ai][bj][m][n], 0, 0, 0); __builtin_amdgcn_s_setprio(0); } while (0)
#define PG8_WAIT_V(n) asm volatile("s_waitcnt vmcnt(" #n ")" ::: "memory")
#define PG8_WAIT_L(n) asm volatile("s_waitcnt lgkmcnt(" #n ")" ::: "memory")
#define PG8_BAR __builtin_amdgcn_s_barrier()
#define PG8_SCHED __builtin_amdgcn_sched_barrier(0)
    Unit cur, nxt; int ui = 0;
    if (!S.next(0, cur)) return;
    f32x4 acc[2][2][4][2];
#pragma unroll
    for (int a = 0; a < 2; ++a)
#pragma unroll
        for (int b = 0; b < 2; ++b)
#pragma unroll
            for (int m = 0; m < 4; ++m)
#pragma unroll
                for (int n = 0; n < 2; ++n) acc[a][b][m][n] = (f32x4){0.f, 0.f, 0.f, 0.f};
    bf16x8 At[4][2], B0[2][2], B1[2][2];
    const char* cA = (const char*)g.A + (size_t)cur.pm * tstep; const char* cB = (const char*)g.Bt + (size_t)cur.pn * tstep;
    PG8_STAGE(PG8_SB(0, 0), cB, voffB); PG8_STAGE(PG8_SB(0, 1), cB + hstep, voffB); PG8_STAGE(PG8_SA(0, 0), cA, voffA); PG8_STAGE(PG8_SA(0, 1), cA + hstep, voffA);
    if (wr == 1) PG8_BAR;
    PG8_WAIT_V(2); PG8_BAR;
    PG8_STAGE(PG8_SB(1, 0), cB + kstep, voffB); PG8_STAGE(PG8_SA(1, 0), cA + kstep, voffA); PG8_STAGE(PG8_SB(1, 1), cB + hstep + kstep, voffB);
    PG8_WAIT_V(6); PG8_BAR;
    for (;;) {
        const bool has_next = S.next(ui + 1, nxt);
        const char* nA = has_next ? (const char*)g.A + (size_t)nxt.pm * tstep : cA; const char* nB = has_next ? (const char*)g.Bt + (size_t)nxt.pn * tstep : cB;
        for (int t = 0; t < nt; t += 2) {
            const bool last = (t == nt - 2);
            const char* a1 = cA + (size_t)(t + 1) * kstep;
            const char* a2 = last ? nA : cA + (size_t)(t + 2) * kstep; const char* b2 = last ? nB : cB + (size_t)(t + 2) * kstep;
            const char* a3 = a2 + kstep; const char* b3 = b2 + kstep;
            PG8_LDB(B0, 0, 0); PG8_LDB(B1, 0, 1); PG8_SCHED; PG8_LDA(At, 0, 0); PG8_STAGE(PG8_SA(1, 1), a1 + hstep, voffA);
            PG8_WAIT_V(8); PG8_WAIT_L(0); PG8_BAR; PG8_MMA(0, 0, At, B0); PG8_MMA(0, 1, At, B1); PG8_BAR; PG8_SCHED;
            PG8_LDA(At, 0, 1); PG8_STAGE(PG8_SB(0, 0), b2, voffB); PG8_STAGE(PG8_SB(0, 1), b2 + hstep, voffB); PG8_STAGE(PG8_SA(0, 0), a2, voffA);
            PG8_WAIT_V(8); PG8_WAIT_L(0); PG8_BAR; PG8_MMA(1, 0, At, B0); PG8_MMA(1, 1, At, B1); PG8_BAR; PG8_SCHED;
            PG8_LDB(B0, 1, 0); PG8_LDB(B1, 1, 1); PG8_SCHED; PG8_LDA(At, 1, 0); PG8_STAGE(PG8_SA(0, 1), a2 + hstep, voffA);
            PG8_WAIT_V(8); PG8_WAIT_L(0); PG8_BAR; PG8_MMA(0, 0, At, B0); PG8_MMA(0, 1, At, B1); PG8_BAR; PG8_SCHED;
            PG8_LDA(At, 1, 1); PG8_STAGE(PG8_SB(1, 0), b3, voffB); PG8_STAGE(PG8_SB(1, 1), b3 + hstep, voffB); PG8_STAGE(PG8_SA(1, 0), a3, voffA);
            PG8_WAIT_V(8); PG8_WAIT_L(0); PG8_BAR; PG8_MMA(1, 0, At, B0); PG8_MMA(1, 1, At, B1); PG8_BAR; PG8_SCHED;
        }
        if (wr == 0) PG8_BAR;
        E(acc, cur, wr, wc, fr, fq);
        if (!has_next) break;
#pragma unroll
        for (int a = 0; a < 2; ++a)
#pragma unroll
            for (int b = 0; b < 2; ++b)
#pragma unroll
                for (int m = 0; m < 4; ++m)
#pragma unroll
                    for (int n = 0; n < 2; ++n) acc[a][b][m][n] = (f32x4){0.f, 0.f, 0.f, 0.f};
        cur = nxt; cA = nA; cB = nB; ++ui;
        if (wr == 1) PG8_BAR;
    }
    PG8_WAIT_V(0);
    PG8_BAR;
#undef PG8_SA
#undef PG8_SB
#undef PG8_STAGE
#undef PG8_LDA
#undef PG8_LDB
#undef PG8_MMA
#undef PG8_WAIT_V
#undef PG8_WAIT_L
#undef PG8_BAR
#undef PG8_SCHED
}
}
using pg8::Unit;
typedef f32x4 Acc[2][2][4][2];

struct EpiSG {
    bf16_t* P0; float* stats;
    __device__ __forceinline__ void operator()(const Acc& acc, const Unit& u, int wr, int wc, int fr, int fq) const {
        const int row0 = u.pm * 256 + wr * 64 + fr;
        if (u.pn < 16) {
            const int col0 = u.pn * 128 + wc * 32 + 8 * fq;
#pragma unroll
            for (int ai = 0; ai < 2; ++ai)
#pragma unroll
                for (int m = 0; m < 4; ++m) {
                    const int row = row0 + ai * 128 + m * 16;
                    f32x4 a = acc[ai][0][m][0], b = acc[ai][0][m][1]; const f32x4 za = acc[ai][1][m][0], zb = acc[ai][1][m][1];
#pragma unroll
                    for (int e = 0; e < 4; ++e) { a[e] = geluf_(a[e]) * siluf_(za[e]); b[e] = geluf_(b[e]) * siluf_(zb[e]); }
                    u32x4 w; w.x = cvt_pk_bf16(a[0], a[1]); w.y = cvt_pk_bf16(a[2], a[3]); w.z = cvt_pk_bf16(b[0], b[1]); w.w = cvt_pk_bf16(b[2], b[3]);
                    *(u32x4*)(P0 + (size_t)row * DM + col0) = w;
                }
        } else {
            const int vt = u.pn - 16, col0 = vt * 256 + wc * 32 + 8 * fq;
            bf16_t* base = P0 + (size_t)M * DM;
#pragma unroll
            for (int ai = 0; ai < 2; ++ai)
#pragma unroll
                for (int m = 0; m < 4; ++m) {
                    const int row = row0 + ai * 128 + m * 16; float s = 0.f, q = 0.f;
#pragma unroll
                    for (int bj = 0; bj < 2; ++bj) {
                        f32x4 a = acc[ai][bj][m][0], b = acc[ai][bj][m][1];
#pragma unroll
                        for (int e = 0; e < 4; ++e) { a[e] = geluf_(a[e]); b[e] = geluf_(b[e]); }
                        s += (a[0] + a[1]) + (a[2] + a[3]) + (b[0] + b[1]) + (b[2] + b[3]);
                        q += (a[0] * a[0] + a[1] * a[1]) + (a[2] * a[2] + a[3] * a[3]) + (b[0] * b[0] + b[1] * b[1]) + (b[2] * b[2] + b[3] * b[3]);
                        u32x4 w; w.x = cvt_pk_bf16(a[0], a[1]); w.y = cvt_pk_bf16(a[2], a[3]); w.z = cvt_pk_bf16(b[0], b[1]); w.w = cvt_pk_bf16(b[2], b[3]);
                        *(u32x4*)(base + (size_t)row * DM + col0 + bj * 128) = w;
                    }
                    s += __shfl_xor(s, 16); s += __shfl_xor(s, 32); q += __shfl_xor(q, 16); q += __shfl_xor(q, 32);
                    if (fq == 0) *(f32x2*)(stats + ((size_t)row * 32 + vt * 4 + wc) * 2) = (f32x2){s, q};
                }
        }
    }
};
struct EpiSWA {
    bf16_t *Q, *Kb, *Vb, *Z; const f32x2* rope;
    __device__ __forceinline__ void operator()(const Acc& acc, const Unit& u, int wr, int wc, int fr, int fq) const {
        const int pn = u.pn; bf16_t* base; int ld, colt; bool rp = false, act = false;
        if (pn < 8) { base = Q; ld = DM; colt = pn * 256; rp = true; }
        else if (pn == 8) { base = Kb; ld = 256; colt = 0; rp = true; }
        else if (pn == 9) { base = Vb; ld = 256; colt = 0; }
        else { base = Z; ld = DM; colt = (pn - 10) * 256; act = true; }
        const int row0 = u.pm * 256 + wr * 64 + fr, col0 = colt + wc * 32 + 8 * fq;
        const int f0 = 16 * (wc & 1) + 4 * fq;
#pragma unroll
        for (int ai = 0; ai < 2; ++ai)
#pragma unroll
            for (int m = 0; m < 4; ++m) {
                const int row = row0 + ai * 128 + m * 16;
                f32x4 cs0 = {1.f, 0.f, 1.f, 0.f}, cs1 = cs0;
                if (rp) { const f32x4* rr = (const f32x4*)(rope + (size_t)row * 32 + f0); cs0 = rr[0]; cs1 = rr[1]; }
#pragma unroll
                for (int bj = 0; bj < 2; ++bj) {
                    f32x4 a = acc[ai][bj][m][0], b = acc[ai][bj][m][1];
                    if (rp) {
                        const float c0 = cs0[0], s0 = cs0[1], c1 = cs0[2], s1 = cs0[3], c2 = cs1[0], s2 = cs1[1], c3 = cs1[2], s3 = cs1[3];
                        f32x4 o1, o2;
                        o1[0] = a[0] * c0 - b[0] * s0; o2[0] = b[0] * c0 + a[0] * s0;
                        o1[1] = a[1] * c1 - b[1] * s1; o2[1] = b[1] * c1 + a[1] * s1;
                        o1[2] = a[2] * c2 - b[2] * s2; o2[2] = b[2] * c2 + a[2] * s2;
                        o1[3] = a[3] * c3 - b[3] * s3; o2[3] = b[3] * c3 + a[3] * s3;
                        a = o1; b = o2;
                    }
                    if (act) {
#pragma unroll
                        for (int e = 0; e < 4; ++e) { a[e] = siluf_(a[e]); b[e] = siluf_(b[e]); }
                    }
                    u32x4 w; w.x = cvt_pk_bf16(a[0], a[1]); w.y = cvt_pk_bf16(a[2], a[3]); w.z = cvt_pk_bf16(b[0], b[1]); w.w = cvt_pk_bf16(b[2], b[3]);
                    *(u32x4*)(base + (size_t)row * ld + col0 + bj * 128) = w;
                }
            }
    }
};
struct EpiPlain {
    bf16_t* O; int ld;
    __device__ __forceinline__ void operator()(const Acc& acc, const Unit& u, int wr, int wc, int fr, int fq) const {
        const int row0 = u.pm * 256 + wr * 64 + fr, col0 = u.pn * 256 + wc * 32 + 8 * fq;
#pragma unroll
        for (int ai = 0; ai < 2; ++ai)
#pragma unroll
            for (int m = 0; m < 4; ++m) {
                const int row = row0 + ai * 128 + m * 16;
#pragma unroll
                for (int bj = 0; bj < 2; ++bj) {
                    const f32x4 a = acc[ai][bj][m][0], b = acc[ai][bj][m][1];
                    u32x4 w; w.x = cvt_pk_bf16(a[0], a[1]); w.y = cvt_pk_bf16(a[2], a[3]); w.z = cvt_pk_bf16(b[0], b[1]); w.w = cvt_pk_bf16(b[2], b[3]);
                    *(u32x4*)(O + (size_t)row * ld + col0 + bj * 128) = w;
                }
            }
    }
};
struct EpiOut {
    const float* xin; float* xout; const float* macc; const float* mb;
    bf16_t* xb; float* ssq; const float* g; const float* macc_sc; const float* mb_sc;
    __device__ __forceinline__ void operator()(const Acc& acc, const Unit& u, int wr, int wc, int fr, int fq) const {
        const int row0 = u.pm * 256 + wr * 64 + fr, col0 = u.pn * 256 + wc * 32 + 8 * fq;
        const int b = u.pm >> 4;
        float ss[2][4];
#pragma unroll
        for (int ai = 0; ai < 2; ++ai)
#pragma unroll
            for (int m = 0; m < 4; ++m) ss[ai][m] = 0.f;
#pragma unroll
        for (int bj = 0; bj < 2; ++bj) {
            const int cj = col0 + bj * 128;
            const f32x4 gt0 = *(const f32x4*)(macc + (size_t)b * N_SG + cj) + *(const f32x4*)(mb + cj), gt1 = *(const f32x4*)(macc + (size_t)b * N_SG + cj + 4) + *(const f32x4*)(mb + cj + 4);
            f32x4 gs0 = {0.f, 0.f, 0.f, 0.f}, gs1 = gs0;
            if (xb) { gs0 = *(const f32x4*)(g + cj) * (*(const f32x4*)(macc_sc + (size_t)b * N_SG + cj) + *(const f32x4*)(mb_sc + cj) + 1.0f);
                      gs1 = *(const f32x4*)(g + cj + 4) * (*(const f32x4*)(macc_sc + (size_t)b * N_SG + cj + 4) + *(const f32x4*)(mb_sc + cj + 4) + 1.0f); }
#pragma unroll
            for (int ai = 0; ai < 2; ++ai)
#pragma unroll
                for (int m = 0; m < 4; ++m) {
                    const size_t off = (size_t)(row0 + ai * 128 + m * 16) * DM + cj;
                    const f32x4 x0 = *(const f32x4*)(xin + off) + gt0 * acc[ai][bj][m][0];
                    const f32x4 x1 = *(const f32x4*)(xin + off + 4) + gt1 * acc[ai][bj][m][1];
                    *(f32x4*)(xout + off) = x0; *(f32x4*)(xout + off + 4) = x1;
                    if (xb) {
                        ss[ai][m] += (x0[0] * x0[0] + x0[1] * x0[1]) + (x0[2] * x0[2] + x0[3] * x0[3]) + (x1[0] * x1[0] + x1[1] * x1[1]) + (x1[2] * x1[2] + x1[3] * x1[3]);
                        const f32x4 h0 = x0 * gs0, h1 = x1 * gs1;
                        u32x4 w; w.x = cvt_pk_bf16(h0[0], h0[1]); w.y = cvt_pk_bf16(h0[2], h0[3]); w.z = cvt_pk_bf16(h1[0], h1[1]); w.w = cvt_pk_bf16(h1[2], h1[3]);
                        *(u32x4*)(xb + off) = w;
                    }
                    if (m & 1) asm volatile("" ::: "memory");
                }
        }
        if (xb) {
#pragma unroll
            for (int ai = 0; ai < 2; ++ai)
#pragma unroll
                for (int m = 0; m < 4; ++m) { float s = ss[ai][m]; s += __shfl_xor(s, 16); s += __shfl_xor(s, 32); if (fq == 0) atomicAdd(ssq + row0 + ai * 128 + m * 16, s); }
        }
    }
};
template <class Inner> struct EpiAdj {
    Inner in; const float* ssq; const float* bias;
    __device__ __forceinline__ void operator()(Acc& acc, const Unit& u, int wr, int wc, int fr, int fq) const {
        const int b = u.pm >> 4, colb = u.pn * 256 + wc * 32 + 8 * fq;
        f32x4 bs[2][2];
#pragma unroll
        for (int bj = 0; bj < 2; ++bj)
#pragma unroll
            for (int n = 0; n < 2; ++n) bs[bj][n] = *(const f32x4*)(bias + (size_t)b * N_RWP + colb + bj * 128 + 4 * n);
#pragma unroll
        for (int ai = 0; ai < 2; ++ai)
#pragma unroll
            for (int m = 0; m < 4; ++m) {
                const float rstd = rsqrtf(ssq[u.pm * 256 + ai * 128 + wr * 64 + m * 16 + fr] * (1.0f / DM) + 1e-6f);
#pragma unroll
                for (int bj = 0; bj < 2; ++bj)
#pragma unroll
                    for (int n = 0; n < 2; ++n) acc[ai][bj][m][n] = acc[ai][bj][m][n] * rstd + bs[bj][n];
            }
        in(acc, u, wr, wc, fr, fq);
    }
};

struct Params { const float* in[28]; float* out; unsigned char* ws; int ph_lo, ph_hi, use_cg, pad; };

struct Frame {
    LAS unsigned char* lds; int tid, lane, wave, gw, NGW;
    const Params* p;
};

#define XB_TMO      128
#define XB_XCNT(j)  (256  + 64 * (j))
#define XB_XSUB(j)  (1280 + 64 * (j))
#define XB_XGEN(j)  (2304 + 64 * (j))
#define XB_TOP      3328
#define XB_TOPGEN   3392
#define XB_SPIN_CAP (1u << 22)
__device__ __forceinline__ unsigned xb_ld(unsigned* p)              { return __hip_atomic_load(p, __ATOMIC_RELAXED, __HIP_MEMORY_SCOPE_AGENT); }
__device__ __forceinline__ unsigned xb_add(unsigned* p, unsigned v) { return __hip_atomic_fetch_add(p, v, __ATOMIC_RELAXED, __HIP_MEMORY_SCOPE_AGENT); }
__device__ __forceinline__ unsigned xb_xcc_id() { return (unsigned)__builtin_amdgcn_s_getreg((3 << 11) | 20) & 0xFu; }
#define XB_SPIN(cond, bar) do { unsigned _sp = 0; while (cond) { __builtin_amdgcn_s_sleep(1); \
    if ((++_sp & 255u) == 0u) { if (xb_ld(&(bar)[XB_TMO])) break; if (_sp > XB_SPIN_CAP) { atomicAdd(&(bar)[XB_TMO], 1u); break; } } } } while (0)
struct XcdBarrier { unsigned* bar; unsigned x; volatile LAS unsigned* st; };
__device__ __forceinline__ XcdBarrier xcd_barrier_post(unsigned* bar, volatile LAS unsigned* st) {
    XcdBarrier b; b.bar = bar; b.x = xb_xcc_id(); b.st = st;
    if (threadIdx.x == 0) (void)xb_add(&bar[XB_XCNT(b.x)], 1u);
    return b;
}
__device__ __forceinline__ void xcd_barrier_complete(unsigned* bar, unsigned x, unsigned& nloc, unsigned& nx) {
    const unsigned G = gridDim.x * gridDim.y * gridDim.z;
    unsigned sum, cnt, mine, sp = 0u;
    for (;;) {
        sum = 0u; cnt = 0u; mine = 0u;
#pragma unroll
        for (unsigned j = 0; j < 16; ++j) { const unsigned c = xb_ld(&bar[XB_XCNT(j)]); sum += c; cnt += (c > 0u) ? 1u : 0u; mine = (j == x) ? c : mine; }
        if (sum == G) break;
        __builtin_amdgcn_s_sleep(1);
        if ((++sp & 255u) == 0u) { if (xb_ld(&bar[XB_TMO])) break; if (sp > XB_SPIN_CAP) { atomicAdd(&bar[XB_TMO], 1u); break; } }
    }
    nloc = mine > 0u ? mine : 1u; nx = cnt > 0u ? cnt : 1u;
}
__device__ __forceinline__ void xcd_barrier(const XcdBarrier& b) {
    asm volatile("s_waitcnt vmcnt(0)" ::: "memory");
    __syncthreads();
    if (threadIdx.x == 0) {
        unsigned* bar = b.bar;
        __builtin_amdgcn_s_waitcnt(0);
        unsigned nloc = b.st[0], nx = b.st[1];
        if (nloc == 0u) { xcd_barrier_complete(bar, b.x, nloc, nx); b.st[0] = nloc; b.st[1] = nx; }
        const unsigned old = xb_add(&bar[XB_XSUB(b.x)], 1u);
        const unsigned gen = old / nloc;
        if (old + 1u == (gen + 1u) * nloc) {
            __builtin_amdgcn_fence(__ATOMIC_RELEASE, "agent");
            asm volatile("s_waitcnt vmcnt(0)" ::: "memory");
            const unsigned og = xb_add(&bar[XB_TOP], 1u);
            const unsigned tg = og / nx;
            if (og + 1u == (tg + 1u) * nx) xb_add(&bar[XB_TOPGEN], 1u);
            else XB_SPIN(xb_ld(&bar[XB_TOPGEN]) == tg, bar);
            __builtin_amdgcn_fence(__ATOMIC_ACQUIRE, "agent");
            xb_add(&bar[XB_XGEN(b.x)], 1u);
            asm volatile("s_waitcnt vmcnt(0)" ::: "memory");
        } else {
            XB_SPIN(xb_ld(&bar[XB_XGEN(b.x)]) == gen, bar);
            __builtin_amdgcn_fence(__ATOMIC_ACQUIRE, "agent");
            asm volatile("s_waitcnt vmcnt(0)" ::: "memory");
        }
    }
    __syncthreads();
}

__device__ const float ROPE_INVF[32] = {1.f, 0.749894202f, 0.562341332f, 0.421696514f, 0.316227764f, 0.237137377f, 0.177827939f, 0.133352146f, 0.100000001f, 0.0749894232f, 0.0562341325f, 0.0421696492f, 0.0316227749f, 0.0237137377f, 0.0177827943f, 0.013335214f, 0.00999999978f, 0.00749894232f, 0.00562341325f, 0.00421696482f, 0.00316227763f, 0.00237137382f, 0.00177827943f, 0.00133352145f, 0.00100000005f, 0.000749894185f, 0.000562341302f, 0.000421696517f, 0.000316227757f, 0.00023713737f, 0.00017782794f, 0.00013335215f};

__device__ __forceinline__ int sg_maprow(int n) {
    if (n < DM) return (n >> 7) * 256 + (n & 127);
    if (n >= 2 * DM) { const int c = n - 2 * DM; return (c >> 7) * 256 + 128 + (c & 127); }
    return 2 * DM + (n - DM);
}
__device__ __forceinline__ int swa_maprow(int n) {
    if (n >= 2304) return n;
    const int d = n & 63, half = d >> 5, dd = d & 31, j = dd >> 2, i = dd & 3;
    return (n & ~63) + 8 * j + 4 * half + i;
}
__device__ __forceinline__ void p0_transpose_item(const float* W, int N, bf16_t* WT, int mode, LAS float* scr, int item, int lane) {
    const int nblk = N / 32, kb = item / nblk, nb = item % nblk, k0 = 64 * kb, n0 = 32 * nb;
#pragma unroll 8
    for (int i = 0; i < 32; ++i) { const int kk = 2 * i + (lane >> 5); scr[kk * 33 + (lane & 31)] = W[(size_t)(k0 + kk) * N + n0 + (lane & 31)]; }
    asm volatile("s_waitcnt lgkmcnt(0)" ::: "memory");
    const int c = lane & 7;
#pragma unroll
    for (int j = 0; j < 4; ++j) { const int n = (lane >> 3) + 8 * j; const LAS float* s = scr + (8 * c) * 33 + n;
        u32x4 o; o.x = pk2(s[0 * 33], s[1 * 33]); o.y = pk2(s[2 * 33], s[3 * 33]); o.z = pk2(s[4 * 33], s[5 * 33]); o.w = pk2(s[6 * 33], s[7 * 33]);
        const int dn = mode == 1 ? swa_maprow(n0 + n) : (mode == 2 ? sg_maprow(n0 + n) : (n0 + n));
        *(u32x4*)(WT + (size_t)dn * DM + k0 + 8 * c) = o; }
    asm volatile("s_waitcnt lgkmcnt(0)" ::: "memory");
}
__device__ __forceinline__ void phase_p0(Frame& F) {
    const Params& P = *F.p; unsigned char* ws = P.ws;
    LAS float* scr = (LAS float*)(F.lds + F.wave * 16384);
    const int lane = F.lane;
    constexpr int I_SGIN = 32 * (N_SG / 32), I_OUT = 32 * (DM / 32), I_SWAIN = 32 * (N_SWA / 32), I_RWIN = 32 * (N_RW / 32);
    constexpr int NITEMS = 2 * I_SGIN + 2 * I_OUT + I_SWAIN + I_OUT + I_RWIN + I_OUT;
#ifndef P0REP
#define P0REP 1
#endif
    _Pragma("unroll 1") for (int rep_ = 0; rep_ < P0REP; ++rep_)
    for (int it = F.gw; it < NITEMS; it += F.NGW) {
        int r = it;
        if (r < I_SGIN) { p0_transpose_item(P.in[7], N_SG, (bf16_t*)(ws + W_SGIN0), 2, scr, r, lane); continue; } r -= I_SGIN;
        if (r < I_SGIN) { p0_transpose_item(P.in[7] + (size_t)DM * N_SG, N_SG, (bf16_t*)(ws + W_SGIN1), 2, scr, r, lane); continue; } r -= I_SGIN;
        if (r < I_OUT) { p0_transpose_item(P.in[8], DM, (bf16_t*)(ws + W_SGOUT0), 0, scr, r, lane); continue; } r -= I_OUT;
        if (r < I_OUT) { p0_transpose_item(P.in[8] + (size_t)DM * DM, DM, (bf16_t*)(ws + W_SGOUT1), 0, scr, r, lane); continue; } r -= I_OUT;
        if (r < I_SWAIN) { p0_transpose_item(P.in[13], N_SWA, (bf16_t*)(ws + W_SWAIN), 1, scr, r, lane); continue; } r -= I_SWAIN;
        if (r < I_OUT) { p0_transpose_item(P.in[14], DM, (bf16_t*)(ws + W_SWAOUT), 0, scr, r, lane); continue; } r -= I_OUT;
        if (r < I_RWIN) { p0_transpose_item(P.in[16], N_RW, (bf16_t*)(ws + W_RWIN), 0, scr, r, lane); continue; } r -= I_RWIN;
        p0_transpose_item(P.in[17], DM, (bf16_t*)(ws + W_RWOUT), 0, scr, r, lane);
    }
    { u32x4* z = (u32x4*)(ws + W_RWIN + (size_t)N_RW * DM * 2); const int n16 = (N_RWP - N_RW) * DM * 2 / 16;
      for (int i = blockIdx.x * NTHREADS + F.tid; i < n16; i += gridDim.x * NTHREADS) z[i] = (u32x4){0u, 0u, 0u, 0u}; }
    { float* macc = (float*)(ws + WS_CTL); const float* cin = P.in[1]; const float* mw = P.in[4];
      LAS float* my = (LAS float*)(F.lds + F.wave * 16384);
      for (int bt = blockIdx.x; bt < 4 * 24 * 8; bt += gridDim.x) {
          const int i = bt / 192, rem = bt % 192, cgp = rem / 8, ks = (rem % 8) * 8 + F.wave, n0 = cgp * 256 + lane * 4, k0 = ks * 32;
          const float c0v = siluf_(cin[k0 + (lane & 31)]), c1v = siluf_(cin[DM + k0 + (lane & 31)]);
          f32x4 a0 = {0.f, 0.f, 0.f, 0.f}, a1 = a0;
          const float* wp = mw + ((size_t)i * DM + k0) * N_SG + n0;
#pragma unroll 8
          for (int kk = 0; kk < 32; ++kk) {
              const f32x4 w = *(const f32x4*)(wp + (size_t)kk * N_SG);
              const float s0 = __builtin_bit_cast(float, __builtin_amdgcn_readlane(__builtin_bit_cast(int, c0v), kk));
              const float s1 = __builtin_bit_cast(float, __builtin_amdgcn_readlane(__builtin_bit_cast(int, c1v), kk));
              a0 += w * s0; a1 += w * s1;
          }
          *(LAS f32x4*)(my + lane * 4) = a0; *(LAS f32x4*)(my + 256 + lane * 4) = a1;
          __syncthreads();
          { const int b = F.tid >> 8, col = F.tid & 255; float s = 0.f;
#pragma unroll
            for (int w8 = 0; w8 < 8; ++w8) s += *((const LAS float*)(F.lds + w8 * 16384) + b * 256 + col);
            atomicAdd(macc + ((size_t)i * 2 + b) * N_SG + cgp * 256 + col, s); }
          __syncthreads();
      } }
    { bf16_t* LWH = (bf16_t*)(ws + WS_LORA); bf16_t* LWL = LWH + 2048 * 96; bf16_t* LA = LWL + 2048 * 96; const float* wl = P.in[20]; const float* al = P.in[22];
      for (int idx = blockIdx.x * NTHREADS + F.tid; idx < 96 * DM; idx += gridDim.x * NTHREADS) {
          const int k = idx >> 11, c = idx & (DM - 1); const float w = wl[idx]; const unsigned hi = f2bf(w);
          LWH[c * 96 + k] = (bf16_t)hi; LWL[c * 96 + k] = (bf16_t)f2bf(w - __builtin_bit_cast(float, hi << 16)); LA[c * 96 + k] = (bf16_t)f2bf(al[idx]);
      } }
    { f32x2* tab = (f32x2*)(ws + WS_ROPE); const int* pos = (const int*)P.in[2];
      for (int idx = blockIdx.x * NTHREADS + F.tid; idx < M * 32; idx += gridDim.x * NTHREADS) {
          const int m = idx >> 5, f = idx & 31;
          const float ang = (float)pos[m] * ROPE_INVF[f];
          double rev = (double)ang * 0.15915494309189535; rev -= __builtin_rint(rev);
          const float rf = (float)rev;
          tab[idx] = (f32x2){__builtin_amdgcn_cosf(rf), __builtin_amdgcn_sinf(rf)};
      } }
}

__device__ __forceinline__ void phase_norm(Frame& F, const float* xin, int layer, bf16_t* XN) {
    const Params& P = *F.p; const float* macc = (const float*)(P.ws + WS_CTL); const float* mb = P.in[5] + (size_t)layer * N_SG; const float* g = P.in[3] + (size_t)layer * DM;
    for (int row = F.gw; row < M; row += F.NGW) {
        const int b = row >> 12; const float* ma = macc + ((size_t)layer * 2 + b) * N_SG;
        const f32x4* xr = (const f32x4*)(xin + (size_t)row * DM) + F.lane;
        f32x4 v[8]; float ss = 0.f;
#pragma unroll
        for (int j = 0; j < 8; ++j) { v[j] = xr[64 * j]; ss += (v[j].x * v[j].x + v[j].y * v[j].y) + (v[j].z * v[j].z + v[j].w * v[j].w); }
        const float rstd = rsqrtf(wave_sum(ss) * (1.0f / DM) + 1e-6f);
#pragma unroll
        for (int j = 0; j < 8; ++j) {
            const int c = 256 * j + 4 * F.lane;
            const f32x4 g4 = *(const f32x4*)(g + c);
            const f32x4 sh = *(const f32x4*)(ma + c) + *(const f32x4*)(mb + c);
            const f32x4 sc = *(const f32x4*)(ma + DM + c) + *(const f32x4*)(mb + DM + c);
            const f32x4 h = v[j] * rstd * g4 * (sc + 1.0f) + sh;
            u32x2 w; w.x = pk2(h.x, h.y); w.y = pk2(h.z, h.w);
            *(u32x2*)(XN + (size_t)row * DM + c) = w;
        }
    }
}
__device__ __forceinline__ void phase_bias(Frame& F) {
    const Params& P = *F.p; const float* macc = (const float*)(P.ws + WS_CTL); float* bias = (float*)(P.ws + WS_BIAS);
#pragma unroll 1
    for (int l = 1; l < 4; ++l) {
        const bf16_t* Wt = (const bf16_t*)(P.ws + (l == 1 ? W_SWAIN : (l == 2 ? W_RWIN : W_SGIN1))); const int N = l == 1 ? N_SWA : (l == 2 ? N_RWP : N_SG);
        f32x4 sh[2][4][2];
#pragma unroll
        for (int b = 0; b < 2; ++b)
#pragma unroll
            for (int j = 0; j < 4; ++j)
#pragma unroll
                for (int h = 0; h < 2; ++h) { const int k = 8 * F.lane + 512 * j + 4 * h; sh[b][j][h] = *(const f32x4*)(macc + ((size_t)l * 2 + b) * N_SG + k) + *(const f32x4*)(P.in[5] + (size_t)l * N_SG + k); }
        for (int n = F.gw; n < N; n += F.NGW) {
            float s0 = 0.f, s1 = 0.f;
#pragma unroll
            for (int j = 0; j < 4; ++j) {
                float w[8]; unpack8(*(const u32x4*)(Wt + (size_t)n * DM + 8 * F.lane + 512 * j), w);
#pragma unroll
                for (int e = 0; e < 8; ++e) { s0 += w[e] * sh[0][j][e >> 2][e & 3]; s1 += w[e] * sh[1][j][e >> 2][e & 3]; }
            }
            s0 = wave_sum(s0); s1 = wave_sum(s1);
            if (F.lane == 0) { bias[((size_t)(l - 1) * 2 + 0) * N_RWP + n] = s0; bias[((size_t)(l - 1) * 2 + 1) * N_RWP + n] = s1; }
        }
    }
}
__device__ __forceinline__ void phase_final(Frame& F, const float* xin) {
    const Params& P = *F.p; const float* g = P.in[6];
    for (int row = F.gw; row < M; row += F.NGW) {
        const f32x4* xr = (const f32x4*)(xin + (size_t)row * DM) + F.lane;
        f32x4 v[8]; float ss = 0.f;
#pragma unroll
        for (int j = 0; j < 8; ++j) { v[j] = xr[64 * j]; ss += (v[j].x * v[j].x + v[j].y * v[j].y) + (v[j].z * v[j].z + v[j].w * v[j].w); }
        const float rstd = rsqrtf(wave_sum(ss) * (1.0f / DM) + 1e-6f);
        f32x4* o = (f32x4*)(P.out + (size_t)row * DM) + F.lane;
#pragma unroll
        for (int j = 0; j < 8; ++j) { const f32x4 g4 = *(const f32x4*)(g + 256 * j + 4 * F.lane); o[64 * j] = v[j] * rstd * g4; }
    }
}

__device__ __forceinline__ void phase_sgmix(Frame& F, int j, const bf16_t* UZ, const bf16_t* GV, const float* stats, bf16_t* A2) {
    const Params& P = *F.p;
    const float* ln_g = P.in[9] + (size_t)j * DM; const float* ln_b = P.in[10] + (size_t)j * DM;
    const float* wsp = P.in[11] + (size_t)j * 16 * 128 * 128; const float* bsp = P.in[12] + (size_t)j * 16 * 128;
    LAS bf16_t* VT = (LAS bf16_t*)F.lds;
    LAS f32x2* rowstat = (LAS f32x2*)(F.lds + 128 * 136 * 2);
    const int tid = F.tid, lane = F.lane, w = F.wave, gq = lane >> 4, rho = lane & 15;
    for (int item = blockIdx.x; item < 1024; item += gridDim.x) {
        const int g = item & 15, chunk = item >> 4, t0 = chunk * 128, c0 = g * 128;
        const int t = 16 * w + rho, nks = (w >> 1) + 1;
        u32x4 raw[4];
#pragma unroll
        for (int jj = 0; jj < 4; ++jj) { const int q_ = tid + 512 * jj; raw[jj] = *(const u32x4*)(GV + (size_t)(t0 + (q_ >> 4)) * DM + c0 + (q_ & 15) * 8); }
        f32x4 wa[4], wb[4];
#pragma unroll
        for (int ks = 0; ks < 4; ++ks) {
            wa[ks] = (f32x4){0.f, 0.f, 0.f, 0.f}; wb[ks] = wa[ks];
            if (ks < nks) { const float* wp = wsp + ((size_t)(g * 128 + t)) * 128 + 32 * ks + 8 * gq; wa[ks] = *(const f32x4*)wp; wb[ks] = *(const f32x4*)(wp + 4); }
        }
        const float bias = bsp[g * 128 + t]; const size_t rowoff = (size_t)(t0 + t) * DM + c0;
        u32x4 ur[4];
#pragma unroll
        for (int ntp = 0; ntp < 4; ++ntp) ur[ntp] = *(const u32x4*)(UZ + rowoff + 32 * ntp + 8 * gq);
        float s_ = 0.f, q2_ = 0.f;
        if (tid < 128) {
            const f32x2* sp = (const f32x2*)(stats + (size_t)(t0 + tid) * 64);
#pragma unroll 8
            for (int p = 0; p < 32; ++p) { const f32x2 v = sp[p]; s_ += v.x; q2_ += v.y; }
        }
        __syncthreads();
        if (tid < 128) {
            const float mean = s_ * (1.0f / DM), var = q2_ * (1.0f / DM) - mean * mean;
            rowstat[tid] = (f32x2){mean, rsqrtf(var + 1e-5f)};
        }
        __syncthreads();
#pragma unroll
        for (int jj = 0; jj < 4; ++jj) {
            const int q_ = tid + 512 * jj, s = q_ >> 4, cc = (q_ & 15) * 8;
            const f32x2 st = rowstat[s];
            float v[8]; unpack8(raw[jj], v);
            const f32x4 g0 = *(const f32x4*)(ln_g + c0 + cc), g1 = *(const f32x4*)(ln_g + c0 + cc + 4);
            const f32x4 b0 = *(const f32x4*)(ln_b + c0 + cc), b1 = *(const f32x4*)(ln_b + c0 + cc + 4);
#pragma unroll
            for (int e = 0; e < 8; ++e) {
                const float gg = e < 4 ? g0[e & 3] : g1[e & 3], bb = e < 4 ? b0[e & 3] : b1[e & 3];
                VT[(cc + e) * 136 + (s ^ (cc & 120))] = (bf16_t)f2bf((v[e] - st.x) * st.y * gg + bb);
            }
        }
        __syncthreads();
        bf16x8 yf[4];
#pragma unroll
        for (int ks = 0; ks < 4; ++ks) {
            const int s0 = 32 * ks + 8 * gq; float v[8];
#pragma unroll
            for (int e = 0; e < 4; ++e) { v[e] = (s0 + e <= t) ? wa[ks][e] : 0.f; v[4 + e] = (s0 + 4 + e <= t) ? wb[ks][e] : 0.f; }
            const u32x4 pk = pack8(v); yf[ks] = __builtin_bit_cast(bf16x8, pk);
        }
        f32x4 acc[4][2];
#pragma unroll
        for (int ntp = 0; ntp < 4; ++ntp)
#pragma unroll
            for (int n = 0; n < 2; ++n) {
                acc[ntp][n] = (f32x4){0.f, 0.f, 0.f, 0.f};
                const int c = 32 * ntp + 8 * (rho >> 2) + 4 * n + (rho & 3);
#pragma unroll
                for (int ks = 0; ks < 4; ++ks)
                    if (ks < nks) {
                        const bf16x8 xf = *(const LAS bf16x8*)(VT + c * 136 + ((32 * ks + 8 * gq) ^ (c & 120)));
                        acc[ntp][n] = __builtin_amdgcn_mfma_f32_16x16x32_bf16(xf, yf[ks], acc[ntp][n], 0, 0, 0);
                    }
            }
#pragma unroll
        for (int ntp = 0; ntp < 4; ++ntp) {
            const int c = 32 * ntp + 8 * gq;
            float uf[8], o[8]; unpack8(ur[ntp], uf);
#pragma unroll
            for (int e = 0; e < 8; ++e) { const float f = (e < 4 ? acc[ntp][0][e & 3] : acc[ntp][1][e & 3]) + bias; o[e] = uf[e] * f; }
            *(u32x4*)(A2 + rowoff + c) = pack8(o);
        }
    }
}

__device__ __forceinline__ void phase_attn(Frame& F, const bf16_t* Qb, const bf16_t* Kb, const bf16_t* Vb, const bf16_t* Zb, bf16_t* A2) {
    const Params& P = *F.p; const float* sinks = P.in[15];
    LAS bf16_t* KS = (LAS bf16_t*)F.lds;
    LAS bf16_t* VT = (LAS bf16_t*)(F.lds + 36864);
    LAS bf16_t* PS = (LAS bf16_t*)(F.lds + 72704 + F.wave * 5376);
    const int tid = F.tid, lane = F.lane, w = F.wave, gq = lane >> 4, rho = lane & 15;
    for (int item = blockIdx.x; item < 256; item += gridDim.x) {
        const int g = item & 3, nb = (item >> 2) & 31, b = item >> 7;
        const int tq0 = b * SEQ + nb * 128;
        __syncthreads();
#pragma unroll
        for (int jj = 0; jj < 4; ++jj) {
            const int q_ = tid + 512 * jj, key = q_ >> 3, ch = q_ & 7; const bool valid = (nb > 0) || (key >= 128);
            const size_t go = (size_t)(tq0 - 128 + key) * 256 + g * 64 + ch * 8;
            u32x4 kv = {0u, 0u, 0u, 0u}, vv = kv;
            if (valid) { kv = *(const u32x4*)(Kb + go); vv = *(const u32x4*)(Vb + go); }
            *(LAS u32x4*)(KS + key * 72 + ch * 8) = kv;
            const unsigned ww[4] = {vv.x, vv.y, vv.z, vv.w};
#pragma unroll
            for (int e = 0; e < 4; ++e) { VT[(ch * 8 + 2 * e) * 280 + key] = (bf16_t)(ww[e] & 0xffffu); VT[(ch * 8 + 2 * e + 1) * 280 + key] = (bf16_t)(ww[e] >> 16); }
        }
        if (tid < 192) { const int row = tid / 3, part = tid % 3; *(LAS u32x4*)(VT + row * 280 + 256 + part * 8) = (u32x4){0u, 0u, 0u, 0u}; }
        __syncthreads();
        const bf16_t* qbase = Qb + (size_t)(tq0 + 16 * w + rho) * DM + g * 512 + 8 * gq;
        const size_t zbase = (size_t)(tq0 + 16 * w + rho) * DM + g * 512 + 4 * gq;
        bf16x8 qn0 = *(const bf16x8*)qbase, qn1 = *(const bf16x8*)(qbase + 32);
        u32x2 zn[4];
#pragma unroll
        for (int dt = 0; dt < 4; ++dt) zn[dt] = *(const u32x2*)(Zb + zbase + 16 * dt);
        for (int r = 0; r < 8; ++r) {
            const int hq = g * 8 + r; const float sink = sinks[hq];
            const bf16x8 qf0 = qn0, qf1 = qn1;
            u32x2 zc[4];
#pragma unroll
            for (int dt = 0; dt < 4; ++dt) zc[dt] = zn[dt];
            if (r < 7) {
                qn0 = *(const bf16x8*)(qbase + 64 * (r + 1)); qn1 = *(const bf16x8*)(qbase + 64 * (r + 1) + 32);
#pragma unroll
                for (int dt = 0; dt < 4; ++dt) zn[dt] = *(const u32x2*)(Zb + zbase + 64 * (r + 1) + 16 * dt);
            }
            f32x4 sc[9];
#pragma unroll
            for (int jt = 0; jt < 9; ++jt) {
                const int kt = w + jt; const LAS bf16_t* kp = KS + (16 * kt + rho) * 72 + 8 * gq;
                const bf16x8 k0 = *(const LAS bf16x8*)kp, k1 = *(const LAS bf16x8*)(kp + 32);
                f32x4 a = {0.f, 0.f, 0.f, 0.f};
                a = __builtin_amdgcn_mfma_f32_16x16x32_bf16(qf0, k0, a, 0, 0, 0);
                a = __builtin_amdgcn_mfma_f32_16x16x32_bf16(qf1, k1, a, 0, 0, 0);
                const int kj = 16 * kt + rho;
#pragma unroll
                for (int i = 0; i < 4; ++i) { const int rel = 16 * w + 4 * gq + i + 128 - kj; const bool ok = (rel >= 0) && (rel < 128) && ((nb > 0) || (kj >= 128)); sc[jt][i] = ok ? a[i] * 0.125f : -INFINITY; }
            }
#pragma unroll
            for (int i = 0; i < 4; ++i) {
                float mx = sc[0][i];
#pragma unroll
                for (int jt = 1; jt < 9; ++jt) mx = fmaxf(mx, sc[jt][i]);
                mx = fmaxf(mx, __shfl_xor(mx, 1)); mx = fmaxf(mx, __shfl_xor(mx, 2)); mx = fmaxf(mx, __shfl_xor(mx, 4)); mx = fmaxf(mx, __shfl_xor(mx, 8));
                const float mm = fmaxf(mx, sink); float sum = 0.f;
#pragma unroll
                for (int jt = 0; jt < 9; ++jt) { const float e = __expf(sc[jt][i] - mm); sc[jt][i] = e; sum += e; }
                sum += __shfl_xor(sum, 1); sum += __shfl_xor(sum, 2); sum += __shfl_xor(sum, 4); sum += __shfl_xor(sum, 8);
                const float inv = frcp(sum + __expf(sink - mm));
#pragma unroll
                for (int jt = 0; jt < 9; ++jt) PS[(4 * gq + i) * 168 + 16 * jt + rho] = (bf16_t)f2bf(sc[jt][i] * inv);
                PS[(4 * gq + i) * 168 + 144 + rho] = 0;
            }
            asm volatile("s_waitcnt lgkmcnt(0)" ::: "memory");
            f32x4 o[4];
#pragma unroll
            for (int dt = 0; dt < 4; ++dt) o[dt] = (f32x4){0.f, 0.f, 0.f, 0.f};
#pragma unroll
            for (int ks = 0; ks < 5; ++ks) {
                const bf16x8 pf = *(const LAS bf16x8*)(PS + rho * 168 + 32 * ks + 8 * gq);
#pragma unroll
                for (int dt = 0; dt < 4; ++dt) {
                    const bf16x8 vf = *(const LAS bf16x8*)(VT + (16 * dt + rho) * 280 + 16 * w + 32 * ks + 8 * gq);
                    o[dt] = __builtin_amdgcn_mfma_f32_16x16x32_bf16(vf, pf, o[dt], 0, 0, 0);
                }
            }
            asm volatile("s_waitcnt lgkmcnt(0)" ::: "memory");
#pragma unroll
            for (int dt = 0; dt < 4; ++dt) {
                const size_t off = (size_t)(tq0 + 16 * w + rho) * DM + hq * 64 + 16 * dt + 4 * gq;
                const u32x2 zr = zc[dt];
                u32x2 pk; pk.x = pk2(o[dt][0] * bflo(zr.x), o[dt][1] * bfhi(zr.x)); pk.y = pk2(o[dt][2] * bflo(zr.y), o[dt][3] * bfhi(zr.y));
                *(u32x2*)(A2 + off) = pk;
            }
        }
    }
}

struct RwBufs { bf16_t *R, *K, *V, *KK, *B, *ZS; float *W, *bonus, *Y, *Pc, *Qc, *Sst; };
__device__ __forceinline__ RwBufs rw_bufs(unsigned char* ws) {
    RwBufs r; unsigned char* b = ws + WS_RW;
    r.R = (bf16_t*)b; r.K = (bf16_t*)(b + 32 * MiB); r.V = (bf16_t*)(b + 64 * MiB); r.KK = (bf16_t*)(b + 96 * MiB); r.B = (bf16_t*)(b + 128 * MiB);
    r.W = (float*)(b + 160 * MiB); r.ZS = (bf16_t*)(b + 224 * MiB); r.bonus = (float*)(ws + WS_BONUS);
    r.Y = (float*)(ws + WS_P); r.Pc = (float*)(ws + WS_P + 64 * MiB); r.Qc = (float*)(ws + WS_P + 96 * MiB); r.Sst = (float*)(ws + WS_XN);
    return r;
}
__device__ __forceinline__ void lerp8(const u32x4 cu4, const u32x4 pr4, const LAS float* m, float (&o)[8]) {
    float cu[8], pr[8]; unpack8(cu4, cu); unpack8(pr4, pr);
    const f32x4 m0 = *(const LAS f32x4*)m, m1 = *(const LAS f32x4*)(m + 4);
#pragma unroll
    for (int e = 0; e < 8; ++e) o[e] = cu[e] + (pr[e] - cu[e]) * (e < 4 ? m0[e & 3] : m1[e & 3]);
}
__device__ __forceinline__ void phase_rwprep(Frame& F, const bf16_t* Pb) {
    const Params& P = *F.p; const RwBufs rb = rw_bufs(P.ws);
    const float* mu = P.in[18];
    LAS bf16_t* YWH = (LAS bf16_t*)F.lds; LAS bf16_t* YWL = YWH + 32 * 104; LAS bf16_t* YA = YWL + 32 * 104;
    LAS float* PRM = (LAS float*)(F.lds + 20480);
    const bf16_t* LWH = (const bf16_t*)(P.ws + WS_LORA); const bf16_t* LWL = LWH + 2048 * 96; const bf16_t* LA = LWL + 2048 * 96;
    const int tid = F.tid, lane = F.lane, gq = lane >> 4, rho = lane & 15;
    int cur_hg = -1;
    for (int item = blockIdx.x; item < 1024; item += gridDim.x) {
        const int tt = item >> 2, hg = item & 3, t0 = tt * 32, head = hg * 8 + F.wave;
        __syncthreads();
        if (hg != cur_hg) {
            cur_hg = hg;
#pragma unroll
            for (int v = 0; v < 9; ++v) {
                const float* srcp = v < 4 ? mu + v * DM : P.in[v == 4 ? 19 : (v == 5 ? 21 : (v == 6 ? 23 : (v == 7 ? 24 : 25)))];
                PRM[v * 512 + tid] = srcp[hg * 512 + tid];
            }
        }
#pragma unroll
        for (int jj = 0; jj < 2; ++jj) {
            const int q_ = tid + 512 * jj;
            if (q_ < 768) {
                const int tok = q_ / 24, ch = q_ % 24, row = t0 + tok, col = 4 * DM + ch * 8;
                const u32x4 c4 = *(const u32x4*)(Pb + (size_t)row * N_RWP + col);
                u32x4 p4 = {0u, 0u, 0u, 0u};
                if (row & (SEQ - 1)) p4 = *(const u32x4*)(Pb + (size_t)(row - 1) * N_RWP + col);
                const f32x4 m0 = *(const f32x4*)(mu + col), m1 = *(const f32x4*)(mu + col + 4);
                float cu[8], pr[8], hi[8], lo[8]; unpack8(c4, cu); unpack8(p4, pr);
#pragma unroll
                for (int x = 0; x < 8; ++x) cu[x] = cu[x] + (pr[x] - cu[x]) * (x < 4 ? m0[x & 3] : m1[x & 3]);
                if (ch < 12) {
#pragma unroll
                    for (int x = 0; x < 8; ++x) { const float th = tanhf_(cu[x]); const unsigned h = f2bf(th); hi[x] = __builtin_bit_cast(float, h << 16); lo[x] = th - hi[x]; }
                    *(LAS u32x4*)(YWH + tok * 104 + ch * 8) = pack8(hi); *(LAS u32x4*)(YWL + tok * 104 + ch * 8) = pack8(lo);
                } else *(LAS u32x4*)(YA + tok * 104 + (ch - 12) * 8) = pack8(cu);
            }
        }
        __syncthreads();
        const int cb = head * 64 + 8 * (rho >> 2) + (rho & 3);
        float carry[2][8];
#pragma unroll
        for (int ntp = 0; ntp < 2; ++ntp)
#pragma unroll
            for (int e = 0; e < 8; ++e) carry[ntp][e] = 0.f;
#pragma unroll 1
        for (int mt = 0; mt < 2; ++mt) {
            const int row = t0 + 16 * mt + rho, t = row & (SEQ - 1), bh = (row >> 12) * 32 + head; const bool first = (t == 0);
            const size_t obase = ((size_t)bh * SEQ + t) * 64;
            const bf16_t* prow = Pb + (size_t)row * N_RWP + head * 64 + 8 * gq; const bf16_t* pprev = first ? prow : prow - N_RWP;
            const u32x4 kc0 = *(const u32x4*)(prow + DM), kc1 = *(const u32x4*)(prow + DM + 32);
            u32x4 kp0 = *(const u32x4*)(pprev + DM), kp1 = *(const u32x4*)(pprev + DM + 32);
            if (first) { kp0 = (u32x4){0u, 0u, 0u, 0u}; kp1 = kp0; }
            const u32x4 rc0 = *(const u32x4*)(prow), vc0 = *(const u32x4*)(prow + 2 * DM), zc0 = *(const u32x4*)(prow + 3 * DM);
            u32x4 rp0 = *(const u32x4*)(pprev), vp0 = *(const u32x4*)(pprev + 2 * DM), zp0 = *(const u32x4*)(pprev + 3 * DM);
            if (first) { rp0 = (u32x4){0u, 0u, 0u, 0u}; vp0 = rp0; zp0 = rp0; }
            f32x4 aw[2][2], aa[2][2];
            const int yo = (16 * mt + rho) * 104 + 8 * gq;
#pragma unroll
            for (int ntp = 0; ntp < 2; ++ntp)
#pragma unroll
                for (int n = 0; n < 2; ++n) {
                    aw[ntp][n] = (f32x4){0.f, 0.f, 0.f, 0.f}; aa[ntp][n] = aw[ntp][n];
                    const size_t xo = (size_t)(cb + 32 * ntp + 4 * n) * 96 + 8 * gq;
#pragma unroll
                    for (int k3 = 0; k3 < 3; ++k3) {
                        const bf16x8 xh = *(const bf16x8*)(LWH + xo + 32 * k3), xl = *(const bf16x8*)(LWL + xo + 32 * k3), xa = *(const bf16x8*)(LA + xo + 32 * k3);
                        const bf16x8 ywh = *(const LAS bf16x8*)(YWH + yo + 32 * k3), ywl = *(const LAS bf16x8*)(YWL + yo + 32 * k3), ya = *(const LAS bf16x8*)(YA + yo + 32 * k3);
                        aw[ntp][n] = __builtin_amdgcn_mfma_f32_16x16x32_bf16(xh, ywh, aw[ntp][n], 0, 0, 0);
                        aw[ntp][n] = __builtin_amdgcn_mfma_f32_16x16x32_bf16(xh, ywl, aw[ntp][n], 0, 0, 0);
                        aw[ntp][n] = __builtin_amdgcn_mfma_f32_16x16x32_bf16(xl, ywh, aw[ntp][n], 0, 0, 0);
                        aa[ntp][n] = __builtin_amdgcn_mfma_f32_16x16x32_bf16(xa, ya, aa[ntp][n], 0, 0, 0);
                    }
                    asm volatile("" ::: "memory");
                }
            const LAS float* prm = PRM + F.wave * 64 + 8 * gq;
            float kl[2][8]; float kkss = 0.f, bon = 0.f;
            lerp8(kc0, kp0, prm + 512, kl[0]); lerp8(kc1, kp1, prm + 512 + 32, kl[1]);
#pragma unroll
            for (int ntp = 0; ntp < 2; ++ntp) {
                const f32x4 q0 = *(const LAS f32x4*)(prm + 6 * 512 + 32 * ntp), q1 = *(const LAS f32x4*)(prm + 6 * 512 + 32 * ntp + 4);
#pragma unroll
                for (int e = 0; e < 8; ++e) { const float l = kl[ntp][e] * (e < 4 ? q0[e & 3] : q1[e & 3]); kkss += l * l; }
            }
            kkss += __shfl_xor(kkss, 16); kkss += __shfl_xor(kkss, 32);
            const float inv = 1.0f / fmaxf(sqrtf(kkss), 1e-12f);
#pragma unroll
            for (int ntp = 0; ntp < 2; ++ntp) {
                const int cl = 32 * ntp + 8 * gq;
                const f32x4 aa0 = aa[ntp][0], aa1 = aa[ntp][1];
                const LAS float* pq = prm + 32 * ntp;
                u32x4 rcx = rc0, vcx = vc0, zcx = zc0, rpx = rp0, vpx = vp0, zpx = zp0;
                if (ntp == 1) {
                    rcx = *(const u32x4*)(prow + 32); vcx = *(const u32x4*)(prow + 2 * DM + 32); zcx = *(const u32x4*)(prow + 3 * DM + 32);
                    rpx = *(const u32x4*)(pprev + 32); vpx = *(const u32x4*)(pprev + 2 * DM + 32); zpx = *(const u32x4*)(pprev + 3 * DM + 32);
                    if (first) { vpx = (u32x4){0u, 0u, 0u, 0u}; zpx = vpx; rpx = vpx; }
                }
                float lwv[8], G[8];
                { const f32x4 w0a = *(const LAS f32x4*)(pq + 4 * 512), w0b = *(const LAS f32x4*)(pq + 4 * 512 + 4);
#pragma unroll
                  for (int e = 0; e < 8; ++e) {
                    const float lw = (e < 4 ? aw[ntp][0][e & 3] + w0a[e & 3] : aw[ntp][1][e & 3] + w0b[e & 3]);
                    const float l = -DECAY_SCALE * sigmoidf_(lw); lwv[e] = l;
                    float x = l;
                    x += __builtin_bit_cast(float, __builtin_amdgcn_update_dpp(0, __builtin_bit_cast(int, x), 0x111, 0xF, 0xF, true));
                    x += __builtin_bit_cast(float, __builtin_amdgcn_update_dpp(0, __builtin_bit_cast(int, x), 0x112, 0xF, 0xF, true));
                    x += __builtin_bit_cast(float, __builtin_amdgcn_update_dpp(0, __builtin_bit_cast(int, x), 0x114, 0xF, 0xF, true));
                    x += __builtin_bit_cast(float, __builtin_amdgcn_update_dpp(0, __builtin_bit_cast(int, x), 0x118, 0xF, 0xF, true));
                    x += carry[ntp][e]; G[e] = x;
                    carry[ntp][e] = __shfl(x, (lane & 48) | 15);
                  } }
                float rl[8], vl[8], zl[8];
                lerp8(rcx, rpx, pq, rl); lerp8(vcx, vpx, pq + 2 * 512, vl); lerp8(zcx, zpx, pq + 3 * 512, zl);
#pragma unroll
                for (int e = 0; e < 8; ++e) zl[e] = siluf_(zl[e]);
                *(u32x4*)(rb.V + obase + cl) = pack8(vl);
                *(u32x4*)(rb.ZS + obase + cl) = pack8(zl);
                const f32x4 a0a = *(const LAS f32x4*)(pq + 5 * 512), a0b = *(const LAS f32x4*)(pq + 5 * 512 + 4);
                const f32x4 kka = *(const LAS f32x4*)(pq + 6 * 512), kkb = *(const LAS f32x4*)(pq + 6 * 512 + 4), kaa = *(const LAS f32x4*)(pq + 7 * 512), kab = *(const LAS f32x4*)(pq + 7 * 512 + 4);
                const f32x4 rka = *(const LAS f32x4*)(pq + 8 * 512), rkb = *(const LAS f32x4*)(pq + 8 * 512 + 4);
                float eg[8], rs[8], ks_[8], kkn[8], bbn[8];
#pragma unroll
                for (int e = 0; e < 8; ++e) {
                    const float la = (e < 4 ? aa0[e & 3] + a0a[e & 3] : aa1[e & 3] + a0b[e & 3]);
                    const float a = sigmoidf_(la);
                    const float g = G[e]; eg[e] = __expf(g); const float egn = __expf(-g), egp = __expf(g - lwv[e]);
                    const float kx = kl[ntp][e];
                    const float kk = kx * (e < 4 ? kka[e & 3] : kkb[e & 3]) * inv;
                    kkn[e] = kk * egp; bbn[e] = kk * a * egn;
                    const float kmod = kx * (1.0f + (a - 1.0f) * (e < 4 ? kaa[e & 3] : kab[e & 3]));
                    bon += rl[e] * kmod * (e < 4 ? rka[e & 3] : rkb[e & 3]);
                    ks_[e] = kmod * egn; rs[e] = rl[e] * eg[e];
                }
                *(u32x4*)(rb.KK + obase + cl) = pack8(kkn);
                *(u32x4*)(rb.B + obase + cl) = pack8(bbn);
                *(u32x4*)(rb.K + obase + cl) = pack8(ks_);
                *(u32x4*)(rb.R + obase + cl) = pack8(rs);
                if ((t & 31) == 31) {
                    float* gp = rb.W + ((size_t)bh * (SEQ / 32) + (t >> 5)) * 64 + cl;
                    *(f32x4*)gp = (f32x4){eg[0], eg[1], eg[2], eg[3]}; *(f32x4*)(gp + 4) = (f32x4){eg[4], eg[5], eg[6], eg[7]};
                }
            }
            bon += __shfl_xor(bon, 16); bon += __shfl_xor(bon, 32);
            if (gq == 0) rb.bonus[(size_t)bh * SEQ + t] = bon;
        }
    }
}

__device__ __forceinline__ float dpp_xor1(float v) { return __builtin_bit_cast(float, __builtin_amdgcn_mov_dpp(__builtin_bit_cast(int, v), 0xB1, 0xF, 0xF, true)); }
__device__ __forceinline__ float dpp_xor2(float v) { return __builtin_bit_cast(float, __builtin_amdgcn_mov_dpp(__builtin_bit_cast(int, v), 0x4E, 0xF, 0xF, true)); }

template <int MODE>
__device__ __forceinline__ void scan_task(LAS float* L, int lane, int bh, int chunk, const RwBufs& rb, const float* gn_g = nullptr, const float* gn_b = nullptr, bf16_t* A2 = nullptr) {
    const int rg = lane >> 2, ks = lane & 3;
    f32x2 s[4][8];
    const size_t mat = ((size_t)bh * NCH + chunk) * 4096;
#pragma unroll
    for (int j = 0; j < 4; ++j)
#pragma unroll
        for (int i = 0; i < 8; ++i) {
            if (MODE == 0) { const int v = 4 * rg + j, k = 16 * ks + 2 * i; s[j][i] = (f32x2){v == k ? 1.f : 0.f, v == k + 1 ? 1.f : 0.f}; }
            else if (MODE == 1) s[j][i] = (f32x2){0.f, 0.f};
            else s[j][i] = *(const f32x2*)(rb.Sst + mat + (4 * rg + j) * 64 + 16 * ks + 2 * i);
        }
    const size_t g0 = ((size_t)bh * SEQ + (size_t)chunk * CHL) * 64;
    const float* gam = rb.W + ((size_t)bh * (SEQ / 32) + (size_t)chunk * (CHL / 32)) * 64 + 16 * ks;
    u32x4 rkk, rbb, rk = {0u, 0u, 0u, 0u}, rr = rk, rv = rk;
    { const size_t go = g0 + lane * 8;
      rkk = *(const u32x4*)(rb.KK + go); rbb = *(const u32x4*)(rb.B + go);
      if (MODE != 0) { rk = *(const u32x4*)(rb.K + go); rv = *(const u32x4*)(rb.V + go); }
      if (MODE == 2) rr = *(const u32x4*)(rb.R + go); }
    f32x4 gm[4];
    const int sp = lane >> 3, ch = lane & 7, hh = bh & 31;
    f32x4 gg0 = {0.f, 0.f, 0.f, 0.f}, gg1 = gg0, gb0 = gg0, gb1 = gg0;
    if (MODE == 2) { gg0 = *(const f32x4*)(gn_g + hh * 64 + ch * 8); gg1 = *(const f32x4*)(gn_g + hh * 64 + ch * 8 + 4); gb0 = *(const f32x4*)(gn_b + hh * 64 + ch * 8); gb1 = *(const f32x4*)(gn_b + hh * 64 + ch * 8 + 4); }
    for (int blk = 0; blk < CHL / 8; ++blk) {
        LAS float* d = L + lane * 8;
        u32x4 zs4 = {0u, 0u, 0u, 0u}; float bon = 0.f;
        if (MODE == 2) { const size_t pr = (size_t)bh * SEQ + (size_t)chunk * CHL + blk * 8 + sp; zs4 = *(const u32x4*)(rb.ZS + pr * 64 + ch * 8); bon = rb.bonus[pr]; }
        { float f[8]; unpack8(rkk, f); *(LAS f32x4*)(d) = (f32x4){f[0], f[1], f[2], f[3]}; *(LAS f32x4*)(d + 4) = (f32x4){f[4], f[5], f[6], f[7]}; }
        { float f[8]; unpack8(rbb, f); *(LAS f32x4*)(d + 512) = (f32x4){f[0], f[1], f[2], f[3]}; *(LAS f32x4*)(d + 516) = (f32x4){f[4], f[5], f[6], f[7]}; }
        if (MODE != 0) {
            { float f[8]; unpack8(rk, f); *(LAS f32x4*)(d + 1024) = (f32x4){f[0], f[1], f[2], f[3]}; *(LAS f32x4*)(d + 1028) = (f32x4){f[4], f[5], f[6], f[7]}; }
            { float f[8]; unpack8(rv, f); *(LAS f32x4*)(d + 2048) = (f32x4){f[0], f[1], f[2], f[3]}; *(LAS f32x4*)(d + 2052) = (f32x4){f[4], f[5], f[6], f[7]}; }
        }
        if (MODE == 2) { float f[8]; unpack8(rr, f); *(LAS f32x4*)(d + 1536) = (f32x4){f[0], f[1], f[2], f[3]}; *(LAS f32x4*)(d + 1540) = (f32x4){f[4], f[5], f[6], f[7]}; }
        if (blk + 1 < CHL / 8) {
            const size_t go = g0 + (size_t)(blk + 1) * 512 + lane * 8;
            rkk = *(const u32x4*)(rb.KK + go); rbb = *(const u32x4*)(rb.B + go);
            if (MODE != 0) { rk = *(const u32x4*)(rb.K + go); rv = *(const u32x4*)(rb.V + go); }
            if (MODE == 2) rr = *(const u32x4*)(rb.R + go);
        }
        if ((blk & 3) == 0) {
            const float* gp = gam + (size_t)(blk >> 2) * 64;
            gm[0] = *(const f32x4*)gp; gm[1] = *(const f32x4*)(gp + 4); gm[2] = *(const f32x4*)(gp + 8); gm[3] = *(const f32x4*)(gp + 12);
        }
        asm volatile("s_waitcnt lgkmcnt(0)" ::: "memory");
#pragma unroll 1
        for (int st = 0; st < 8; ++st) {
            const LAS float* q = L + st * 64 + 16 * ks;
            f32x2 kk2[8], b2[8], k2[8], r2[8];
#pragma unroll
            for (int i4 = 0; i4 < 4; ++i4) {
                const f32x4 b = *(const LAS f32x4*)(q + 4 * i4); kk2[2 * i4] = (f32x2){b.x, b.y}; kk2[2 * i4 + 1] = (f32x2){b.z, b.w};
                const f32x4 c = *(const LAS f32x4*)(q + 512 + 4 * i4); b2[2 * i4] = (f32x2){c.x, c.y}; b2[2 * i4 + 1] = (f32x2){c.z, c.w};
                if (MODE != 0) { const f32x4 dd = *(const LAS f32x4*)(q + 1024 + 4 * i4); k2[2 * i4] = (f32x2){dd.x, dd.y}; k2[2 * i4 + 1] = (f32x2){dd.z, dd.w}; }
                if (MODE == 2) { const f32x4 e = *(const LAS f32x4*)(q + 1536 + 4 * i4); r2[2 * i4] = (f32x2){e.x, e.y}; r2[2 * i4 + 1] = (f32x2){e.z, e.w}; }
            }
            f32x4 vv = {0.f, 0.f, 0.f, 0.f};
            if (MODE != 0) vv = *(const LAS f32x4*)(L + 2048 + st * 64 + 4 * rg);
            float yv[4], sa[4];
#pragma unroll
            for (int j = 0; j < 4; ++j) {
                f32x2 a0 = s[j][0] * kk2[0], a1 = s[j][1] * kk2[1];
#pragma unroll
                for (int i = 2; i < 8; i += 2) { a0 += s[j][i] * kk2[i]; a1 += s[j][i + 1] * kk2[i + 1]; }
                const f32x2 a = a0 + a1; sa[j] = a.x + a.y;
            }
#pragma unroll
            for (int j = 0; j < 4; ++j) sa[j] += dpp_xor1(sa[j]);
#pragma unroll
            for (int j = 0; j < 4; ++j) sa[j] += dpp_xor2(sa[j]);
            if (MODE != 0) {
#pragma unroll
                for (int j = 0; j < 4; ++j) {
                    const f32x2 vj = (f32x2){vv[j], vv[j]};
#pragma unroll
                    for (int i = 0; i < 8; ++i) s[j][i] = __builtin_elementwise_fma(vj, k2[i], s[j][i]);
                }
            }
#pragma unroll
            for (int j = 0; j < 4; ++j) {
                const f32x2 nsa = (f32x2){-sa[j], -sa[j]};
#pragma unroll
                for (int i = 0; i < 8; ++i) s[j][i] = __builtin_elementwise_fma(nsa, b2[i], s[j][i]);
            }
            if (MODE == 2) {
#pragma unroll
                for (int j = 0; j < 4; ++j) {
                    f32x2 y0 = s[j][0] * r2[0], y1 = s[j][1] * r2[1];
#pragma unroll
                    for (int i = 2; i < 8; i += 2) { y0 += s[j][i] * r2[i]; y1 += s[j][i + 1] * r2[i + 1]; }
                    const f32x2 y = y0 + y1; yv[j] = y.x + y.y;
                }
#pragma unroll
                for (int j = 0; j < 4; ++j) yv[j] += dpp_xor1(yv[j]);
#pragma unroll
                for (int j = 0; j < 4; ++j) yv[j] += dpp_xor2(yv[j]);
            }
            if (MODE == 2) { if (ks == 0) *(LAS f32x4*)(L + 2560 + st * 64 + 4 * rg) = (f32x4){yv[0], yv[1], yv[2], yv[3]}; }
        }
        if (MODE == 2) {
            asm volatile("s_waitcnt lgkmcnt(0)" ::: "memory");
            const f32x4 y0 = *(const LAS f32x4*)(L + 2560 + sp * 64 + ch * 8), y1 = *(const LAS f32x4*)(L + 2560 + sp * 64 + ch * 8 + 4);
            const f32x4 v0 = *(const LAS f32x4*)(L + 2048 + sp * 64 + ch * 8), v1 = *(const LAS f32x4*)(L + 2048 + sp * 64 + ch * 8 + 4);
            float y[8] = {y0.x, y0.y, y0.z, y0.w, y1.x, y1.y, y1.z, y1.w};
            const float vf[8] = {v0.x, v0.y, v0.z, v0.w, v1.x, v1.y, v1.z, v1.w};
            float sm = 0.f;
#pragma unroll
            for (int e = 0; e < 8; ++e) sm += y[e];
            sm += __shfl_xor(sm, 1); sm += __shfl_xor(sm, 2); sm += __shfl_xor(sm, 4);
            const float mean = sm * (1.0f / 64.0f); float qq = 0.f;
#pragma unroll
            for (int e = 0; e < 8; ++e) { y[e] -= mean; qq += y[e] * y[e]; }
            qq += __shfl_xor(qq, 1); qq += __shfl_xor(qq, 2); qq += __shfl_xor(qq, 4);
            const float rstd = rsqrtf(qq * (1.0f / 64.0f) + 64e-5f);
            float zf[8], o[8]; unpack8(zs4, zf);
#pragma unroll
            for (int e = 0; e < 8; ++e) o[e] = (y[e] * rstd * (e < 4 ? gg0[e & 3] : gg1[e & 3]) + (e < 4 ? gb0[e & 3] : gb1[e & 3]) + bon * vf[e]) * zf[e];
            const size_t tok = (size_t)(bh >> 5) * SEQ + (size_t)chunk * CHL + blk * 8 + sp;
            *(u32x4*)(A2 + tok * DM + hh * 64 + ch * 8) = pack8(o);
        }
        if ((blk & 3) == 3) {
#pragma unroll
            for (int j = 0; j < 4; ++j)
#pragma unroll
                for (int i4 = 0; i4 < 4; ++i4) { s[j][2 * i4] *= (f32x2){gm[i4].x, gm[i4].y}; s[j][2 * i4 + 1] *= (f32x2){gm[i4].z, gm[i4].w}; }
        }
        asm volatile("s_waitcnt lgkmcnt(0)" ::: "memory");
    }
    if (MODE != 2) {
        float* dst = (MODE == 0 ? rb.Pc : rb.Qc) + mat;
#pragma unroll
        for (int j = 0; j < 4; ++j)
#pragma unroll
            for (int i = 0; i < 8; ++i) *(f32x2*)(dst + (4 * rg + j) * 64 + 16 * ks + 2 * i) = s[j][i];
    }
}
__device__ __forceinline__ void phase_scanA(Frame& F) {
    const RwBufs rb = rw_bufs(F.p->ws); LAS float* L = (LAS float*)(F.lds + F.wave * 12288);
    const int part = F.wave >> 2, npair = gridDim.x * 4;
    for (int bc = blockIdx.x * 4 + (F.wave & 3); bc < 64 * NCH; bc += npair) {
        const int bh = bc / NCH, chunk = bc % NCH;
        if (part == 0) scan_task<0>(L, F.lane, bh, chunk, rb); else scan_task<1>(L, F.lane, bh, chunk, rb);
    }
}
__device__ __forceinline__ void phase_scanC(Frame& F) {
    const RwBufs rb = rw_bufs(F.p->ws); LAS float* L = (LAS float*)(F.lds + F.wave * 12288);
    for (int task = F.gw; task < 64 * NCH; task += F.NGW) scan_task<2>(L, F.lane, task / NCH, task % NCH, rb, F.p->in[26], F.p->in[27], (bf16_t*)(F.p->ws + WS_A2));
}
__device__ __forceinline__ void phase_scanB(Frame& F) {
    const RwBufs rb = rw_bufs(F.p->ws);
    LAS float* SL = (LAS float*)F.lds;
    LAS float* PL = SL + 16 * 68;
    const int tid = F.tid, lane = F.lane, w = F.wave, g = lane >> 4, rho = lane & 15;
    for (int unit = blockIdx.x; unit < 256; unit += gridDim.x) {
        const int bh = unit >> 2, vq = unit & 3;
        f32x4 acc = {0.f, 0.f, 0.f, 0.f};
        const size_t rowoff = (size_t)(16 * vq + 4 * g) * 64 + 16 * (w & 3) + rho;
        if (w < 4) {
            float* d = rb.Sst + ((size_t)bh * NCH) * 4096 + rowoff;
#pragma unroll
            for (int i = 0; i < 4; ++i) d[64 * i] = 0.f;
        }
        f32x4 pa, pb; float qv[4];
        { const size_t mat = ((size_t)bh * NCH) * 4096;
          pa = *(const f32x4*)(rb.Pc + mat + tid * 8); pb = *(const f32x4*)(rb.Pc + mat + tid * 8 + 4);
#pragma unroll
          for (int i = 0; i < 4; ++i) qv[i] = rb.Qc[mat + rowoff + 64 * i]; }
        for (int c = 0; c < NCH - 1; ++c) {
            const size_t mat = ((size_t)bh * NCH + c) * 4096;
            __syncthreads();
            { const int r = tid >> 3, cc = (tid & 7) * 8; *(LAS f32x4*)(PL + r * 68 + cc) = pa; *(LAS f32x4*)(PL + r * 68 + cc + 4) = pb; }
            if (w < 4) {
#pragma unroll
                for (int i = 0; i < 4; ++i) SL[(4 * g + i) * 68 + 16 * w + rho] = acc[i];
            }
            f32x4 a0 = {qv[0], qv[1], qv[2], qv[3]};
            if (c + 1 < NCH - 1) {
                pa = *(const f32x4*)(rb.Pc + mat + 4096 + tid * 8); pb = *(const f32x4*)(rb.Pc + mat + 4096 + tid * 8 + 4);
#pragma unroll
                for (int i = 0; i < 4; ++i) qv[i] = rb.Qc[mat + 4096 + rowoff + 64 * i];
            }
            __syncthreads();
            if (w < 4) {
                f32x4 a1 = {0.f, 0.f, 0.f, 0.f};
#pragma unroll
                for (int ks = 0; ks < 16; ks += 2) {
                    const float s0 = SL[rho * 68 + 4 * ks + g], p0 = PL[(4 * ks + g) * 68 + 16 * w + rho];
                    const float s1 = SL[rho * 68 + 4 * ks + 4 + g], p1 = PL[(4 * ks + 4 + g) * 68 + 16 * w + rho];
                    a0 = __builtin_amdgcn_mfma_f32_16x16x4f32(s0, p0, a0, 0, 0, 0);
                    a1 = __builtin_amdgcn_mfma_f32_16x16x4f32(s1, p1, a1, 0, 0, 0);
                }
                acc = a0 + a1;
                float* d = rb.Sst + mat + 4096 + rowoff;
#pragma unroll
                for (int i = 0; i < 4; ++i) d[64 * i] = acc[i];
            }
        }
    }
}
__device__ __forceinline__ void phase_rwpost(Frame& F, bf16_t* A2) {
    const Params& P = *F.p; const RwBufs rb = rw_bufs(P.ws); const float* gn_g = P.in[26]; const float* gn_b = P.in[27];
    const int lane = F.lane, ch = lane & 7;
    for (int it = F.gw; it < 64 * SEQ / 8; it += F.NGW) {
        const int pair = it * 8 + (lane >> 3), bh = pair >> 12, t = pair & (SEQ - 1), h = bh & 31, b = bh >> 5, c = h * 64 + ch * 8;
        const size_t go = (size_t)pair * 64 + ch * 8;
        const f32x4 y0 = *(const f32x4*)(rb.Y + go), y1 = *(const f32x4*)(rb.Y + go + 4);
        float y[8] = {y0.x, y0.y, y0.z, y0.w, y1.x, y1.y, y1.z, y1.w};
        float s = 0.f;
#pragma unroll
        for (int e = 0; e < 8; ++e) s += y[e];
        s += __shfl_xor(s, 1); s += __shfl_xor(s, 2); s += __shfl_xor(s, 4);
        const float mean = s * (1.0f / 64.0f); float q = 0.f;
#pragma unroll
        for (int e = 0; e < 8; ++e) { y[e] -= mean; q += y[e] * y[e]; }
        q += __shfl_xor(q, 1); q += __shfl_xor(q, 2); q += __shfl_xor(q, 4);
        const float rstd = rsqrtf(q * (1.0f / 64.0f) + 64e-5f), bon = rb.bonus[pair];
        float vf[8], zf[8], o[8]; unpack8(*(const u32x4*)(rb.V + go), vf); unpack8(*(const u32x4*)(rb.ZS + go), zf);
        const f32x4 g0 = *(const f32x4*)(gn_g + c), g1 = *(const f32x4*)(gn_g + c + 4), b0 = *(const f32x4*)(gn_b + c), b1 = *(const f32x4*)(gn_b + c + 4);
#pragma unroll
        for (int e = 0; e < 8; ++e) o[e] = (y[e] * rstd * (e < 4 ? g0[e & 3] : g1[e & 3]) + (e < 4 ? b0[e & 3] : b1[e & 3]) + bon * vf[e]) * zf[e];
        *(u32x4*)(A2 + ((size_t)b * SEQ + t) * DM + c) = pack8(o);
    }
}

constexpr int LDS_BYTES = 147456;
constexpr int NPHASE = 22;
__global__ void __launch_bounds__(NTHREADS, 2) fwd(Params prm) {
    extern __shared__ __attribute__((aligned(16))) unsigned char lds_raw[];
    Frame F; F.lds = (LAS unsigned char*)lds_raw; F.tid = threadIdx.x; F.lane = F.tid & 63; F.wave = __builtin_amdgcn_readfirstlane(F.tid >> 6);
    F.gw = blockIdx.x * NWAVES + F.wave; F.NGW = gridDim.x * NWAVES; F.p = &prm;
    unsigned char* ws = prm.ws;
    volatile LAS unsigned* MISC = (volatile LAS unsigned*)(F.lds + 131072 + 8192);
    if (F.tid < 16) MISC[F.tid] = 0u;
    __syncthreads();
    XcdBarrier bar; bar.bar = (unsigned*)(ws + WS_BAR); bar.x = 0; bar.st = MISC;
#if SINGLE_LAUNCH
    bar = xcd_barrier_post((unsigned*)(ws + WS_BAR), MISC);
    if (prm.use_cg) cg::this_grid().sync();
#endif
    const int lo = prm.ph_lo, hi = prm.ph_hi;
    float* X = (float*)(ws + WS_X); bf16_t* XN = (bf16_t*)(ws + WS_XN); bf16_t* A2 = (bf16_t*)(ws + WS_A2);
    bf16_t* PB = (bf16_t*)(ws + WS_P); float* stats = (float*)(ws + WS_STATS);
    const float* macc = (const float*)(ws + WS_CTL); float* ssq = (float*)(ws + WS_SSQ); const float* biasb = (const float*)(ws + WS_BIAS);
#ifndef PHMASK
#define PHMASK 0x3fffff
#endif
#define IN(k) ((((PHMASK) >> (k)) & 1) && lo <= (k) && (k) < hi)
#ifndef REPMASK
#define REPMASK 0
#endif
#define RP(k) _Pragma("unroll 1") for (int rp_ = 0; rp_ < 1 + (((REPMASK) >> (k)) & 1); ++rp_)
#if SINGLE_LAUNCH
#define SEAM(k) do { if (IN(k) && IN((k) + 1)) xcd_barrier(bar); } while (0)
#else
#define SEAM(k) do { } while (0)
#endif
#define GEMM_IN(EPI, Wt, N_) do { pg8::Gemm g{XN, (const bf16_t*)(ws + (Wt)), M, (N_), DM}; pg8::StaticOrder S; S.init(M, (N_), gridDim.x, blockIdx.x); pg8::gemm_phase(F.lds, g, S, EPI); } while (0)
#define GEMM_OUT(layer, Wt, xin_, fuse_) do { pg8::Gemm g{A2, (const bf16_t*)(ws + (Wt)), M, DM, DM}; pg8::StaticOrder S; S.init(M, DM, gridDim.x, blockIdx.x); \
        EpiOut E{(xin_), X, macc + (size_t)(layer) * 2 * N_SG + 2 * DM, prm.in[5] + (size_t)(layer) * N_SG + 2 * DM, \
                 (fuse_) ? XN : (bf16_t*)nullptr, ssq + (size_t)((layer) + 1) * M, prm.in[3] + (size_t)((layer) + 1) * DM, macc + (size_t)((layer) + 1) * 2 * N_SG + DM, prm.in[5] + (size_t)((layer) + 1) * N_SG + DM}; \
        pg8::gemm_phase(F.lds, g, S, E); } while (0)

    if (IN(0)) RP(0) { phase_p0(F); } SEAM(0);
    if (IN(1)) RP(1) { phase_norm(F, prm.in[0], 0, XN); phase_bias(F); } SEAM(1);
    if (IN(2)) RP(2) { EpiSG E{PB, stats}; GEMM_IN(E, W_SGIN0, N_SG); } SEAM(2);
    if (IN(3)) RP(3) { phase_sgmix(F, 0, PB, PB + (size_t)M * DM, stats, A2); } SEAM(3);
    if (IN(4)) RP(4) { GEMM_OUT(0, W_SGOUT0, prm.in[0], true); } SEAM(4);
    if (IN(6)) RP(6) { EpiAdj<EpiSWA> E{{PB, PB + (size_t)M * DM, PB + (size_t)M * DM + (size_t)M * 256, PB + (size_t)2 * M * DM, (const f32x2*)(ws + WS_ROPE)}, ssq + (size_t)1 * M, biasb}; GEMM_IN(E, W_SWAIN, N_SWA); } SEAM(6);
    if (IN(7)) RP(7) { phase_attn(F, PB, PB + (size_t)M * DM, PB + (size_t)M * DM + (size_t)M * 256, PB + (size_t)2 * M * DM, A2); } SEAM(7);
    if (IN(8)) RP(8) { GEMM_OUT(1, W_SWAOUT, X, true); } SEAM(8);
    if (IN(10)) RP(10) { EpiAdj<EpiPlain> E{{PB, N_RWP}, ssq + (size_t)2 * M, biasb + (size_t)2 * N_RWP}; GEMM_IN(E, W_RWIN, N_RWP); } SEAM(10);
    if (IN(11)) RP(11) { phase_rwprep(F, PB); } SEAM(11);
    if (IN(12)) RP(12) { phase_scanA(F); } SEAM(12);
    if (IN(13)) RP(13) { phase_scanB(F); } SEAM(13);
    if (IN(14)) RP(14) { phase_scanC(F); } SEAM(14);
    if (IN(16)) RP(16) { GEMM_OUT(2, W_RWOUT, X, true); } SEAM(16);
    if (IN(18)) RP(18) { EpiAdj<EpiSG> E{{PB, stats}, ssq + (size_t)3 * M, biasb + (size_t)4 * N_RWP}; GEMM_IN(E, W_SGIN1, N_SG); } SEAM(18);
    if (IN(19)) RP(19) { phase_sgmix(F, 1, PB, PB + (size_t)M * DM, stats, A2); } SEAM(19);
    if (IN(20)) RP(20) { GEMM_OUT(3, W_SGOUT1, X, false); } SEAM(20);
    if (IN(21)) RP(21) { phase_final(F, X); }
}

extern "C" void kernel_launch(void* const* d_in, const int* in_sizes, int n_in, void* d_out, int out_size, void* d_ws, size_t ws_size, hipStream_t stream) {
    static int grid = 0;
    if (grid == 0) {
        if (n_in != 28 || out_size != M * DM || ws_size < WS_END) { fprintf(stderr, "kernel_launch: unexpected shapes (n_in %d out %d ws %zu)\n", n_in, out_size, ws_size); grid = -1; return; }
        int dev = 0, cus = 0, per_cu = 0;
        hipGetDevice(&dev); hipDeviceGetAttribute(&cus, hipDeviceAttributeMultiprocessorCount, dev);
        hipFuncSetAttribute((const void*)fwd, hipFuncAttributeMaxDynamicSharedMemorySize, LDS_BYTES);
        hipOccupancyMaxActiveBlocksPerMultiprocessor(&per_cu, (const void*)fwd, NTHREADS, LDS_BYTES);
        (void)hipGetLastError();
        if (per_cu < 1) per_cu = 1;
        grid = cus;
        if (grid > 256) grid = 256;
    }
    if (grid < 0) return;
    hipMemsetAsync((char*)d_ws + WS_CTL, 0, CTL_BYTES, stream);
    Params p{};
    for (int i = 0; i < 28; ++i) p.in[i] = (const float*)d_in[i];
    p.out = (float*)d_out; p.ws = (unsigned char*)d_ws; p.use_cg = 0; p.pad = 0;
#if SINGLE_LAUNCH
    p.ph_lo = 0; p.ph_hi = NPHASE;
    void* args[] = {&p};
    hipError_t e = hipLaunchCooperativeKernel((const void*)fwd, dim3(grid), dim3(NTHREADS), args, LDS_BYTES, stream);
    if (e != hipSuccess) fprintf(stderr, "cooperative launch failed: %s (grid %d)\n", hipGetErrorString(e), grid);
#else
    for (int ph = 0; ph < NPHASE; ++ph) {
        p.ph_lo = ph; p.ph_hi = ph + 1;
        hipLaunchKernelGGL(fwd, dim3(grid), dim3(NTHREADS), LDS_BYTES, stream, p);
    }
#endif
}
```

```cpp
#include <hip/hip_runtime.h>
#include <hip/hip_cooperative_groups.h>
#include <cstdio>
#include <cstdint>
namespace cg = cooperative_groups;

#ifndef SINGLE_LAUNCH
#define SINGLE_LAUNCH 1
#endif

#define LAS __attribute__((address_space(3)))
typedef unsigned short bf16_t;
typedef short bf16x8 __attribute__((ext_vector_type(8)));
typedef float f32x4 __attribute__((ext_vector_type(4)));
typedef float f32x2 __attribute__((ext_vector_type(2)));
typedef unsigned u32x4 __attribute__((ext_vector_type(4)));
typedef unsigned u32x2 __attribute__((ext_vector_type(2)));

constexpr int BATCH = 2, SEQ = 4096, DM = 2048, M = BATCH * SEQ;
constexpr int N_SG = 6144, N_SWA = 4608, N_RW = 8384, N_RWP = 8448;
constexpr int NWAVES = 8, NTHREADS = 512;
constexpr int NCH = 32, CHL = 128;
constexpr float DECAY_SCALE = 0.6065306597126334f;

constexpr size_t MiB = 1u << 20;
constexpr size_t WS_CTL = 0, CTL_BYTES = 1 * MiB;
constexpr size_t WS_BAR = 512 * 1024;
constexpr size_t WS_SSQ = 256 * 1024;
constexpr size_t WS_BIAS = 7 * MiB + 512 * 1024;
constexpr size_t WS_ROPE = 1 * MiB;
constexpr size_t WS_STATS = 3 * MiB;
constexpr size_t WS_BONUS = 5 * MiB;
constexpr size_t WS_LORA = 6 * MiB;
constexpr size_t WS_W = 8 * MiB;
constexpr size_t W_SGIN0 = WS_W, W_SGIN1 = W_SGIN0 + 24 * MiB, W_SGOUT0 = W_SGIN1 + 24 * MiB, W_SGOUT1 = W_SGOUT0 + 8 * MiB;
constexpr size_t W_SWAIN = W_SGOUT1 + 8 * MiB, W_SWAOUT = W_SWAIN + 18 * MiB, W_RWIN = W_SWAOUT + 8 * MiB, W_RWOUT = W_RWIN + 33 * MiB;
constexpr size_t WS_X = 140 * MiB;
constexpr size_t WS_XN = 204 * MiB;
constexpr size_t WS_A2 = 236 * MiB;
constexpr size_t WS_P = 268 * MiB;
constexpr size_t WS_RW = 400 * MiB;
constexpr size_t WS_END = 656 * MiB;
static_assert(W_RWOUT + 8 * MiB <= WS_X, "ws map");

__device__ __forceinline__ unsigned pk2(float lo, float hi) { unsigned r; asm("v_cvt_pk_bf16_f32 %0, %1, %2" : "=v"(r) : "v"(lo), "v"(hi)); return r; }
__device__ __forceinline__ unsigned f2bf(float f) { return pk2(f, 0.f) & 0xffffu; }
__device__ __forceinline__ float bflo(unsigned w) { return __builtin_bit_cast(float, w << 16); }
__device__ __forceinline__ float bfhi(unsigned w) { return __builtin_bit_cast(float, w & 0xffff0000u); }
__device__ __forceinline__ float bf2f(bf16_t h) { return __builtin_bit_cast(float, (unsigned)h << 16); }
__device__ __forceinline__ unsigned cvt_pk_bf16(float lo, float hi) { unsigned r; asm volatile("v_cvt_pk_bf16_f32 %0, %1, %2" : "=v"(r) : "v"(lo), "v"(hi)); return r; }
__device__ __forceinline__ float frcp(float x) { return __builtin_amdgcn_rcpf(x); }
__device__ __forceinline__ float sigmoidf_(float x) { return frcp(1.0f + __expf(-x)); }
__device__ __forceinline__ float siluf_(float x) { return x * frcp(1.0f + __expf(-x)); }
__device__ __forceinline__ float geluf_(float x) { return x * frcp(1.0f + __expf(-1.5957691216057308f * (x + 0.044715f * x * x * x))); }
__device__ __forceinline__ float tanhf_(float x) { return 1.0f - 2.0f * frcp(__expf(2.0f * x) + 1.0f); }
__device__ __forceinline__ float wave_sum(float v) {
#pragma unroll
    for (int o = 1; o < 64; o <<= 1) v += __shfl_xor(v, o);
    return v;
}
__device__ __forceinline__ void unpack8(u32x4 w, float (&f)[8]) {
    f[0] = bflo(w.x); f[1] = bfhi(w.x); f[2] = bflo(w.y); f[3] = bfhi(w.y); f[4] = bflo(w.z); f[5] = bfhi(w.z); f[6] = bflo(w.w); f[7] = bfhi(w.w);
}
__device__ __forceinline__ u32x4 pack8(const float (&f)[8]) {
    u32x4 w; w.x = pk2(f[0], f[1]); w.y = pk2(f[2], f[3]); w.z = pk2(f[4], f[5]); w.w = pk2(f[6], f[7]); return w;
}

namespace pg8 {
constexpr int BM = 256, BK = 64, HALF = 128, HTB = HALF * BK * 2, STAGE_BYTES = 8 * HTB, NXCD = 8, WGM = 8;
__host__ __device__ __forceinline__ int lds_byte(int r, int c) { const int st = (r >> 4) * 2 + (c >> 5), rr = r & 15, cc = c & 31, ob = rr * 64 + cc * 2; return st * 1024 + (ob ^ (((ob >> 9) & 1) << 5)); }
__host__ __device__ __forceinline__ void stage_rc(int b, int& R, int& C) { const int st = b / 1024, sb = b % 1024, swz = sb ^ (((sb >> 9) & 1) << 5); R = (st >> 1) * 16 + swz / 64; C = (st & 1) * 32 + (swz % 64) / 2; }
__host__ __device__ __forceinline__ int perm32(int rho) { const int n = rho >> 4, i = rho & 15; return 8 * (i >> 2) + 4 * n + (i & 3); }
struct Unit { int pm, pn; };
struct Gemm { const bf16_t* A; const bf16_t* Bt; int M, N, K; };
struct StaticOrder {
    int nM, nN, nwg, G, c;
    __device__ void init(int M_, int N_, int G_, int c_) { nM = M_ / BM; nN = N_ / BM; nwg = nM * nN; G = G_; c = c_; }
    __device__ bool next(int i, Unit& u) const {
        const long L = (long)i * G + c; if (L >= nwg) return false;
        int wgid = (int)L; { const int q = nwg / NXCD, r = nwg % NXCD, xcd = wgid % NXCD, off = wgid / NXCD; wgid = (xcd < r ? xcd * (q + 1) : r * (q + 1) + (xcd - r) * q) + off; }
        const int nig = WGM * nN, gid = wgid / nig, fm = gid * WGM, gsz = (nM - fm) < WGM ? (nM - fm) : WGM;
        u.pm = fm + ((wgid % nig) % gsz); u.pn = (wgid % nig) / gsz; return true;
    }
};
template <class Epi>
__device__ __forceinline__ void gemm_phase(LAS unsigned char* lds, const Gemm g, const StaticOrder& S, const Epi& E) {
    const int tid = threadIdx.x, wid = __builtin_amdgcn_readfirstlane(tid >> 6), lane = tid & 63, wr = wid >> 2, wc = wid & 3, fr = lane & 15, fq = lane >> 4;
    const int K = g.K, nt = K / BK;
    unsigned voffA[2], voffB[2];
#pragma unroll
    for (int i = 0; i < 2; ++i) { int R, C; stage_rc(tid * 16 + i * 8192, R, C); const int Rb = (R & ~31) + perm32(R & 31);
        voffA[i] = (unsigned)(R * K + C) * 2u; voffB[i] = (unsigned)(Rb * K + C) * 2u; }
    const size_t kstep = (size_t)(BK * 2);
    const size_t hstep = (size_t)HALF * K * 2;
    const size_t tstep = 2 * hstep;
    const unsigned ldsw = (unsigned)wid * 1024u;
    const int aoff = lds_byte(wr * 64 + fr, fq * 8), boff = lds_byte(wc * 32 + fr, fq * 8);
#define PG8_SA(b, h) (((b) * 2 + (h)) * HTB)
#define PG8_SB(b, h) ((4 + (b) * 2 + (h)) * HTB)
#define PG8_STAGE(bufoff, gbase, voff) do { _Pragma("unroll") for (int _i = 0; _i < 2; ++_i) \
        __builtin_amdgcn_global_load_lds((const unsigned*)((const char*)(gbase) + (voff)[_i]), (LAS unsigned*)(lds + (bufoff) + ldsw + _i * 8192), 16, 0, 0); } while (0)
#define PG8_LDA(dst, b, h) do { _Pragma("unroll") for (int m = 0; m < 4; ++m) _Pragma("unroll") for (int k = 0; k < 2; ++k) dst[m][k] = *(const LAS bf16x8*)(lds + PG8_SA(b, h) + aoff + m * 2048 + k * 1024); } while (0)
#define PG8_LDB(dst, b, h) do { _Pragma("unroll") for (int n = 0; n < 2; ++n) _Pragma("unroll") for (int k = 0; k < 2; ++k) dst[n][k] = *(const LAS bf16x8*)(lds + PG8_SB(b, h) + boff + n * 2048 + k * 1024); } while (0)
#define PG8_MMA(ai, bj, At, Bt) do { __builtin_amdgcn_s_setprio(1); _Pragma("unroll") for (int m = 0; m < 4; ++m) _Pragma("unroll") for (int n = 0; n < 2; ++n) _Pragma("unroll") for (int k = 0; k < 2; ++k) \
        acc[ai][bj][m][n] = __builtin_amdgcn_mfma_f32_16x16x32_bf16(Bt[n][k], At[m][k], acc[ai][bj][m][n], 0, 0, 0); __builtin_amdgcn_s_setprio(0); } while (0)
#define PG8_WAIT_V(n) asm volatile("s_waitcnt vmcnt(" #n ")" ::: "memory")
#define PG8_WAIT_L(n) asm volatile("s_waitcnt lgkmcnt(" #n ")" ::: "memory")
#define PG8_BAR __builtin_amdgcn_s_barrier()
#define PG8_SCHED __builtin_amdgcn_sched_barrier(0)
    Unit cur, nxt; int ui = 0;
    if (!S.next(0, cur)) return;
    f32x4 acc[2][2][4][2];
#pragma unroll
    for (int a = 0; a < 2; ++a)
#pragma unroll
        for (int b = 0; b < 2; ++b)
#pragma unroll
            for (int m = 0; m < 4; ++m)
#pragma unroll
                for (int n = 0; n < 2; ++n) acc[a][b][m][n] = (f32x4){0.f, 0.f, 0.f, 0.f};
    bf16x8 At[4][2], B0[2][2], B1[2][2];
    const char* cA = (const char*)g.A + (size_t)cur.pm * tstep; const char* cB = (const char*)g.Bt + (size_t)cur.pn * tstep;
    PG8_STAGE(PG8_SB(0, 0), cB, voffB); PG8_STAGE(PG8_SB(0, 1), cB + hstep, voffB); PG8_STAGE(PG8_SA(0, 0), cA, voffA); PG8_STAGE(PG8_SA(0, 1), cA + hstep, voffA);
    if (wr == 1) PG8_BAR;
    PG8_WAIT_V(2); PG8_BAR;
    PG8_STAGE(PG8_SB(1, 0), cB + kstep, voffB); PG8_STAGE(PG8_SA(1, 0), cA + kstep, voffA); PG8_STAGE(PG8_SB(1, 1), cB + hstep + kstep, voffB);
    PG8_WAIT_V(6); PG8_BAR;
    for (;;) {
        const bool has_next = S.next(ui + 1, nxt);
        const char* nA = has_next ? (const char*)g.A + (size_t)nxt.pm * tstep : cA; const char* nB = has_next ? (const char*)g.Bt + (size_t)nxt.pn * tstep : cB;
        for (int t = 0; t < nt; t += 2) {
            const bool last = (t == nt - 2);
            const char* a1 = cA + (size_t)(t + 1) * kstep;
            const char* a2 = last ? nA : cA + (size_t)(t + 2) * kstep; const char* b2 = last ? nB : cB + (size_t)(t + 2) * kstep;
            const char* a3 = a2 + kstep; const char* b3 = b2 + kstep;
            PG8_LDB(B0, 0, 0); PG8_LDB(B1, 0, 1); PG8_SCHED; PG8_LDA(At, 0, 0); PG8_STAGE(PG8_SA(1, 1), a1 + hstep, voffA);
            PG8_WAIT_V(8); PG8_WAIT_L(0); PG8_BAR; PG8_MMA(0, 0, At, B0); PG8_MMA(0, 1, At, B1); PG8_BAR; PG8_SCHED;
            PG8_LDA(At, 0, 1); PG8_STAGE(PG8_SB(0, 0), b2, voffB); PG8_STAGE(PG8_SB(0, 1), b2 + hstep, voffB); PG8_STAGE(PG8_SA(0, 0), a2, voffA);
            PG8_WAIT_V(8); PG8_WAIT_L(0); PG8_BAR; PG8_MMA(1, 0, At, B0); PG8_MMA(1, 1, At, B1); PG8_BAR; PG8_SCHED;
            PG8_LDB(B0, 1, 0); PG8_LDB(B1, 1, 1); PG8_SCHED; PG8_LDA(At, 1, 0); PG8_STAGE(PG8_SA(0, 1), a2 + hstep, voffA);
            PG8_WAIT_V(8); PG8_WAIT_L(0); PG8_BAR; PG8_MMA(0, 0, At, B0); PG8_MMA(0, 1, At, B1); PG8_BAR; PG8_SCHED;
            PG8_LDA(At, 1, 1); PG8_STAGE(PG8_SB(1, 0), b3, voffB); PG8_STAGE(PG8_SB(1, 1), b3 + hstep, voffB); PG8_STAGE(PG8_SA(1, 0), a3, voffA);
            PG8_WAIT_V(8); PG8_WAIT_L(0); PG8_BAR; PG8_MMA(1, 0, At, B0); PG8_MMA(1, 1, At, B1); PG8_BAR; PG8_SCHED;
        }
        if (wr == 0) PG8_BAR;
        E(acc, cur, wr, wc, fr, fq);
        if (!has_next) break;
#pragma unroll
        for (int a = 0; a < 2; ++a)
#pragma unroll
            for (int b = 0; b < 2; ++b)
#pragma unroll
                for (int m = 0; m < 4; ++m)
#pragma unroll
                    for (int n = 0; n < 2; ++n) acc[a][b][m][n] = (f32x4){0.f, 0.f, 0.f, 0.f};
        cur = nxt; cA = nA; cB = nB; ++ui;
        if (wr == 1) PG8_BAR;
    }
    PG8_WAIT_V(0);
    PG8_BAR;
#undef PG8_SA
#undef PG8_SB
#undef PG8_STAGE
#undef PG8_LDA
#undef PG8_LDB
#undef PG8_MMA
#undef PG8_WAIT_V
#undef PG8_WAIT_L
#undef PG8_BAR
#undef PG8_SCHED
}
}
using pg8::Unit;
typedef f32x4 Acc[2][2][4][2];

struct EpiSG {
    bf16_t* P0; float* stats;
    __device__ __forceinline__ void operator()(const Acc& acc, const Unit& u, int wr, int wc, int fr, int fq) const {
        const int row0 = u.pm * 256 + wr * 64 + fr;
        if (u.pn < 16) {
            const int col0 = u.pn * 128 + wc * 32 + 8 * fq;
#pragma unroll
            for (int ai = 0; ai < 2; ++ai)
#pragma unroll
                for (int m = 0; m < 4; ++m) {
                    const int row = row0 + ai * 128 + m * 16;
                    f32x4 a = acc[ai][0][m][0], b = acc[ai][0][m][1]; const f32x4 za = acc[ai][1][m][0], zb = acc[ai][1][m][1];
#pragma unroll
                    for (int e = 0; e < 4; ++e) { a[e] = geluf_(a[e]) * siluf_(za[e]); b[e] = geluf_(b[e]) * siluf_(zb[e]); }
                    u32x4 w; w.x = cvt_pk_bf16(a[0], a[1]); w.y = cvt_pk_bf16(a[2], a[3]); w.z = cvt_pk_bf16(b[0], b[1]); w.w = cvt_pk_bf16(b[2], b[3]);
                    *(u32x4*)(P0 + (size_t)row * DM + col0) = w;
                }
        } else {
            const int vt = u.pn - 16, col0 = vt * 256 + wc * 32 + 8 * fq;
            bf16_t* base = P0 + (size_t)M * DM;
#pragma unroll
            for (int ai = 0; ai < 2; ++ai)
#pragma unroll
                for (int m = 0; m < 4; ++m) {
                    const int row = row0 + ai * 128 + m * 16; float s = 0.f, q = 0.f;
#pragma unroll
                    for (int bj = 0; bj < 2; ++bj) {
                        f32x4 a = acc[ai][bj][m][0], b = acc[ai][bj][m][1];
#pragma unroll
                        for (int e = 0; e < 4; ++e) { a[e] = geluf_(a[e]); b[e] = geluf_(b[e]); }
                        s += (a[0] + a[1]) + (a[2] + a[3]) + (b[0] + b[1]) + (b[2] + b[3]);
                        q += (a[0] * a[0] + a[1] * a[1]) + (a[2] * a[2] + a[3] * a[3]) + (b[0] * b[0] + b[1] * b[1]) + (b[2] * b[2] + b[3] * b[3]);
                        u32x4 w; w.x = cvt_pk_bf16(a[0], a[1]); w.y = cvt_pk_bf16(a[2], a[3]); w.z = cvt_pk_bf16(b[0], b[1]); w.w = cvt_pk_bf16(b[2], b[3]);
                        *(u32x4*)(base + (size_t)row * DM + col0 + bj * 128) = w;
                    }
                    s += __shfl_xor(s, 16); s += __shfl_xor(s, 32); q += __shfl_xor(q, 16); q += __shfl_xor(q, 32);
                    if (fq == 0) *(f32x2*)(stats + ((size_t)row * 32 + vt * 4 + wc) * 2) = (f32x2){s, q};
                }
        }
    }
};
struct EpiSWA {
    bf16_t *Q, *Kb, *Vb, *Z; const f32x2* rope;
    __device__ __forceinline__ void operator()(const Acc& acc, const Unit& u, int wr, int wc, int fr, int fq) const {
        const int pn = u.pn; bf16_t* base; int ld, colt; bool rp = false, act = false;
        if (pn < 8) { base = Q; ld = DM; colt = pn * 256; rp = true; }
        else if (pn == 8) { base = Kb; ld = 256; colt = 0; rp = true; }
        else if (pn == 9) { base = Vb; ld = 256; colt = 0; }
        else { base = Z; ld = DM; colt = (pn - 10) * 256; act = true; }
        const int row0 = u.pm * 256 + wr * 64 + fr, col0 = colt + wc * 32 + 8 * fq;
        const int f0 = 16 * (wc & 1) + 4 * fq;
#pragma unroll
        for (int ai = 0; ai < 2; ++ai)
#pragma unroll
            for (int m = 0; m < 4; ++m) {
                const int row = row0 + ai * 128 + m * 16;
                f32x4 cs0 = {1.f, 0.f, 1.f, 0.f}, cs1 = cs0;
                if (rp) { const f32x4* rr = (const f32x4*)(rope + (size_t)row * 32 + f0); cs0 = rr[0]; cs1 = rr[1]; }
#pragma unroll
                for (int bj = 0; bj < 2; ++bj) {
                    f32x4 a = acc[ai][bj][m][0], b = acc[ai][bj][m][1];
                    if (rp) {
                        const float c0 = cs0[0], s0 = cs0[1], c1 = cs0[2], s1 = cs0[3], c2 = cs1[0], s2 = cs1[1], c3 = cs1[2], s3 = cs1[3];
                        f32x4 o1, o2;
                        o1[0] = a[0] * c0 - b[0] * s0; o2[0] = b[0] * c0 + a[0] * s0;
                        o1[1] = a[1] * c1 - b[1] * s1; o2[1] = b[1] * c1 + a[1] * s1;
                        o1[2] = a[2] * c2 - b[2] * s2; o2[2] = b[2] * c2 + a[2] * s2;
                        o1[3] = a[3] * c3 - b[3] * s3; o2[3] = b[3] * c3 + a[3] * s3;
                        a = o1; b = o2;
                    }
                    if (act) {
#pragma unroll
                        for (int e = 0; e < 4; ++e) { a[e] = siluf_(a[e]); b[e] = siluf_(b[e]); }
                    }
                    u32x4 w; w.x = cvt_pk_bf16(a[0], a[1]); w.y = cvt_pk_bf16(a[2], a[3]); w.z = cvt_pk_bf16(b[0], b[1]); w.w = cvt_pk_bf16(b[2], b[3]);
                    *(u32x4*)(base + (size_t)row * ld + col0 + bj * 128) = w;
                }
            }
    }
};
struct EpiPlain {
    bf16_t* O; int ld;
    __device__ __forceinline__ void operator()(const Acc& acc, const Unit& u, int wr, int wc, int fr, int fq) const {
        const int row0 = u.pm * 256 + wr * 64 + fr, col0 = u.pn * 256 + wc * 32 + 8 * fq;
#pragma unroll
        for (int ai = 0; ai < 2; ++ai)
#pragma unroll
            for (int m = 0; m < 4; ++m) {
                const int row = row0 + ai * 128 + m * 16;
#pragma unroll
                for (int bj = 0; bj < 2; ++bj) {
                    const f32x4 a = acc[ai][bj][m][0], b = acc[ai][bj][m][1];
                    u32x4 w; w.x = cvt_pk_bf16(a[0], a[1]); w.y = cvt_pk_bf16(a[2], a[3]); w.z = cvt_pk_bf16(b[0], b[1]); w.w = cvt_pk_bf16(b[2], b[3]);
                    *(u32x4*)(O + (size_t)row * ld + col0 + bj * 128) = w;
                }
            }
    }
};
struct EpiOut {
    const float* xin; float* xout; const float* macc; const float* mb;
    bf16_t* xb; float* ssq; const float* g; const float* macc_sc; const float* mb_sc;
    __device__ __forceinline__ void operator()(const Acc& acc, const Unit& u, int wr, int wc, int fr, int fq) const {
        const int row0 = u.pm * 256 + wr * 64 + fr, col0 = u.pn * 256 + wc * 32 + 8 * fq;
        const int b = u.pm >> 4;
        float ss[2][4];
#pragma unroll
        for (int ai = 0; ai < 2; ++ai)
#pragma unroll
            for (int m = 0; m < 4; ++m) ss[ai][m] = 0.f;
#pragma unroll
        for (int bj = 0; bj < 2; ++bj) {
            const int cj = col0 + bj * 128;
            const f32x4 gt0 = *(const f32x4*)(macc + (size_t)b * N_SG + cj) + *(const f32x4*)(mb + cj), gt1 = *(const f32x4*)(macc + (size_t)b * N_SG + cj + 4) + *(const f32x4*)(mb + cj + 4);
            f32x4 gs0 = {0.f, 0.f, 0.f, 0.f}, gs1 = gs0;
            if (xb) { gs0 = *(const f32x4*)(g + cj) * (*(const f32x4*)(macc_sc + (size_t)b * N_SG + cj) + *(const f32x4*)(mb_sc + cj) + 1.0f);
                      gs1 = *(const f32x4*)(g + cj + 4) * (*(const f32x4*)(macc_sc + (size_t)b * N_SG + cj + 4) + *(const f32x4*)(mb_sc + cj + 4) + 1.0f); }
#pragma unroll
            for (int ai = 0; ai < 2; ++ai)
#pragma unroll
                for (int m = 0; m < 4; ++m) {
                    const size_t off = (size_t)(row0 + ai * 128 + m * 16) * DM + cj;
                    const f32x4 x0 = *(const f32x4*)(xin + off) + gt0 * acc[ai][bj][m][0];
                    const f32x4 x1 = *(const f32x4*)(xin + off + 4) + gt1 * acc[ai][bj][m][1];
                    *(f32x4*)(xout + off) = x0; *(f32x4*)(xout + off + 4) = x1;
                    if (xb) {
                        ss[ai][m] += (x0[0] * x0[0] + x0[1] * x0[1]) + (x0[2] * x0[2] + x0[3] * x0[3]) + (x1[0] * x1[0] + x1[1] * x1[1]) + (x1[2] * x1[2] + x1[3] * x1[3]);
                        const f32x4 h0 = x0 * gs0, h1 = x1 * gs1;
                        u32x4 w; w.x = cvt_pk_bf16(h0[0], h0[1]); w.y = cvt_pk_bf16(h0[2], h0[3]); w.z = cvt_pk_bf16(h1[0], h1[1]); w.w = cvt_pk_bf16(h1[2], h1[3]);
                        *(u32x4*)(xb + off) = w;
                    }
                    if (m & 1) asm volatile("" ::: "memory");
                }
        }
        if (xb) {
#pragma unroll
            for (int ai = 0; ai < 2; ++ai)
#pragma unroll
                for (int m = 0; m < 4; ++m) { float s = ss[ai][m]; s += __shfl_xor(s, 16); s += __shfl_xor(s, 32); if (fq == 0) atomicAdd(ssq + row0 + ai * 128 + m * 16, s); }
        }
    }
};
template <class Inner> struct EpiAdj {
    Inner in; const float* ssq; const float* bias;
    __device__ __forceinline__ void operator()(Acc& acc, const Unit& u, int wr, int wc, int fr, int fq) const {
        const int b = u.pm >> 4, colb = u.pn * 256 + wc * 32 + 8 * fq;
        f32x4 bs[2][2];
#pragma unroll
        for (int bj = 0; bj < 2; ++bj)
#pragma unroll
            for (int n = 0; n < 2; ++n) bs[bj][n] = *(const f32x4*)(bias + (size_t)b * N_RWP + colb + bj * 128 + 4 * n);
#pragma unroll
        for (int ai = 0; ai < 2; ++ai)
#pragma unroll
            for (int m = 0; m < 4; ++m) {
                const float rstd = rsqrtf(ssq[u.pm * 256 + ai * 128 + wr * 64 + m * 16 + fr] * (1.0f / DM) + 1e-6f);
#pragma unroll
                for (int bj = 0; bj < 2; ++bj)
#pragma unroll
                    for (int n = 0; n < 2; ++n) acc[ai][bj][m][n] = acc[ai][bj][m][n] * rstd + bs[bj][n];
            }
        in(acc, u, wr, wc, fr, fq);
    }
};

struct Params { const float* in[28]; float* out; unsigned char* ws; int ph_lo, ph_hi, use_cg, pad; };

struct Frame {
    LAS unsigned char* lds; int tid, lane, wave, gw, NGW;
    const Params* p;
};

#define XB_TMO      128
#define XB_XCNT(j)  (256  + 64 * (j))
#define XB_XSUB(j)  (1280 + 64 * (j))
#define XB_XGEN(j)  (2304 + 64 * (j))
#define XB_TOP      3328
#define XB_TOPGEN   3392
#define XB_SPIN_CAP (1u << 22)
__device__ __forceinline__ unsigned xb_ld(unsigned* p)              { return __hip_atomic_load(p, __ATOMIC_RELAXED, __HIP_MEMORY_SCOPE_AGENT); }
__device__ __forceinline__ unsigned xb_add(unsigned* p, unsigned v) { return __hip_atomic_fetch_add(p, v, __ATOMIC_RELAXED, __HIP_MEMORY_SCOPE_AGENT); }
__device__ __forceinline__ unsigned xb_xcc_id() { return (unsigned)__builtin_amdgcn_s_getreg((3 << 11) | 20) & 0xFu; }
#define XB_SPIN(cond, bar) do { unsigned _sp = 0; while (cond) { __builtin_amdgcn_s_sleep(1); \
    if ((++_sp & 255u) == 0u) { if (xb_ld(&(bar)[XB_TMO])) break; if (_sp > XB_SPIN_CAP) { atomicAdd(&(bar)[XB_TMO], 1u); break; } } } } while (0)
struct XcdBarrier { unsigned* bar; unsigned x; volatile LAS unsigned* st; };
__device__ __forceinline__ XcdBarrier xcd_barrier_post(unsigned* bar, volatile LAS unsigned* st) {
    XcdBarrier b; b.bar = bar; b.x = xb_xcc_id(); b.st = st;
    if (threadIdx.x == 0) (void)xb_add(&bar[XB_XCNT(b.x)], 1u);
    return b;
}
__device__ __forceinline__ void xcd_barrier_complete(unsigned* bar, unsigned x, unsigned& nloc, unsigned& nx) {
    const unsigned G = gridDim.x * gridDim.y * gridDim.z;
    unsigned sum, cnt, mine, sp = 0u;
    for (;;) {
        sum = 0u; cnt = 0u; mine = 0u;
#pragma unroll
        for (unsigned j = 0; j < 16; ++j) { const unsigned c = xb_ld(&bar[XB_XCNT(j)]); sum += c; cnt += (c > 0u) ? 1u : 0u; mine = (j == x) ? c : mine; }
        if (sum == G) break;
        __builtin_amdgcn_s_sleep(1);
        if ((++sp & 255u) == 0u) { if (xb_ld(&bar[XB_TMO])) break; if (sp > XB_SPIN_CAP) { atomicAdd(&bar[XB_TMO], 1u); break; } }
    }
    nloc = mine > 0u ? mine : 1u; nx = cnt > 0u ? cnt : 1u;
}
__device__ __forceinline__ void xcd_barrier(const XcdBarrier& b) {
    asm volatile("s_waitcnt vmcnt(0)" ::: "memory");
    __syncthreads();
    if (threadIdx.x == 0) {
        unsigned* bar = b.bar;
        __builtin_amdgcn_s_waitcnt(0);
        unsigned nloc = b.st[0], nx = b.st[1];
        if (nloc == 0u) { xcd_barrier_complete(bar, b.x, nloc, nx); b.st[0] = nloc; b.st[1] = nx; }
        const unsigned old = xb_add(&bar[XB_XSUB(b.x)], 1u);
        const unsigned gen = old / nloc;
        if (old + 1u == (gen + 1u) * nloc) {
            __builtin_amdgcn_fence(__ATOMIC_RELEASE, "agent");
            asm volatile("s_waitcnt vmcnt(0)" ::: "memory");
            const unsigned og = xb_add(&bar[XB_TOP], 1u);
            const unsigned tg = og / nx;
            if (og + 1u == (tg + 1u) * nx) xb_add(&bar[XB_TOPGEN], 1u);
            else XB_SPIN(xb_ld(&bar[XB_TOPGEN]) == tg, bar);
            __builtin_amdgcn_fence(__ATOMIC_ACQUIRE, "agent");
            xb_add(&bar[XB_XGEN(b.x)], 1u);
            asm volatile("s_waitcnt vmcnt(0)" ::: "memory");
        } else {
            XB_SPIN(xb_ld(&bar[XB_XGEN(b.x)]) == gen, bar);
            __builtin_amdgcn_fence(__ATOMIC_ACQUIRE, "agent");
            asm volatile("s_waitcnt vmcnt(0)" ::: "memory");
        }
    }
    __syncthreads();
}

__device__ const float ROPE_INVF[32] = {1.f, 0.749894202f, 0.562341332f, 0.421696514f, 0.316227764f, 0.237137377f, 0.177827939f, 0.133352146f, 0.100000001f, 0.0749894232f, 0.0562341325f, 0.0421696492f, 0.0316227749f, 0.0237137377f, 0.0177827943f, 0.013335214f, 0.00999999978f, 0.00749894232f, 0.00562341325f, 0.00421696482f, 0.00316227763f, 0.00237137382f, 0.00177827943f, 0.00133352145f, 0.00100000005f, 0.000749894185f, 0.000562341302f, 0.000421696517f, 0.000316227757f, 0.00023713737f, 0.00017782794f, 0.00013335215f};

__device__ __forceinline__ int sg_maprow(int n) {
    if (n < DM) return (n >> 7) * 256 + (n & 127);
    if (n >= 2 * DM) { const int c = n - 2 * DM; return (c >> 7) * 256 + 128 + (c & 127); }
    return 2 * DM + (n - DM);
}
__device__ __forceinline__ int swa_maprow(int n) {
    if (n >= 2304) return n;
    const int d = n & 63, half = d >> 5, dd = d & 31, j = dd >> 2, i = dd & 3;
    return (n & ~63) + 8 * j + 4 * half + i;
}
__device__ __forceinline__ void p0_transpose_item(const float* W, int N, bf16_t* WT, int mode, LAS float* scr, int item, int lane) {
    const int nblk = N / 32, kb = item / nblk, nb = item % nblk, k0 = 64 * kb, n0 = 32 * nb;
#pragma unroll 8
    for (int i = 0; i < 32; ++i) { const int kk = 2 * i + (lane >> 5); scr[kk * 33 + (lane & 31)] = __builtin_nontemporal_load(W + (size_t)(k0 + kk) * N + n0 + (lane & 31)); }
    asm volatile("s_waitcnt lgkmcnt(0)" ::: "memory");
    const int c = lane & 7;
#pragma unroll
    for (int j = 0; j < 4; ++j) { const int n = (lane >> 3) + 8 * j; const LAS float* s = scr + (8 * c) * 33 + n;
        u32x4 o; o.x = pk2(s[0 * 33], s[1 * 33]); o.y = pk2(s[2 * 33], s[3 * 33]); o.z = pk2(s[4 * 33], s[5 * 33]); o.w = pk2(s[6 * 33], s[7 * 33]);
        const int dn = mode == 1 ? swa_maprow(n0 + n) : (mode == 2 ? sg_maprow(n0 + n) : (n0 + n));
        *(u32x4*)(WT + (size_t)dn * DM + k0 + 8 * c) = o; }
    asm volatile("s_waitcnt lgkmcnt(0)" ::: "memory");
}
__device__ __forceinline__ void phase_p0(Frame& F) {
    const Params& P = *F.p; unsigned char* ws = P.ws;
    LAS float* scr = (LAS float*)(F.lds + F.wave * 16384);
    const int lane = F.lane;
    constexpr int I_SGIN = 32 * (N_SG / 32), I_OUT = 32 * (DM / 32), I_SWAIN = 32 * (N_SWA / 32), I_RWIN = 32 * (N_RW / 32);
    constexpr int NITEMS = 2 * I_SGIN + 2 * I_OUT + I_SWAIN + I_OUT + I_RWIN + I_OUT;
#ifndef P0REP
#define P0REP 1
#endif
    _Pragma("unroll 1") for (int rep_ = 0; rep_ < P0REP; ++rep_)
    for (int it = F.gw; it < NITEMS; it += F.NGW) {
        int r = it;
        if (r < I_SGIN) { p0_transpose_item(P.in[7], N_SG, (bf16_t*)(ws + W_SGIN0), 2, scr, r, lane); continue; } r -= I_SGIN;
        if (r < I_SGIN) { p0_transpose_item(P.in[7] + (size_t)DM * N_SG, N_SG, (bf16_t*)(ws + W_SGIN1), 2, scr, r, lane); continue; } r -= I_SGIN;
        if (r < I_OUT) { p0_transpose_item(P.in[8], DM, (bf16_t*)(ws + W_SGOUT0), 0, scr, r, lane); continue; } r -= I_OUT;
        if (r < I_OUT) { p0_transpose_item(P.in[8] + (size_t)DM * DM, DM, (bf16_t*)(ws + W_SGOUT1), 0, scr, r, lane); continue; } r -= I_OUT;
        if (r < I_SWAIN) { p0_transpose_item(P.in[13], N_SWA, (bf16_t*)(ws + W_SWAIN), 1, scr, r, lane); continue; } r -= I_SWAIN;
        if (r < I_OUT) { p0_transpose_item(P.in[14], DM, (bf16_t*)(ws + W_SWAOUT), 0, scr, r, lane); continue; } r -= I_OUT;
        if (r < I_RWIN) { p0_transpose_item(P.in[16], N_RW, (bf16_t*)(ws + W_RWIN), 0, scr, r, lane); continue; } r -= I_RWIN;
        p0_transpose_item(P.in[17], DM, (bf16_t*)(ws + W_RWOUT), 0, scr, r, lane);
    }
    { u32x4* z = (u32x4*)(ws + W_RWIN + (size_t)N_RW * DM * 2); const int n16 = (N_RWP - N_RW) * DM * 2 / 16;
      for (int i = blockIdx.x * NTHREADS + F.tid; i < n16; i += gridDim.x * NTHREADS) z[i] = (u32x4){0u, 0u, 0u, 0u}; }
    { float* macc = (float*)(ws + WS_CTL); const float* cin = P.in[1]; const float* mw = P.in[4];
      LAS float* my = (LAS float*)(F.lds + F.wave * 16384);
      for (int bt = blockIdx.x; bt < 4 * 24 * 8; bt += gridDim.x) {
          const int i = bt / 192, rem = bt % 192, cgp = rem / 8, ks = (rem % 8) * 8 + F.wave, n0 = cgp * 256 + lane * 4, k0 = ks * 32;
          const float c0v = siluf_(cin[k0 + (lane & 31)]), c1v = siluf_(cin[DM + k0 + (lane & 31)]);
          f32x4 a0 = {0.f, 0.f, 0.f, 0.f}, a1 = a0;
          const float* wp = mw + ((size_t)i * DM + k0) * N_SG + n0;
#pragma unroll 8
          for (int kk = 0; kk < 32; ++kk) {
              const f32x4 w = __builtin_nontemporal_load((const f32x4*)(wp + (size_t)kk * N_SG));
              const float s0 = __builtin_bit_cast(float, __builtin_amdgcn_readlane(__builtin_bit_cast(int, c0v), kk));
              const float s1 = __builtin_bit_cast(float, __builtin_amdgcn_readlane(__builtin_bit_cast(int, c1v), kk));
              a0 += w * s0; a1 += w * s1;
          }
          *(LAS f32x4*)(my + lane * 4) = a0; *(LAS f32x4*)(my + 256 + lane * 4) = a1;
          __syncthreads();
          { const int b = F.tid >> 8, col = F.tid & 255; float s = 0.f;
#pragma unroll
            for (int w8 = 0; w8 < 8; ++w8) s += *((const LAS float*)(F.lds + w8 * 16384) + b * 256 + col);
            atomicAdd(macc + ((size_t)i * 2 + b) * N_SG + cgp * 256 + col, s); }
          __syncthreads();
      } }
    { bf16_t* LWH = (bf16_t*)(ws + WS_LORA); bf16_t* LWL = LWH + 2048 * 96; bf16_t* LA = LWL + 2048 * 96; const float* wl = P.in[20]; const float* al = P.in[22];
      for (int idx = blockIdx.x * NTHREADS + F.tid; idx < 96 * DM; idx += gridDim.x * NTHREADS) {
          const int k = idx >> 11, c = idx & (DM - 1); const float w = wl[idx]; const unsigned hi = f2bf(w);
          LWH[c * 96 + k] = (bf16_t)hi; LWL[c * 96 + k] = (bf16_t)f2bf(w - __builtin_bit_cast(float, hi << 16)); LA[c * 96 + k] = (bf16_t)f2bf(al[idx]);
      } }
    { f32x2* tab = (f32x2*)(ws + WS_ROPE); const int* pos = (const int*)P.in[2];
      for (int idx = blockIdx.x * NTHREADS + F.tid; idx < M * 32; idx += gridDim.x * NTHREADS) {
          const int m = idx >> 5, f = idx & 31;
          const float ang = (float)pos[m] * ROPE_INVF[f];
          double rev = (double)ang * 0.15915494309189535; rev -= __builtin_rint(rev);
          const float rf = (float)rev;
          tab[idx] = (f32x2){__builtin_amdgcn_cosf(rf), __builtin_amdgcn_sinf(rf)};
      } }
}

__device__ __forceinline__ void phase_norm(Frame& F, const float* xin, int layer, bf16_t* XN) {
    const Params& P = *F.p; const float* macc = (const float*)(P.ws + WS_CTL); const float* mb = P.in[5] + (size_t)layer * N_SG; const float* g = P.in[3] + (size_t)layer * DM;
    for (int row = F.gw; row < M; row += F.NGW) {
        const int b = row >> 12; const float* ma = macc + ((size_t)layer * 2 + b) * N_SG;
        const f32x4* xr = (const f32x4*)(xin + (size_t)row * DM) + F.lane;
        f32x4 v[8]; float ss = 0.f;
#pragma unroll
        for (int j = 0; j < 8; ++j) { v[j] = __builtin_nontemporal_load(xr + 64 * j); ss += (v[j].x * v[j].x + v[j].y * v[j].y) + (v[j].z * v[j].z + v[j].w * v[j].w); }
        const float rstd = rsqrtf(wave_sum(ss) * (1.0f / DM) + 1e-6f);
#pragma unroll
        for (int j = 0; j < 8; ++j) {
            const int c = 256 * j + 4 * F.lane;
            const f32x4 g4 = *(const f32x4*)(g + c);
            const f32x4 sh = *(const f32x4*)(ma + c) + *(const f32x4*)(mb + c);
            const f32x4 sc = *(const f32x4*)(ma + DM + c) + *(const f32x4*)(mb + DM + c);
            const f32x4 h = v[j] * rstd * g4 * (sc + 1.0f) + sh;
            u32x2 w; w.x = pk2(h.x, h.y); w.y = pk2(h.z, h.w);
            *(u32x2*)(XN + (size_t)row * DM + c) = w;
        }
    }
}
__device__ __forceinline__ void phase_bias(Frame& F) {
    const Params& P = *F.p; const float* macc = (const float*)(P.ws + WS_CTL); float* bias = (float*)(P.ws + WS_BIAS);
#pragma unroll 1
    for (int l = 1; l < 4; ++l) {
        const bf16_t* Wt = (const bf16_t*)(P.ws + (l == 1 ? W_SWAIN : (l == 2 ? W_RWIN : W_SGIN1))); const int N = l == 1 ? N_SWA : (l == 2 ? N_RWP : N_SG);
        f32x4 sh[2][4][2];
#pragma unroll
        for (int b = 0; b < 2; ++b)
#pragma unroll
            for (int j = 0; j < 4; ++j)
#pragma unroll
                for (int h = 0; h < 2; ++h) { const int k = 8 * F.lane + 512 * j + 4 * h; sh[b][j][h] = *(const f32x4*)(macc + ((size_t)l * 2 + b) * N_SG + k) + *(const f32x4*)(P.in[5] + (size_t)l * N_SG + k); }
        for (int n = F.gw; n < N; n += F.NGW) {
            float s0 = 0.f, s1 = 0.f;
#pragma unroll
            for (int j = 0; j < 4; ++j) {
                float w[8]; unpack8(*(const u32x4*)(Wt + (size_t)n * DM + 8 * F.lane + 512 * j), w);
#pragma unroll
                for (int e = 0; e < 8; ++e) { s0 += w[e] * sh[0][j][e >> 2][e & 3]; s1 += w[e] * sh[1][j][e >> 2][e & 3]; }
            }
            s0 = wave_sum(s0); s1 = wave_sum(s1);
            if (F.lane == 0) { bias[((size_t)(l - 1) * 2 + 0) * N_RWP + n] = s0; bias[((size_t)(l - 1) * 2 + 1) * N_RWP + n] = s1; }
        }
    }
}
__device__ __forceinline__ void phase_final(Frame& F, const float* xin) {
    const Params& P = *F.p; const float* g = P.in[6];
    for (int row = F.gw; row < M; row += F.NGW) {
        const f32x4* xr = (const f32x4*)(xin + (size_t)row * DM) + F.lane;
        f32x4 v[8]; float ss = 0.f;
#pragma unroll
        for (int j = 0; j < 8; ++j) { v[j] = __builtin_nontemporal_load(xr + 64 * j); ss += (v[j].x * v[j].x + v[j].y * v[j].y) + (v[j].z * v[j].z + v[j].w * v[j].w); }
        const float rstd = rsqrtf(wave_sum(ss) * (1.0f / DM) + 1e-6f);
        f32x4* o = (f32x4*)(P.out + (size_t)row * DM) + F.lane;
#pragma unroll
        for (int j = 0; j < 8; ++j) { const f32x4 g4 = *(const f32x4*)(g + 256 * j + 4 * F.lane); __builtin_nontemporal_store(v[j] * rstd * g4, o + 64 * j); }
    }
}

__device__ __forceinline__ void phase_sgmix(Frame& F, int j, const bf16_t* UZ, const bf16_t* GV, const float* stats, bf16_t* A2) {
    const Params& P = *F.p;
    const float* ln_g = P.in[9] + (size_t)j * DM; const float* ln_b = P.in[10] + (size_t)j * DM;
    const float* wsp = P.in[11] + (size_t)j * 16 * 128 * 128; const float* bsp = P.in[12] + (size_t)j * 16 * 128;
    LAS bf16_t* VT = (LAS bf16_t*)F.lds;
    LAS f32x2* rowstat = (LAS f32x2*)(F.lds + 128 * 136 * 2);
    const int tid = F.tid, lane = F.lane, w = F.wave, gq = lane >> 4, rho = lane & 15;
    for (int item = blockIdx.x; item < 1024; item += gridDim.x) {
        const int g = item & 15, chunk = item >> 4, t0 = chunk * 128, c0 = g * 128;
        const int t = 16 * w + rho, nks = (w >> 1) + 1;
        u32x4 raw[4];
#pragma unroll
        for (int jj = 0; jj < 4; ++jj) { const int q_ = tid + 512 * jj; raw[jj] = *(const u32x4*)(GV + (size_t)(t0 + (q_ >> 4)) * DM + c0 + (q_ & 15) * 8); }
        f32x4 wa[4], wb[4];
#pragma unroll
        for (int ks = 0; ks < 4; ++ks) {
            wa[ks] = (f32x4){0.f, 0.f, 0.f, 0.f}; wb[ks] = wa[ks];
            if (ks < nks) { const float* wp = wsp + ((size_t)(g * 128 + t)) * 128 + 32 * ks + 8 * gq; wa[ks] = *(const f32x4*)wp; wb[ks] = *(const f32x4*)(wp + 4); }
        }
        const float bias = bsp[g * 128 + t]; const size_t rowoff = (size_t)(t0 + t) * DM + c0;
        u32x4 ur[4];
#pragma unroll
        for (int ntp = 0; ntp < 4; ++ntp) ur[ntp] = *(const u32x4*)(UZ + rowoff + 32 * ntp + 8 * gq);
        float s_ = 0.f, q2_ = 0.f;
        if (tid < 128) {
            const f32x2* sp = (const f32x2*)(stats + (size_t)(t0 + tid) * 64);
#pragma unroll 8
            for (int p = 0; p < 32; ++p) { const f32x2 v = sp[p]; s_ += v.x; q2_ += v.y; }
        }
        __syncthreads();
        if (tid < 128) {
            const float mean = s_ * (1.0f / DM), var = q2_ * (1.0f / DM) - mean * mean;
            rowstat[tid] = (f32x2){mean, rsqrtf(var + 1e-5f)};
        }
        __syncthreads();
#pragma unroll
        for (int jj = 0; jj < 4; ++jj) {
            const int q_ = tid + 512 * jj, s = q_ >> 4, cc = (q_ & 15) * 8;
            const f32x2 st = rowstat[s];
            float v[8]; unpack8(raw[jj], v);
            const f32x4 g0 = *(const f32x4*)(ln_g + c0 + cc), g1 = *(const f32x4*)(ln_g + c0 + cc + 4);
            const f32x4 b0 = *(const f32x4*)(ln_b + c0 + cc), b1 = *(const f32x4*)(ln_b + c0 + cc + 4);
#pragma unroll
            for (int e = 0; e < 8; ++e) {
                const float gg = e < 4 ? g0[e & 3] : g1[e & 3], bb = e < 4 ? b0[e & 3] : b1[e & 3];
                VT[(cc + e) * 136 + (s ^ (cc & 120))] = (bf16_t)f2bf((v[e] - st.x) * st.y * gg + bb);
            }
        }
        __syncthreads();
        bf16x8 yf[4];
#pragma unroll
        for (int ks = 0; ks < 4; ++ks) {
            const int s0 = 32 * ks + 8 * gq; float v[8];
#pragma unroll
            for (int e = 0; e < 4; ++e) { v[e] = (s0 + e <= t) ? wa[ks][e] : 0.f; v[4 + e] = (s0 + 4 + e <= t) ? wb[ks][e] : 0.f; }
            const u32x4 pk = pack8(v); yf[ks] = __builtin_bit_cast(bf16x8, pk);
        }
        f32x4 acc[4][2];
#pragma unroll
        for (int ntp = 0; ntp < 4; ++ntp)
#pragma unroll
            for (int n = 0; n < 2; ++n) {
                acc[ntp][n] = (f32x4){0.f, 0.f, 0.f, 0.f};
                const int c = 32 * ntp + 8 * (rho >> 2) + 4 * n + (rho & 3);
#pragma unroll
                for (int ks = 0; ks < 4; ++ks)
                    if (ks < nks) {
                        const bf16x8 xf = *(const LAS bf16x8*)(VT + c * 136 + ((32 * ks + 8 * gq) ^ (c & 120)));
                        acc[ntp][n] = __builtin_amdgcn_mfma_f32_16x16x32_bf16(xf, yf[ks], acc[ntp][n], 0, 0, 0);
                    }
            }
#pragma unroll
        for (int ntp = 0; ntp < 4; ++ntp) {
            const int c = 32 * ntp + 8 * gq;
            float uf[8], o[8]; unpack8(ur[ntp], uf);
#pragma unroll
            for (int e = 0; e < 8; ++e) { const float f = (e < 4 ? acc[ntp][0][e & 3] : acc[ntp][1][e & 3]) + bias; o[e] = uf[e] * f; }
            *(u32x4*)(A2 + rowoff + c) = pack8(o);
        }
    }
}

__device__ __forceinline__ void phase_attn(Frame& F, const bf16_t* Qb, const bf16_t* Kb, const bf16_t* Vb, const bf16_t* Zb, bf16_t* A2) {
    const Params& P = *F.p; const float* sinks = P.in[15];
    LAS bf16_t* KS = (LAS bf16_t*)F.lds;
    LAS bf16_t* VT = (LAS bf16_t*)(F.lds + 36864);
    LAS bf16_t* PS = (LAS bf16_t*)(F.lds + 72704 + F.wave * 5376);
    const int tid = F.tid, lane = F.lane, w = F.wave, gq = lane >> 4, rho = lane & 15;
    for (int item = blockIdx.x; item < 256; item += gridDim.x) {
        const int g = item & 3, nb = (item >> 2) & 31, b = item >> 7;
        const int tq0 = b * SEQ + nb * 128;
        __syncthreads();
#pragma unroll
        for (int jj = 0; jj < 4; ++jj) {
            const int q_ = tid + 512 * jj, key = q_ >> 3, ch = q_ & 7; const bool valid = (nb > 0) || (key >= 128);
            const size_t go = (size_t)(tq0 - 128 + key) * 256 + g * 64 + ch * 8;
            u32x4 kv = {0u, 0u, 0u, 0u}, vv = kv;
            if (valid) { kv = *(const u32x4*)(Kb + go); vv = *(const u32x4*)(Vb + go); }
            *(LAS u32x4*)(KS + key * 72 + ch * 8) = kv;
            const unsigned ww[4] = {vv.x, vv.y, vv.z, vv.w};
#pragma unroll
            for (int e = 0; e < 4; ++e) { VT[(ch * 8 + 2 * e) * 280 + key] = (bf16_t)(ww[e] & 0xffffu); VT[(ch * 8 + 2 * e + 1) * 280 + key] = (bf16_t)(ww[e] >> 16); }
        }
        if (tid < 192) { const int row = tid / 3, part = tid % 3; *(LAS u32x4*)(VT + row * 280 + 256 + part * 8) = (u32x4){0u, 0u, 0u, 0u}; }
        __syncthreads();
        const bf16_t* qbase = Qb + (size_t)(tq0 + 16 * w + rho) * DM + g * 512 + 8 * gq;
        const size_t zbase = (size_t)(tq0 + 16 * w + rho) * DM + g * 512 + 4 * gq;
        bf16x8 qn0 = *(const bf16x8*)qbase, qn1 = *(const bf16x8*)(qbase + 32);
        u32x2 zn[4];
#pragma unroll
        for (int dt = 0; dt < 4; ++dt) zn[dt] = *(const u32x2*)(Zb + zbase + 16 * dt);
        for (int r = 0; r < 8; ++r) {
            const int hq = g * 8 + r; const float sink = sinks[hq];
            const bf16x8 qf0 = qn0, qf1 = qn1;
            u32x2 zc[4];
#pragma unroll
            for (int dt = 0; dt < 4; ++dt) zc[dt] = zn[dt];
            if (r < 7) {
                qn0 = *(const bf16x8*)(qbase + 64 * (r + 1)); qn1 = *(const bf16x8*)(qbase + 64 * (r + 1) + 32);
#pragma unroll
                for (int dt = 0; dt < 4; ++dt) zn[dt] = *(const u32x2*)(Zb + zbase + 64 * (r + 1) + 16 * dt);
            }
            f32x4 sc[9];
#pragma unroll
            for (int jt = 0; jt < 9; ++jt) {
                const int kt = w + jt; const LAS bf16_t* kp = KS + (16 * kt + rho) * 72 + 8 * gq;
                const bf16x8 k0 = *(const LAS bf16x8*)kp, k1 = *(const LAS bf16x8*)(kp + 32);
                f32x4 a = {0.f, 0.f, 0.f, 0.f};
                a = __builtin_amdgcn_mfma_f32_16x16x32_bf16(qf0, k0, a, 0, 0, 0);
                a = __builtin_amdgcn_mfma_f32_16x16x32_bf16(qf1, k1, a, 0, 0, 0);
                const int kj = 16 * kt + rho;
#pragma unroll
                for (int i = 0; i < 4; ++i) { const int rel = 16 * w + 4 * gq + i + 128 - kj; const bool ok = (rel >= 0) && (rel < 128) && ((nb > 0) || (kj >= 128)); sc[jt][i] = ok ? a[i] * 0.125f : -INFINITY; }
            }
#pragma unroll
            for (int i = 0; i < 4; ++i) {
                float mx = sc[0][i];
#pragma unroll
                for (int jt = 1; jt < 9; ++jt) mx = fmaxf(mx, sc[jt][i]);
                mx = fmaxf(mx, __shfl_xor(mx, 1)); mx = fmaxf(mx, __shfl_xor(mx, 2)); mx = fmaxf(mx, __shfl_xor(mx, 4)); mx = fmaxf(mx, __shfl_xor(mx, 8));
                const float mm = fmaxf(mx, sink); float sum = 0.f;
#pragma unroll
                for (int jt = 0; jt < 9; ++jt) { const float e = __expf(sc[jt][i] - mm); sc[jt][i] = e; sum += e; }
                sum += __shfl_xor(sum, 1); sum += __shfl_xor(sum, 2); sum += __shfl_xor(sum, 4); sum += __shfl_xor(sum, 8);
                const float inv = frcp(sum + __expf(sink - mm));
#pragma unroll
                for (int jt = 0; jt < 9; ++jt) PS[(4 * gq + i) * 168 + 16 * jt + rho] = (bf16_t)f2bf(sc[jt][i] * inv);
                PS[(4 * gq + i) * 168 + 144 + rho] = 0;
            }
            asm volatile("s_waitcnt lgkmcnt(0)" ::: "memory");
            f32x4 o[4];
#pragma unroll
            for (int dt = 0; dt < 4; ++dt) o[dt] = (f32x4){0.f, 0.f, 0.f, 0.f};
#pragma unroll
            for (int ks = 0; ks < 5; ++ks) {
                const bf16x8 pf = *(const LAS bf16x8*)(PS + rho * 168 + 32 * ks + 8 * gq);
#pragma unroll
                for (int dt = 0; dt < 4; ++dt) {
                    const bf16x8 vf = *(const LAS bf16x8*)(VT + (16 * dt + rho) * 280 + 16 * w + 32 * ks + 8 * gq);
                    o[dt] = __builtin_amdgcn_mfma_f32_16x16x32_bf16(vf, pf, o[dt], 0, 0, 0);
                }
            }
            asm volatile("s_waitcnt lgkmcnt(0)" ::: "memory");
#pragma unroll
            for (int dt = 0; dt < 4; ++dt) {
                const size_t off = (size_t)(tq0 + 16 * w + rho) * DM + hq * 64 + 16 * dt + 4 * gq;
                const u32x2 zr = zc[dt];
                u32x2 pk; pk.x = pk2(o[dt][0] * bflo(zr.x), o[dt][1] * bfhi(zr.x)); pk.y = pk2(o[dt][2] * bflo(zr.y), o[dt][3] * bfhi(zr.y));
                *(u32x2*)(A2 + off) = pk;
            }
        }
    }
}

struct RwBufs { bf16_t *R, *K, *V, *KK, *B, *ZS; float *W, *bonus, *Y, *Pc, *Qc, *Sst; };
__device__ __forceinline__ RwBufs rw_bufs(unsigned char* ws) {
    RwBufs r; unsigned char* b = ws + WS_RW;
    r.R = (bf16_t*)b; r.K = (bf16_t*)(b + 32 * MiB); r.V = (bf16_t*)(b + 64 * MiB); r.KK = (bf16_t*)(b + 96 * MiB); r.B = (bf16_t*)(b + 128 * MiB);
    r.W = (float*)(b + 160 * MiB); r.ZS = (bf16_t*)(b + 224 * MiB); r.bonus = (float*)(ws + WS_BONUS);
    r.Y = (float*)(ws + WS_P); r.Pc = (float*)(ws + WS_P + 64 * MiB); r.Qc = (float*)(ws + WS_P + 96 * MiB); r.Sst = (float*)(ws + WS_XN);
    return r;
}
__device__ __forceinline__ void lerp8(const u32x4 cu4, const u32x4 pr4, const LAS float* m, float (&o)[8]) {
    float cu[8], pr[8]; unpack8(cu4, cu); unpack8(pr4, pr);
    const f32x4 m0 = *(const LAS f32x4*)m, m1 = *(const LAS f32x4*)(m + 4);
#pragma unroll
    for (int e = 0; e < 8; ++e) o[e] = cu[e] + (pr[e] - cu[e]) * (e < 4 ? m0[e & 3] : m1[e & 3]);
}
__device__ __forceinline__ void phase_rwprep(Frame& F, const bf16_t* Pb) {
    const Params& P = *F.p; const RwBufs rb = rw_bufs(P.ws);
    const float* mu = P.in[18];
    LAS bf16_t* YWH = (LAS bf16_t*)F.lds; LAS bf16_t* YWL = YWH + 32 * 104; LAS bf16_t* YA = YWL + 32 * 104;
    LAS float* PRM = (LAS float*)(F.lds + 20480);
    const bf16_t* LWH = (const bf16_t*)(P.ws + WS_LORA); const bf16_t* LWL = LWH + 2048 * 96; const bf16_t* LA = LWL + 2048 * 96;
    const int tid = F.tid, lane = F.lane, gq = lane >> 4, rho = lane & 15;
    int cur_hg = -1;
    for (int item = blockIdx.x; item < 1024; item += gridDim.x) {
        const int tt = item >> 2, hg = item & 3, t0 = tt * 32, head = hg * 8 + F.wave;
        __syncthreads();
        if (hg != cur_hg) {
            cur_hg = hg;
#pragma unroll
            for (int v = 0; v < 9; ++v) {
                const float* srcp = v < 4 ? mu + v * DM : P.in[v == 4 ? 19 : (v == 5 ? 21 : (v == 6 ? 23 : (v == 7 ? 24 : 25)))];
                PRM[v * 512 + tid] = srcp[hg * 512 + tid];
            }
        }
#pragma unroll
        for (int jj = 0; jj < 2; ++jj) {
            const int q_ = tid + 512 * jj;
            if (q_ < 768) {
                const int tok = q_ / 24, ch = q_ % 24, row = t0 + tok, col = 4 * DM + ch * 8;
                const u32x4 c4 = *(const u32x4*)(Pb + (size_t)row * N_RWP + col);
                u32x4 p4 = {0u, 0u, 0u, 0u};
                if (row & (SEQ - 1)) p4 = *(const u32x4*)(Pb + (size_t)(row - 1) * N_RWP + col);
                const f32x4 m0 = *(const f32x4*)(mu + col), m1 = *(const f32x4*)(mu + col + 4);
                float cu[8], pr[8], hi[8], lo[8]; unpack8(c4, cu); unpack8(p4, pr);
#pragma unroll
                for (int x = 0; x < 8; ++x) cu[x] = cu[x] + (pr[x] - cu[x]) * (x < 4 ? m0[x & 3] : m1[x & 3]);
                if (ch < 12) {
#pragma unroll
                    for (int x = 0; x < 8; ++x) { const float th = tanhf_(cu[x]); const unsigned h = f2bf(th); hi[x] = __builtin_bit_cast(float, h << 16); lo[x] = th - hi[x]; }
                    *(LAS u32x4*)(YWH + tok * 104 + ch * 8) = pack8(hi); *(LAS u32x4*)(YWL + tok * 104 + ch * 8) = pack8(lo);
                } else *(LAS u32x4*)(YA + tok * 104 + (ch - 12) * 8) = pack8(cu);
            }
        }
        __syncthreads();
        const int cb = head * 64 + 8 * (rho >> 2) + (rho & 3);
        float carry[2][8];
#pragma unroll
        for (int ntp = 0; ntp < 2; ++ntp)
#pragma unroll
            for (int e = 0; e < 8; ++e) carry[ntp][e] = 0.f;
#pragma unroll 1
        for (int mt = 0; mt < 2; ++mt) {
            const int row = t0 + 16 * mt + rho, t = row & (SEQ - 1), bh = (row >> 12) * 32 + head; const bool first = (t == 0);
            const size_t obase = ((size_t)bh * SEQ + t) * 64;
            const bf16_t* prow = Pb + (size_t)row * N_RWP + head * 64 + 8 * gq; const bf16_t* pprev = first ? prow : prow - N_RWP;
            const u32x4 kc0 = *(const u32x4*)(prow + DM), kc1 = *(const u32x4*)(prow + DM + 32);
            u32x4 kp0 = *(const u32x4*)(pprev + DM), kp1 = *(const u32x4*)(pprev + DM + 32);
            if (first) { kp0 = (u32x4){0u, 0u, 0u, 0u}; kp1 = kp0; }
            const u32x4 rc0 = *(const u32x4*)(prow), vc0 = *(const u32x4*)(prow + 2 * DM), zc0 = *(const u32x4*)(prow + 3 * DM);
            u32x4 rp0 = *(const u32x4*)(pprev), vp0 = *(const u32x4*)(pprev + 2 * DM), zp0 = *(const u32x4*)(pprev + 3 * DM);
            if (first) { rp0 = (u32x4){0u, 0u, 0u, 0u}; vp0 = rp0; zp0 = rp0; }
            f32x4 aw[2][2], aa[2][2];
            const int yo = (16 * mt + rho) * 104 + 8 * gq;
#pragma unroll
            for (int ntp = 0; ntp < 2; ++ntp)
#pragma unroll
                for (int n = 0; n < 2; ++n) {
                    aw[ntp][n] = (f32x4){0.f, 0.f, 0.f, 0.f}; aa[ntp][n] = aw[ntp][n];
                    const size_t xo = (size_t)(cb + 32 * ntp + 4 * n) * 96 + 8 * gq;
#pragma unroll
                    for (int k3 = 0; k3 < 3; ++k3) {
                        const bf16x8 xh = *(const bf16x8*)(LWH + xo + 32 * k3), xl = *(const bf16x8*)(LWL + xo + 32 * k3), xa = *(const bf16x8*)(LA + xo + 32 * k3);
                        const bf16x8 ywh = *(const LAS bf16x8*)(YWH + yo + 32 * k3), ywl = *(const LAS bf16x8*)(YWL + yo + 32 * k3), ya = *(const LAS bf16x8*)(YA + yo + 32 * k3);
                        aw[ntp][n] = __builtin_amdgcn_mfma_f32_16x16x32_bf16(xh, ywh, aw[ntp][n], 0, 0, 0);
                        aw[ntp][n] = __builtin_amdgcn_mfma_f32_16x16x32_bf16(xh, ywl, aw[ntp][n], 0, 0, 0);
                        aw[ntp][n] = __builtin_amdgcn_mfma_f32_16x16x32_bf16(xl, ywh, aw[ntp][n], 0, 0, 0);
                        aa[ntp][n] = __builtin_amdgcn_mfma_f32_16x16x32_bf16(xa, ya, aa[ntp][n], 0, 0, 0);
                    }
                    asm volatile("" ::: "memory");
                }
            const LAS float* prm = PRM + F.wave * 64 + 8 * gq;
            float kl[2][8]; float kkss = 0.f, bon = 0.f;
            lerp8(kc0, kp0, prm + 512, kl[0]); lerp8(kc1, kp1, prm + 512 + 32, kl[1]);
#pragma unroll
            for (int ntp = 0; ntp < 2; ++ntp) {
                const f32x4 q0 = *(const LAS f32x4*)(prm + 6 * 512 + 32 * ntp), q1 = *(const LAS f32x4*)(prm + 6 * 512 + 32 * ntp + 4);
#pragma unroll
                for (int e = 0; e < 8; ++e) { const float l = kl[ntp][e] * (e < 4 ? q0[e & 3] : q1[e & 3]); kkss += l * l; }
            }
            kkss += __shfl_xor(kkss, 16); kkss += __shfl_xor(kkss, 32);
            const float inv = 1.0f / fmaxf(sqrtf(kkss), 1e-12f);
#pragma unroll
            for (int ntp = 0; ntp < 2; ++ntp) {
                const int cl = 32 * ntp + 8 * gq;
                const f32x4 aa0 = aa[ntp][0], aa1 = aa[ntp][1];
                const LAS float* pq = prm + 32 * ntp;
                u32x4 rcx = rc0, vcx = vc0, zcx = zc0, rpx = rp0, vpx = vp0, zpx = zp0;
                if (ntp == 1) {
                    rcx = *(const u32x4*)(prow + 32); vcx = *(const u32x4*)(prow + 2 * DM + 32); zcx = *(const u32x4*)(prow + 3 * DM + 32);
                    rpx = *(const u32x4*)(pprev + 32); vpx = *(const u32x4*)(pprev + 2 * DM + 32); zpx = *(const u32x4*)(pprev + 3 * DM + 32);
                    if (first) { vpx = (u32x4){0u, 0u, 0u, 0u}; zpx = vpx; rpx = vpx; }
                }
                float lwv[8], G[8];
                { const f32x4 w0a = *(const LAS f32x4*)(pq + 4 * 512), w0b = *(const LAS f32x4*)(pq + 4 * 512 + 4);
#pragma unroll
                  for (int e = 0; e < 8; ++e) {
                    const float lw = (e < 4 ? aw[ntp][0][e & 3] + w0a[e & 3] : aw[ntp][1][e & 3] + w0b[e & 3]);
                    const float l = -DECAY_SCALE * sigmoidf_(lw); lwv[e] = l;
                    float x = l;
                    x += __builtin_bit_cast(float, __builtin_amdgcn_update_dpp(0, __builtin_bit_cast(int, x), 0x111, 0xF, 0xF, true));
                    x += __builtin_bit_cast(float, __builtin_amdgcn_update_dpp(0, __builtin_bit_cast(int, x), 0x112, 0xF, 0xF, true));
                    x += __builtin_bit_cast(float, __builtin_amdgcn_update_dpp(0, __builtin_bit_cast(int, x), 0x114, 0xF, 0xF, true));
                    x += __builtin_bit_cast(float, __builtin_amdgcn_update_dpp(0, __builtin_bit_cast(int, x), 0x118, 0xF, 0xF, true));
                    x += carry[ntp][e]; G[e] = x;
                    carry[ntp][e] = __shfl(x, (lane & 48) | 15);
                  } }
                float rl[8], vl[8], zl[8];
                lerp8(rcx, rpx, pq, rl); lerp8(vcx, vpx, pq + 2 * 512, vl); lerp8(zcx, zpx, pq + 3 * 512, zl);
#pragma unroll
                for (int e = 0; e < 8; ++e) zl[e] = siluf_(zl[e]);
                *(u32x4*)(rb.V + obase + cl) = pack8(vl);
                *(u32x4*)(rb.ZS + obase + cl) = pack8(zl);
                const f32x4 a0a = *(const LAS f32x4*)(pq + 5 * 512), a0b = *(const LAS f32x4*)(pq + 5 * 512 + 4);
                const f32x4 kka = *(const LAS f32x4*)(pq + 6 * 512), kkb = *(const LAS f32x4*)(pq + 6 * 512 + 4), kaa = *(const LAS f32x4*)(pq + 7 * 512), kab = *(const LAS f32x4*)(pq + 7 * 512 + 4);
                const f32x4 rka = *(const LAS f32x4*)(pq + 8 * 512), rkb = *(const LAS f32x4*)(pq + 8 * 512 + 4);
                float eg[8], rs[8], ks_[8], kkn[8], bbn[8];
#pragma unroll
                for (int e = 0; e < 8; ++e) {
                    const float la = (e < 4 ? aa0[e & 3] + a0a[e & 3] : aa1[e & 3] + a0b[e & 3]);
                    const float a = sigmoidf_(la);
                    const float g = G[e]; eg[e] = __expf(g); const float egn = __expf(-g), egp = __expf(g - lwv[e]);
                    const float kx = kl[ntp][e];
                    const float kk = kx * (e < 4 ? kka[e & 3] : kkb[e & 3]) * inv;
                    kkn[e] = kk * egp; bbn[e] = kk * a * egn;
                    const float kmod = kx * (1.0f + (a - 1.0f) * (e < 4 ? kaa[e & 3] : kab[e & 3]));
                    bon += rl[e] * kmod * (e < 4 ? rka[e & 3] : rkb[e & 3]);
                    ks_[e] = kmod * egn; rs[e] = rl[e] * eg[e];
                }
                *(u32x4*)(rb.KK + obase + cl) = pack8(kkn);
                *(u32x4*)(rb.B + obase + cl) = pack8(bbn);
                *(u32x4*)(rb.K + obase + cl) = pack8(ks_);
                *(u32x4*)(rb.R + obase + cl) = pack8(rs);
                if ((t & 31) == 31) {
                    float* gp = rb.W + ((size_t)bh * (SEQ / 32) + (t >> 5)) * 64 + cl;
                    *(f32x4*)gp = (f32x4){eg[0], eg[1], eg[2], eg[3]}; *(f32x4*)(gp + 4) = (f32x4){eg[4], eg[5], eg[6], eg[7]};
                }
            }
            bon += __shfl_xor(bon, 16); bon += __shfl_xor(bon, 32);
            if (gq == 0) rb.bonus[(size_t)bh * SEQ + t] = bon;
        }
    }
}

__device__ __forceinline__ float dpp_xor1(float v) { return __builtin_bit_cast(float, __builtin_amdgcn_mov_dpp(__builtin_bit_cast(int, v), 0xB1, 0xF, 0xF, true)); }
__device__ __forceinline__ float dpp_xor2(float v) { return __builtin_bit_cast(float, __builtin_amdgcn_mov_dpp(__builtin_bit_cast(int, v), 0x4E, 0xF, 0xF, true)); }

template <int MODE>
__device__ __forceinline__ void scan_task(LAS float* L, int lane, int bh, int chunk, const RwBufs& rb, const float* gn_g = nullptr, const float* gn_b = nullptr, bf16_t* A2 = nullptr) {
    const int rg = lane >> 2, ks = lane & 3;
    f32x2 s[4][8];
    const size_t mat = ((size_t)bh * NCH + chunk) * 4096;
#pragma unroll
    for (int j = 0; j < 4; ++j)
#pragma unroll
        for (int i = 0; i < 8; ++i) {
            if (MODE == 0) { const int v = 4 * rg + j, k = 16 * ks + 2 * i; s[j][i] = (f32x2){v == k ? 1.f : 0.f, v == k + 1 ? 1.f : 0.f}; }
            else if (MODE == 1) s[j][i] = (f32x2){0.f, 0.f};
            else s[j][i] = *(const f32x2*)(rb.Sst + mat + (4 * rg + j) * 64 + 16 * ks + 2 * i);
        }
    const size_t g0 = ((size_t)bh * SEQ + (size_t)chunk * CHL) * 64;
    const float* gam = rb.W + ((size_t)bh * (SEQ / 32) + (size_t)chunk * (CHL / 32)) * 64 + 16 * ks;
    u32x4 rkk, rbb, rk = {0u, 0u, 0u, 0u}, rr = rk, rv = rk;
    { const size_t go = g0 + lane * 8;
      rkk = *(const u32x4*)(rb.KK + go); rbb = *(const u32x4*)(rb.B + go);
      if (MODE != 0) { rk = *(const u32x4*)(rb.K + go); rv = *(const u32x4*)(rb.V + go); }
      if (MODE == 2) rr = *(const u32x4*)(rb.R + go); }
    f32x4 gm[4];
    const int sp = lane >> 3, ch = lane & 7, hh = bh & 31;
    f32x4 gg0 = {0.f, 0.f, 0.f, 0.f}, gg1 = gg0, gb0 = gg0, gb1 = gg0;
    if (MODE == 2) { gg0 = *(const f32x4*)(gn_g + hh * 64 + ch * 8); gg1 = *(const f32x4*)(gn_g + hh * 64 + ch * 8 + 4); gb0 = *(const f32x4*)(gn_b + hh * 64 + ch * 8); gb1 = *(const f32x4*)(gn_b + hh * 64 + ch * 8 + 4); }
    for (int blk = 0; blk < CHL / 8; ++blk) {
        LAS float* d = L + lane * 8;
        u32x4 zs4 = {0u, 0u, 0u, 0u}; float bon = 0.f;
        if (MODE == 2) { const size_t pr = (size_t)bh * SEQ + (size_t)chunk * CHL + blk * 8 + sp; zs4 = *(const u32x4*)(rb.ZS + pr * 64 + ch * 8); bon = rb.bonus[pr]; }
        { float f[8]; unpack8(rkk, f); *(LAS f32x4*)(d) = (f32x4){f[0], f[1], f[2], f[3]}; *(LAS f32x4*)(d + 4) = (f32x4){f[4], f[5], f[6], f[7]}; }
        { float f[8]; unpack8(rbb, f); *(LAS f32x4*)(d + 512) = (f32x4){f[0], f[1], f[2], f[3]}; *(LAS f32x4*)(d + 516) = (f32x4){f[4], f[5], f[6], f[7]}; }
        if (MODE != 0) {
            { float f[8]; unpack8(rk, f); *(LAS f32x4*)(d + 1024) = (f32x4){f[0], f[1], f[2], f[3]}; *(LAS f32x4*)(d + 1028) = (f32x4){f[4], f[5], f[6], f[7]}; }
            { float f[8]; unpack8(rv, f); *(LAS f32x4*)(d + 2048) = (f32x4){f[0], f[1], f[2], f[3]}; *(LAS f32x4*)(d + 2052) = (f32x4){f[4], f[5], f[6], f[7]}; }
        }
        if (MODE == 2) { float f[8]; unpack8(rr, f); *(LAS f32x4*)(d + 1536) = (f32x4){f[0], f[1], f[2], f[3]}; *(LAS f32x4*)(d + 1540) = (f32x4){f[4], f[5], f[6], f[7]}; }
        if (blk + 1 < CHL / 8) {
            const size_t go = g0 + (size_t)(blk + 1) * 512 + lane * 8;
            rkk = *(const u32x4*)(rb.KK + go); rbb = *(const u32x4*)(rb.B + go);
            if (MODE != 0) { rk = *(const u32x4*)(rb.K + go); rv = *(const u32x4*)(rb.V + go); }
            if (MODE == 2) rr = *(const u32x4*)(rb.R + go);
        }
        if ((blk & 3) == 0) {
            const float* gp = gam + (size_t)(blk >> 2) * 64;
            gm[0] = *(const f32x4*)gp; gm[1] = *(const f32x4*)(gp + 4); gm[2] = *(const f32x4*)(gp + 8); gm[3] = *(const f32x4*)(gp + 12);
        }
        asm volatile("s_waitcnt lgkmcnt(0)" ::: "memory");
#pragma unroll 1
        for (int st = 0; st < 8; ++st) {
            const LAS float* q = L + st * 64 + 16 * ks;
            f32x2 kk2[8], b2[8], k2[8], r2[8];
#pragma unroll
            for (int i4 = 0; i4 < 4; ++i4) {
                const f32x4 b = *(const LAS f32x4*)(q + 4 * i4); kk2[2 * i4] = (f32x2){b.x, b.y}; kk2[2 * i4 + 1] = (f32x2){b.z, b.w};
                const f32x4 c = *(const LAS f32x4*)(q + 512 + 4 * i4); b2[2 * i4] = (f32x2){c.x, c.y}; b2[2 * i4 + 1] = (f32x2){c.z, c.w};
                if (MODE != 0) { const f32x4 dd = *(const LAS f32x4*)(q + 1024 + 4 * i4); k2[2 * i4] = (f32x2){dd.x, dd.y}; k2[2 * i4 + 1] = (f32x2){dd.z, dd.w}; }
                if (MODE == 2) { const f32x4 e = *(const LAS f32x4*)(q + 1536 + 4 * i4); r2[2 * i4] = (f32x2){e.x, e.y}; r2[2 * i4 + 1] = (f32x2){e.z, e.w}; }
            }
            f32x4 vv = {0.f, 0.f, 0.f, 0.f};
            if (MODE != 0) vv = *(const LAS f32x4*)(L + 2048 + st * 64 + 4 * rg);
            float yv[4], sa[4];
#pragma unroll
            for (int j = 0; j < 4; ++j) {
                f32x2 a0 = s[j][0] * kk2[0], a1 = s[j][1] * kk2[1];
#pragma unroll
                for (int i = 2; i < 8; i += 2) { a0 += s[j][i] * kk2[i]; a1 += s[j][i + 1] * kk2[i + 1]; }
                const f32x2 a = a0 + a1; sa[j] = a.x + a.y;
            }
#pragma unroll
            for (int j = 0; j < 4; ++j) sa[j] += dpp_xor1(sa[j]);
#pragma unroll
            for (int j = 0; j < 4; ++j) sa[j] += dpp_xor2(sa[j]);
            if (MODE != 0) {
#pragma unroll
                for (int j = 0; j < 4; ++j) {
                    const f32x2 vj = (f32x2){vv[j], vv[j]};
#pragma unroll
                    for (int i = 0; i < 8; ++i) s[j][i] = __builtin_elementwise_fma(vj, k2[i], s[j][i]);
                }
            }
#pragma unroll
            for (int j = 0; j < 4; ++j) {
                const f32x2 nsa = (f32x2){-sa[j], -sa[j]};
#pragma unroll
                for (int i = 0; i < 8; ++i) s[j][i] = __builtin_elementwise_fma(nsa, b2[i], s[j][i]);
            }
            if (MODE == 2) {
#pragma unroll
                for (int j = 0; j < 4; ++j) {
                    f32x2 y0 = s[j][0] * r2[0], y1 = s[j][1] * r2[1];
#pragma unroll
                    for (int i = 2; i < 8; i += 2) { y0 += s[j][i] * r2[i]; y1 += s[j][i + 1] * r2[i + 1]; }
                    const f32x2 y = y0 + y1; yv[j] = y.x + y.y;
                }
#pragma unroll
                for (int j = 0; j < 4; ++j) yv[j] += dpp_xor1(yv[j]);
#pragma unroll
                for (int j = 0; j < 4; ++j) yv[j] += dpp_xor2(yv[j]);
            }
            if (MODE == 2) { if (ks == 0) *(LAS f32x4*)(L + 2560 + st * 64 + 4 * rg) = (f32x4){yv[0], yv[1], yv[2], yv[3]}; }
        }
        if (MODE == 2) {
            asm volatile("s_waitcnt lgkmcnt(0)" ::: "memory");
            const f32x4 y0 = *(const LAS f32x4*)(L + 2560 + sp * 64 + ch * 8), y1 = *(const LAS f32x4*)(L + 2560 + sp * 64 + ch * 8 + 4);
            const f32x4 v0 = *(const LAS f32x4*)(L + 2048 + sp * 64 + ch * 8), v1 = *(const LAS f32x4*)(L + 2048 + sp * 64 + ch * 8 + 4);
            float y[8] = {y0.x, y0.y, y0.z, y0.w, y1.x, y1.y, y1.z, y1.w};
            const float vf[8] = {v0.x, v0.y, v0.z, v0.w, v1.x, v1.y, v1.z, v1.w};
            float sm = 0.f;
#pragma unroll
            for (int e = 0; e < 8; ++e) sm += y[e];
            sm += __shfl_xor(sm, 1); sm += __shfl_xor(sm, 2); sm += __shfl_xor(sm, 4);
            const float mean = sm * (1.0f / 64.0f); float qq = 0.f;
#pragma unroll
            for (int e = 0; e < 8; ++e) { y[e] -= mean; qq += y[e] * y[e]; }
            qq += __shfl_xor(qq, 1); qq += __shfl_xor(qq, 2); qq += __shfl_xor(qq, 4);
            const float rstd = rsqrtf(qq * (1.0f / 64.0f) + 64e-5f);
            float zf[8], o[8]; unpack8(zs4, zf);
#pragma unroll
            for (int e = 0; e < 8; ++e) o[e] = (y[e] * rstd * (e < 4 ? gg0[e & 3] : gg1[e & 3]) + (e < 4 ? gb0[e & 3] : gb1[e & 3]) + bon * vf[e]) * zf[e];
            const size_t tok = (size_t)(bh >> 5) * SEQ + (size_t)chunk * CHL + blk * 8 + sp;
            *(u32x4*)(A2 + tok * DM + hh * 64 + ch * 8) = pack8(o);
        }
        if ((blk & 3) == 3) {
#pragma unroll
            for (int j = 0; j < 4; ++j)
#pragma unroll
                for (int i4 = 0; i4 < 4; ++i4) { s[j][2 * i4] *= (f32x2){gm[i4].x, gm[i4].y}; s[j][2 * i4 + 1] *= (f32x2){gm[i4].z, gm[i4].w}; }
        }
        asm volatile("s_waitcnt lgkmcnt(0)" ::: "memory");
    }
    if (MODE != 2) {
        float* dst = (MODE == 0 ? rb.Pc : rb.Qc) + mat;
#pragma unroll
        for (int j = 0; j < 4; ++j)
#pragma unroll
            for (int i = 0; i < 8; ++i) *(f32x2*)(dst + (4 * rg + j) * 64 + 16 * ks + 2 * i) = s[j][i];
    }
}
__device__ __forceinline__ void phase_scanA(Frame& F) {
    const RwBufs rb = rw_bufs(F.p->ws); LAS float* L = (LAS float*)(F.lds + F.wave * 12288);
    const int part = F.wave >> 2, npair = gridDim.x * 4;
    for (int bc = blockIdx.x * 4 + (F.wave & 3); bc < 64 * NCH; bc += npair) {
        const int bh = bc / NCH, chunk = bc % NCH;
        if (part == 0) scan_task<0>(L, F.lane, bh, chunk, rb); else scan_task<1>(L, F.lane, bh, chunk, rb);
    }
}
__device__ __forceinline__ void phase_scanC(Frame& F) {
    const RwBufs rb = rw_bufs(F.p->ws); LAS float* L = (LAS float*)(F.lds + F.wave * 12288);
    for (int task = F.gw; task < 64 * NCH; task += F.NGW) scan_task<2>(L, F.lane, task / NCH, task % NCH, rb, F.p->in[26], F.p->in[27], (bf16_t*)(F.p->ws + WS_A2));
}
__device__ __forceinline__ void phase_scanB(Frame& F) {
    const RwBufs rb = rw_bufs(F.p->ws);
    LAS float* SL = (LAS float*)F.lds;
    LAS float* PL = SL + 16 * 68;
    const int tid = F.tid, lane = F.lane, w = F.wave, g = lane >> 4, rho = lane & 15;
    for (int unit = blockIdx.x; unit < 256; unit += gridDim.x) {
        const int bh = unit >> 2, vq = unit & 3;
        f32x4 acc = {0.f, 0.f, 0.f, 0.f};
        const size_t rowoff = (size_t)(16 * vq + 4 * g) * 64 + 16 * (w & 3) + rho;
        if (w < 4) {
            float* d = rb.Sst + ((size_t)bh * NCH) * 4096 + rowoff;
#pragma unroll
            for (int i = 0; i < 4; ++i) d[64 * i] = 0.f;
        }
        f32x4 pa, pb; float qv[4];
        { const size_t mat = ((size_t)bh * NCH) * 4096;
          pa = *(const f32x4*)(rb.Pc + mat + tid * 8); pb = *(const f32x4*)(rb.Pc + mat + tid * 8 + 4);
#pragma unroll
          for (int i = 0; i < 4; ++i) qv[i] = rb.Qc[mat + rowoff + 64 * i]; }
        for (int c = 0; c < NCH - 1; ++c) {
            const size_t mat = ((size_t)bh * NCH + c) * 4096;
            __syncthreads();
            { const int r = tid >> 3, cc = (tid & 7) * 8; *(LAS f32x4*)(PL + r * 68 + cc) = pa; *(LAS f32x4*)(PL + r * 68 + cc + 4) = pb; }
            if (w < 4) {
#pragma unroll
                for (int i = 0; i < 4; ++i) SL[(4 * g + i) * 68 + 16 * w + rho] = acc[i];
            }
            f32x4 a0 = {qv[0], qv[1], qv[2], qv[3]};
            if (c + 1 < NCH - 1) {
                pa = *(const f32x4*)(rb.Pc + mat + 4096 + tid * 8); pb = *(const f32x4*)(rb.Pc + mat + 4096 + tid * 8 + 4);
#pragma unroll
                for (int i = 0; i < 4; ++i) qv[i] = rb.Qc[mat + 4096 + rowoff + 64 * i];
            }
            __syncthreads();
            if (w < 4) {
                f32x4 a1 = {0.f, 0.f, 0.f, 0.f};
#pragma unroll
                for (int ks = 0; ks < 16; ks += 2) {
                    const float s0 = SL[rho * 68 + 4 * ks + g], p0 = PL[(4 * ks + g) * 68 + 16 * w + rho];
                    const float s1 = SL[rho * 68 + 4 * ks + 4 + g], p1 = PL[(4 * ks + 4 + g) * 68 + 16 * w + rho];
                    a0 = __builtin_amdgcn_mfma_f32_16x16x4f32(s0, p0, a0, 0, 0, 0);
                    a1 = __builtin_amdgcn_mfma_f32_16x16x4f32(s1, p1, a1, 0, 0, 0);
                }
                acc = a0 + a1;
                float* d = rb.Sst + mat + 4096 + rowoff;
#pragma unroll
                for (int i = 0; i < 4; ++i) d[64 * i] = acc[i];
            }
        }
    }
}
__device__ __forceinline__ void phase_rwpost(Frame& F, bf16_t* A2) {
    const Params& P = *F.p; const RwBufs rb = rw_bufs(P.ws); const float* gn_g = P.in[26]; const float* gn_b = P.in[27];
    const int lane = F.lane, ch = lane & 7;
    for (int it = F.gw; it < 64 * SEQ / 8; it += F.NGW) {
        const int pair = it * 8 + (lane >> 3), bh = pair >> 12, t = pair & (SEQ - 1), h = bh & 31, b = bh >> 5, c = h * 64 + ch * 8;
        const size_t go = (size_t)pair * 64 + ch * 8;
        const f32x4 y0 = *(const f32x4*)(rb.Y + go), y1 = *(const f32x4*)(rb.Y + go + 4);
        float y[8] = {y0.x, y0.y, y0.z, y0.w, y1.x, y1.y, y1.z, y1.w};
        float s = 0.f;
#pragma unroll
        for (int e = 0; e < 8; ++e) s += y[e];
        s += __shfl_xor(s, 1); s += __shfl_xor(s, 2); s += __shfl_xor(s, 4);
        const float mean = s * (1.0f / 64.0f); float q = 0.f;
#pragma unroll
        for (int e = 0; e < 8; ++e) { y[e] -= mean; q += y[e] * y[e]; }
        q += __shfl_xor(q, 1); q += __shfl_xor(q, 2); q += __shfl_xor(q, 4);
        const float rstd = rsqrtf(q * (1.0f / 64.0f) + 64e-5f), bon = rb.bonus[pair];
        float vf[8], zf[8], o[8]; unpack8(*(const u32x4*)(rb.V + go), vf); unpack8(*(const u32x4*)(rb.ZS + go), zf);
        const f32x4 g0 = *(const f32x4*)(gn_g + c), g1 = *(const f32x4*)(gn_g + c + 4), b0 = *(const f32x4*)(gn_b + c), b1 = *(const f32x4*)(gn_b + c + 4);
#pragma unroll
        for (int e = 0; e < 8; ++e) o[e] = (y[e] * rstd * (e < 4 ? g0[e & 3] : g1[e & 3]) + (e < 4 ? b0[e & 3] : b1[e & 3]) + bon * vf[e]) * zf[e];
        *(u32x4*)(A2 + ((size_t)b * SEQ + t) * DM + c) = pack8(o);
    }
}

constexpr int LDS_BYTES = 147456;
constexpr int NPHASE = 22;
__global__ void __launch_bounds__(NTHREADS, 2) fwd(Params prm) {
    extern __shared__ __attribute__((aligned(16))) unsigned char lds_raw[];
    Frame F; F.lds = (LAS unsigned char*)lds_raw; F.tid = threadIdx.x; F.lane = F.tid & 63; F.wave = __builtin_amdgcn_readfirstlane(F.tid >> 6);
    F.gw = blockIdx.x * NWAVES + F.wave; F.NGW = gridDim.x * NWAVES; F.p = &prm;
    unsigned char* ws = prm.ws;
    volatile LAS unsigned* MISC = (volatile LAS unsigned*)(F.lds + 131072 + 8192);
    if (F.tid < 16) MISC[F.tid] = 0u;
    __syncthreads();
    XcdBarrier bar; bar.bar = (unsigned*)(ws + WS_BAR); bar.x = 0; bar.st = MISC;
#if SINGLE_LAUNCH
    bar = xcd_barrier_post((unsigned*)(ws + WS_BAR), MISC);
    if (prm.use_cg) cg::this_grid().sync();
#endif
    const int lo = prm.ph_lo, hi = prm.ph_hi;
    float* X = (float*)(ws + WS_X); bf16_t* XN = (bf16_t*)(ws + WS_XN); bf16_t* A2 = (bf16_t*)(ws + WS_A2);
    bf16_t* PB = (bf16_t*)(ws + WS_P); float* stats = (float*)(ws + WS_STATS);
    const float* macc = (const float*)(ws + WS_CTL); float* ssq = (float*)(ws + WS_SSQ); const float* biasb = (const float*)(ws + WS_BIAS);
#ifndef PHMASK
#define PHMASK 0x3fffff
#endif
#define IN(k) ((((PHMASK) >> (k)) & 1) && lo <= (k) && (k) < hi)
#ifndef REPMASK
#define REPMASK 0
#endif
#define RP(k) _Pragma("unroll 1") for (int rp_ = 0; rp_ < 1 + (((REPMASK) >> (k)) & 1); ++rp_)
#if SINGLE_LAUNCH
#define SEAM(k) do { if (IN(k) && IN((k) + 1)) xcd_barrier(bar); } while (0)
#else
#define SEAM(k) do { } while (0)
#endif
#define GEMM_IN(EPI, Wt, N_) do { pg8::Gemm g{XN, (const bf16_t*)(ws + (Wt)), M, (N_), DM}; pg8::StaticOrder S; S.init(M, (N_), gridDim.x, blockIdx.x); pg8::gemm_phase(F.lds, g, S, EPI); } while (0)
#define GEMM_OUT(layer, Wt, xin_, fuse_) do { pg8::Gemm g{A2, (const bf16_t*)(ws + (Wt)), M, DM, DM}; pg8::StaticOrder S; S.init(M, DM, gridDim.x, blockIdx.x); \
        EpiOut E{(xin_), X, macc + (size_t)(layer) * 2 * N_SG + 2 * DM, prm.in[5] + (size_t)(layer) * N_SG + 2 * DM, \
                 (fuse_) ? XN : (bf16_t*)nullptr, ssq + (size_t)((layer) + 1) * M, prm.in[3] + (size_t)((layer) + 1) * DM, macc + (size_t)((layer) + 1) * 2 * N_SG + DM, prm.in[5] + (size_t)((layer) + 1) * N_SG + DM}; \
        pg8::gemm_phase(F.lds, g, S, E); } while (0)

    if (IN(0)) RP(0) { phase_p0(F); } SEAM(0);
    if (IN(1)) RP(1) { phase_norm(F, prm.in[0], 0, XN); phase_bias(F); } SEAM(1);
    if (IN(2)) RP(2) { EpiSG E{PB, stats}; GEMM_IN(E, W_SGIN0, N_SG); } SEAM(2);
    if (IN(3)) RP(3) { phase_sgmix(F, 0, PB, PB + (size_t)M * DM, stats, A2); } SEAM(3);
    if (IN(4)) RP(4) { GEMM_OUT(0, W_SGOUT0, prm.in[0], true); } SEAM(4);
    if (IN(6)) RP(6) { EpiAdj<EpiSWA> E{{PB, PB + (size_t)M * DM, PB + (size_t)M * DM + (size_t)M * 256, PB + (size_t)2 * M * DM, (const f32x2*)(ws + WS_ROPE)}, ssq + (size_t)1 * M, biasb}; GEMM_IN(E, W_SWAIN, N_SWA); } SEAM(6);
    if (IN(7)) RP(7) { phase_attn(F, PB, PB + (size_t)M * DM, PB + (size_t)M * DM + (size_t)M * 256, PB + (size_t)2 * M * DM, A2); } SEAM(7);
    if (IN(8)) RP(8) { GEMM_OUT(1, W_SWAOUT, X, true); } SEAM(8);
    if (IN(10)) RP(10) { EpiAdj<EpiPlain> E{{PB, N_RWP}, ssq + (size_t)2 * M, biasb + (size_t)2 * N_RWP}; GEMM_IN(E, W_RWIN, N_RWP); } SEAM(10);
    if (IN(11)) RP(11) { phase_rwprep(F, PB); } SEAM(11);
    if (IN(12)) RP(12) { phase_scanA(F); } SEAM(12);
    if (IN(13)) RP(13) { phase_scanB(F); } SEAM(13);
    if (IN(14)) RP(14) { phase_scanC(F); } SEAM(14);
    if (IN(16)) RP(16) { GEMM_OUT(2, W_RWOUT, X, true); } SEAM(16);
    if (IN(18)) RP(18) { EpiAdj<EpiSG> E{{PB, stats}, ssq + (size_t)3 * M, biasb + (size_t)4 * N_RWP}; GEMM_IN(E, W_SGIN1, N_SG); } SEAM(18);
    if (IN(19)) RP(19) { phase_sgmix(F, 1, PB, PB + (size_t)M * DM, stats, A2); } SEAM(19);
    if (IN(20)) RP(20) { GEMM_OUT(3, W_SGOUT1, X, false); } SEAM(20);
    if (IN(21)) RP(21) { phase_final(F, X); }
}

extern "C" void kernel_launch(void* const* d_in, const int* in_sizes, int n_in, void* d_out, int out_size, void* d_ws, size_t ws_size, hipStream_t stream) {
    static int grid = 0;
    if (grid == 0) {
        if (n_in != 28 || out_size != M * DM || ws_size < WS_END) { fprintf(stderr, "kernel_launch: unexpected shapes (n_in %d out %d ws %zu)\n", n_in, out_size, ws_size); grid = -1; return; }
        int dev = 0, cus = 0, per_cu = 0;
        hipGetDevice(&dev); hipDeviceGetAttribute(&cus, hipDeviceAttributeMultiprocessorCount, dev);
        hipFuncSetAttribute((const void*)fwd, hipFuncAttributeMaxDynamicSharedMemorySize, LDS_BYTES);
        hipOccupancyMaxActiveBlocksPerMultiprocessor(&per_cu, (const void*)fwd, NTHREADS, LDS_BYTES);
        (void)hipGetLastError();
        if (per_cu < 1) per_cu = 1;
        grid = cus;
        if (grid > 256) grid = 256;
    }
    if (grid < 0) return;
    hipMemsetAsync((char*)d_ws + WS_CTL, 0, CTL_BYTES, stream);
    Params p{};
    for (int i = 0; i < 28; ++i) p.in[i] = (const float*)d_in[i];
    p.out = (float*)d_out; p.ws = (unsigned char*)d_ws; p.use_cg = 0; p.pad = 0;
#if SINGLE_LAUNCH
    p.ph_lo = 0; p.ph_hi = NPHASE;
    void* args[] = {&p};
    hipError_t e = hipLaunchCooperativeKernel((const void*)fwd, dim3(grid), dim3(NTHREADS), args, LDS_BYTES, stream);
    if (e != hipSuccess) fprintf(stderr, "cooperative launch failed: %s (grid %d)\n", hipGetErrorString(e), grid);
#else
    for (int ph = 0; ph < NPHASE; ++ph) {
        p.ph_lo = ph; p.ph_hi = ph + 1;
        hipLaunchKernelGGL(fwd, dim3(grid), dim3(NTHREADS), LDS_BYTES, stream, p);
    }
#endif
}
```

```cpp
#include <hip/hip_runtime.h>
#include <hip/hip_cooperative_groups.h>
#include <cstdio>
#include <cstdint>
namespace cg = cooperative_groups;

#ifndef SINGLE_LAUNCH
#define SINGLE_LAUNCH 1
#endif

#define LAS __attribute__((address_space(3)))
typedef unsigned short bf16_t;
typedef short bf16x8 __attribute__((ext_vector_type(8)));
typedef float f32x4 __attribute__((ext_vector_type(4)));
typedef float f32x2 __attribute__((ext_vector_type(2)));
typedef unsigned u32x4 __attribute__((ext_vector_type(4)));
typedef unsigned u32x2 __attribute__((ext_vector_type(2)));

constexpr int BATCH = 2, SEQ = 4096, DM = 2048, M = BATCH * SEQ;
constexpr int N_SG = 6144, N_SWA = 4608, N_RW = 8384, N_RWP = 8448;
constexpr int NWAVES = 8, NTHREADS = 512;
constexpr int NCH = 32, CHL = 128;
constexpr float DECAY_SCALE = 0.6065306597126334f;

constexpr size_t MiB = 1u << 20;
constexpr size_t WS_CTL = 0, CTL_BYTES = 1 * MiB;
constexpr size_t WS_BAR = 512 * 1024;
constexpr size_t WS_SSQ = 256 * 1024;
constexpr size_t WS_BIAS = 7 * MiB + 512 * 1024;
constexpr size_t WS_ROPE = 1 * MiB;
constexpr size_t WS_STATS = 3 * MiB;
constexpr size_t WS_BONUS = 5 * MiB;
constexpr size_t WS_LORA = 6 * MiB;
constexpr size_t WS_W = 8 * MiB;
constexpr size_t W_SGIN0 = WS_W, W_SGIN1 = W_SGIN0 + 24 * MiB, W_SGOUT0 = W_SGIN1 + 24 * MiB, W_SGOUT1 = W_SGOUT0 + 8 * MiB;
constexpr size_t W_SWAIN = W_SGOUT1 + 8 * MiB, W_SWAOUT = W_SWAIN + 18 * MiB, W_RWIN = W_SWAOUT + 8 * MiB, W_RWOUT = W_RWIN + 33 * MiB;
constexpr size_t WS_X = 140 * MiB;
constexpr size_t WS_XN = 204 * MiB;
constexpr size_t WS_A2 = 236 * MiB;
constexpr size_t WS_P = 268 * MiB;
constexpr size_t WS_RW = 400 * MiB;
constexpr size_t WS_END = 656 * MiB;
static_assert(W_RWOUT + 8 * MiB <= WS_X, "ws map");

__device__ __forceinline__ unsigned pk2(float lo, float hi) { unsigned r; asm("v_cvt_pk_bf16_f32 %0, %1, %2" : "=v"(r) : "v"(lo), "v"(hi)); return r; }
__device__ __forceinline__ unsigned f2bf(float f) { return pk2(f, 0.f) & 0xffffu; }
__device__ __forceinline__ float bflo(unsigned w) { return __builtin_bit_cast(float, w << 16); }
__device__ __forceinline__ float bfhi(unsigned w) { return __builtin_bit_cast(float, w & 0xffff0000u); }
__device__ __forceinline__ float bf2f(bf16_t h) { return __builtin_bit_cast(float, (unsigned)h << 16); }
__device__ __forceinline__ unsigned cvt_pk_bf16(float lo, float hi) { unsigned r; asm volatile("v_cvt_pk_bf16_f32 %0, %1, %2" : "=v"(r) : "v"(lo), "v"(hi)); return r; }
__device__ __forceinline__ float frcp(float x) { return __builtin_amdgcn_rcpf(x); }
__device__ __forceinline__ float sigmoidf_(float x) { return frcp(1.0f + __expf(-x)); }
__device__ __forceinline__ float siluf_(float x) { return x * frcp(1.0f + __expf(-x)); }
__device__ __forceinline__ float geluf_(float x) { return x * frcp(1.0f + __expf(-1.5957691216057308f * (x + 0.044715f * x * x * x))); }
__device__ __forceinline__ float tanhf_(float x) { return 1.0f - 2.0f * frcp(__expf(2.0f * x) + 1.0f); }
__device__ __forceinline__ float wave_sum(float v) {
#pragma unroll
    for (int o = 1; o < 64; o <<= 1) v += __shfl_xor(v, o);
    return v;
}
__device__ __forceinline__ void unpack8(u32x4 w, float (&f)[8]) {
    f[0] = bflo(w.x); f[1] = bfhi(w.x); f[2] = bflo(w.y); f[3] = bfhi(w.y); f[4] = bflo(w.z); f[5] = bfhi(w.z); f[6] = bflo(w.w); f[7] = bfhi(w.w);
}
__device__ __forceinline__ u32x4 pack8(const float (&f)[8]) {
    u32x4 w; w.x = pk2(f[0], f[1]); w.y = pk2(f[2], f[3]); w.z = pk2(f[4], f[5]); w.w = pk2(f[6], f[7]); return w;
}

namespace pg8 {
constexpr int BM = 256, BK = 64, HALF = 128, HTB = HALF * BK * 2, STAGE_BYTES = 8 * HTB, NXCD = 8, WGM = 8;
__host__ __device__ __forceinline__ int lds_byte(int r, int c) { const int st = (r >> 4) * 2 + (c >> 5), rr = r & 15, cc = c & 31, ob = rr * 64 + cc * 2; return st * 1024 + (ob ^ (((ob >> 9) & 1) << 5)); }
__host__ __device__ __forceinline__ void stage_rc(int b, int& R, int& C) { const int st = b / 1024, sb = b % 1024, swz = sb ^ (((sb >> 9) & 1) << 5); R = (st >> 1) * 16 + swz / 64; C = (st & 1) * 32 + (swz % 64) / 2; }
__host__ __device__ __forceinline__ int perm32(int rho) { const int n = rho >> 4, i = rho & 15; return 8 * (i >> 2) + 4 * n + (i & 3); }
struct Unit { int pm, pn; };
struct Gemm { const bf16_t* A; const bf16_t* Bt; int M, N, K; };
struct StaticOrder {
    int nM, nN, nwg, G, c;
    __device__ void init(int M_, int N_, int G_, int c_) { nM = M_ / BM; nN = N_ / BM; nwg = nM * nN; G = G_; c = c_; }
    __device__ bool next(int i, Unit& u) const {
        const long L = (long)i * G + c; if (L >= nwg) return false;
        int wgid = (int)L; { const int q = nwg / NXCD, r = nwg % NXCD, xcd = wgid % NXCD, off = wgid / NXCD; wgid = (xcd < r ? xcd * (q + 1) : r * (q + 1) + (xcd - r) * q) + off; }
        const int nig = WGM * nN, gid = wgid / nig, fm = gid * WGM, gsz = (nM - fm) < WGM ? (nM - fm) : WGM;
        u.pm = fm + ((wgid % nig) % gsz); u.pn = (wgid % nig) / gsz; return true;
    }
};
template <class Epi>
__device__ __forceinline__ void gemm_phase(LAS unsigned char* lds, const Gemm g, const StaticOrder& S, const Epi& E) {
    const int tid = threadIdx.x, wid = __builtin_amdgcn_readfirstlane(tid >> 6), lane = tid & 63, wr = wid >> 2, wc = wid & 3, fr = lane & 15, fq = lane >> 4;
    const int K = g.K, nt = K / BK;
    unsigned voffA[2], voffB[2];
#pragma unroll
    for (int i = 0; i < 2; ++i) { int R, C; stage_rc(tid * 16 + i * 8192, R, C); const int Rb = (R & ~31) + perm32(R & 31);
        voffA[i] = (unsigned)(R * K + C) * 2u; voffB[i] = (unsigned)(Rb * K + C) * 2u; }
    const size_t kstep = (size_t)(BK * 2);
    const size_t hstep = (size_t)HALF * K * 2;
    const size_t tstep = 2 * hstep;
    const unsigned ldsw = (unsigned)wid * 1024u;
    const int aoff = lds_byte(wr * 64 + fr, fq * 8), boff = lds_byte(wc * 32 + fr, fq * 8);
#define PG8_SA(b, h) (((b) * 2 + (h)) * HTB)
#define PG8_SB(b, h) ((4 + (b) * 2 + (h)) * HTB)
#define PG8_STAGE(bufoff, gbase, voff) do { _Pragma("unroll") for (int _i = 0; _i < 2; ++_i) \
        __builtin_amdgcn_global_load_lds((const unsigned*)((const char*)(gbase) + (voff)[_i]), (LAS unsigned*)(lds + (bufoff) + ldsw + _i * 8192), 16, 0, 0); } while (0)
#define PG8_LDA(dst, b, h) do { _Pragma("unroll") for (int m = 0; m < 4; ++m) _Pragma("unroll") for (int k = 0; k < 2; ++k) dst[m][k] = *(const LAS bf16x8*)(lds + PG8_SA(b, h) + aoff + m * 2048 + k * 1024); } while (0)
#define PG8_LDB(dst, b, h) do { _Pragma("unroll") for (int n = 0; n < 2; ++n) _Pragma("unroll") for (int k = 0; k < 2; ++k) dst[n][k] = *(const LAS bf16x8*)(lds + PG8_SB(b, h) + boff + n * 2048 + k * 1024); } while (0)
#define PG8_MMA(ai, bj, At, Bt) do { __builtin_amdgcn_s_setprio(1); _Pragma("unroll") for (int m = 0; m < 4; ++m) _Pragma("unroll") for (int n = 0; n < 2; ++n) _Pragma("unroll") for (int k = 0; k < 2; ++k) \
        acc[ai][bj][m][n] = __builtin_amdgcn_mfma_f32_16x16x32_bf16(Bt[n][k], At[m][k], acc[ai][bj][m][n], 0, 0, 0); __builtin_amdgcn_s_setprio(0); } while (0)
#define PG8_WAIT_V(n) asm volatile("s_waitcnt vmcnt(" #n ")" ::: "memory")
#define PG8_WAIT_L(n) asm volatile("s_waitcnt lgkmcnt(" #n ")" ::: "memory")
#define PG8_BAR __builtin_amdgcn_s_barrier()
#define PG8_SCHED __builtin_amdgcn_sched_barrier(0)
    Unit cur, nxt; int ui = 0;
    if (!S.next(0, cur)) return;
    f32x4 acc[2][2][4][2];
#pragma unroll
    for (int a = 0; a < 2; ++a)
#pragma unroll
        for (int b = 0; b < 2; ++b)
#pragma unroll
            for (int m = 0; m < 4; ++m)
#pragma unroll
                for (int n = 0; n < 2; ++n) acc[a][b][m][n] = (f32x4){0.f, 0.f, 0.f, 0.f};
    bf16x8 At[4][2], B0[2][2], B1[2][2];
    const char* cA = (const char*)g.A + (size_t)cur.pm * tstep; const char* cB = (const char*)g.Bt + (size_t)cur.pn * tstep;
    PG8_STAGE(PG8_SB(0, 0), cB, voffB); PG8_STAGE(PG8_SB(0, 1), cB + hstep, voffB); PG8_STAGE(PG8_SA(0, 0), cA, voffA); PG8_STAGE(PG8_SA(0, 1), cA + hstep, voffA);
    if (wr == 1) PG8_BAR;
    PG8_WAIT_V(2); PG8_BAR;
    PG8_STAGE(PG8_SB(1, 0), cB + kstep, voffB); PG8_STAGE(PG8_SA(1, 0), cA + kstep, voffA); PG8_STAGE(PG8_SB(1, 1), cB + hstep + kstep, voffB);
    PG8_WAIT_V(6); PG8_BAR;
    for (;;) {
        const bool has_next = S.next(ui + 1, nxt);
        const char* nA = has_next ? (const char*)g.A + (size_t)nxt.pm * tstep : cA; const char* nB = has_next ? (const char*)g.Bt + (size_t)nxt.pn * tstep : cB;
        for (int t = 0; t < nt; t += 2) {
            const bool last = (t == nt - 2);
            const char* a1 = cA + (size_t)(t + 1) * kstep;
            const char* a2 = last ? nA : cA + (size_t)(t + 2) * kstep; const char* b2 = last ? nB : cB + (size_t)(t + 2) * kstep;
            const char* a3 = a2 + kstep; const char* b3 = b2 + kstep;
            PG8_LDB(B0, 0, 0); PG8_LDB(B1, 0, 1); PG8_SCHED; PG8_LDA(At, 0, 0); PG8_STAGE(PG8_SA(1, 1), a1 + hstep, voffA);
            PG8_WAIT_V(8); PG8_WAIT_L(0); PG8_BAR; PG8_MMA(0, 0, At, B0); PG8_MMA(0, 1, At, B1); PG8_BAR; PG8_SCHED;
            PG8_LDA(At, 0, 1); PG8_STAGE(PG8_SB(0, 0), b2, voffB); PG8_STAGE(PG8_SB(0, 1), b2 + hstep, voffB); PG8_STAGE(PG8_SA(0, 0), a2, voffA);
            PG8_WAIT_V(8); PG8_WAIT_L(0); PG8_BAR; PG8_MMA(1, 0, At, B0); PG8_MMA(1, 1, At, B1); PG8_BAR; PG8_SCHED;
            PG8_LDB(B0, 1, 0); PG8_LDB(B1, 1, 1); PG8_SCHED; PG8_LDA(At, 1, 0); PG8_STAGE(PG8_SA(0, 1), a2 + hstep, voffA);
            PG8_WAIT_V(8); PG8_WAIT_L(0); PG8_BAR; PG8_MMA(0, 0, At, B0); PG8_MMA(0, 1, At, B1); PG8_BAR; PG8_SCHED;
            PG8_LDA(At, 1, 1); PG8_STAGE(PG8_SB(1, 0), b3, voffB); PG8_STAGE(PG8_SB(1, 1), b3 + hstep, voffB); PG8_STAGE(PG8_SA(1, 0), a3, voffA);
            PG8_WAIT_V(8); PG8_WAIT_L(0); PG8_BAR; PG8_MMA(1, 0, At, B0); PG8_MMA(1, 1, At, B1); PG8_BAR; PG8_SCHED;
        }
        if (wr == 0) PG8_BAR;
        E(acc, cur, wr, wc, fr, fq);
        if (!has_next) break;
#pragma unroll
        for (int a = 0; a < 2; ++a)
#pragma unroll
            for (int b = 0; b < 2; ++b)
#pragma unroll
                for (int m = 0; m < 4; ++m)
#pragma unroll
                    for (int n = 0; n < 2; ++n) acc[a][b][m][n] = (f32x4){0.f, 0.f, 0.f, 0.f};
        cur = nxt; cA = nA; cB = nB; ++ui;
        if (wr == 1) PG8_BAR;
    }
    PG8_WAIT_V(0);
    PG8_BAR;
#undef PG8_SA
#undef PG8_SB
#undef PG8_STAGE
#undef PG8_LDA
#undef PG8_LDB
#undef PG8_MMA
#undef PG8_WAIT_V
#undef PG8_WAIT_L
#undef PG8_BAR
#undef PG8_SCHED
}
}
using pg8::Unit;
typedef f32x4 Acc[2][2][4][2];

struct EpiSG {
    bf16_t* P0; float* stats;
    __device__ __forceinline__ void operator()(const Acc& acc, const Unit& u, int wr, int wc, int fr, int fq) const {
        const int row0 = u.pm * 256 + wr * 64 + fr;
        if (u.pn < 16) {
            const int col0 = u.pn * 128 + wc * 32 + 8 * fq;
#pragma unroll
            for (int ai = 0; ai < 2; ++ai)
#pragma unroll
                for (int m = 0; m < 4; ++m) {
                    const int row = row0 + ai * 128 + m * 16;
                    f32x4 a = acc[ai][0][m][0], b = acc[ai][0][m][1]; const f32x4 za = acc[ai][1][m][0], zb = acc[ai][1][m][1];
#pragma unroll
                    for (int e = 0; e < 4; ++e) { a[e] = geluf_(a[e]) * siluf_(za[e]); b[e] = geluf_(b[e]) * siluf_(zb[e]); }
                    u32x4 w; w.x = cvt_pk_bf16(a[0], a[1]); w.y = cvt_pk_bf16(a[2], a[3]); w.z = cvt_pk_bf16(b[0], b[1]); w.w = cvt_pk_bf16(b[2], b[3]);
                    *(u32x4*)(P0 + (size_t)row * DM + col0) = w;
                }
        } else {
            const int vt = u.pn - 16, col0 = vt * 256 + wc * 32 + 8 * fq;
            bf16_t* base = P0 + (size_t)M * DM;
#pragma unroll
            for (int ai = 0; ai < 2; ++ai)
#pragma unroll
                for (int m = 0; m < 4; ++m) {
                    const int row = row0 + ai * 128 + m * 16; float s = 0.f, q = 0.f;
#pragma unroll
                    for (int bj = 0; bj < 2; ++bj) {
                        f32x4 a = acc[ai][bj][m][0], b = acc[ai][bj][m][1];
#pragma unroll
                        for (int e = 0; e < 4; ++e) { a[e] = geluf_(a[e]); b[e] = geluf_(b[e]); }
                        s += (a[0] + a[1]) + (a[2] + a[3]) + (b[0] + b[1]) + (b[2] + b[3]);
                        q += (a[0] * a[0] + a[1] * a[1]) + (a[2] * a[2] + a[3] * a[3]) + (b[0] * b[0] + b[1] * b[1]) + (b[2] * b[2] + b[3] * b[3]);
                        u32x4 w; w.x = cvt_pk_bf16(a[0], a[1]); w.y = cvt_pk_bf16(a[2], a[3]); w.z = cvt_pk_bf16(b[0], b[1]); w.w = cvt_pk_bf16(b[2], b[3]);
                        *(u32x4*)(base + (size_t)row * DM + col0 + bj * 128) = w;
                    }
                    s += __shfl_xor(s, 16); s += __shfl_xor(s, 32); q += __shfl_xor(q, 16); q += __shfl_xor(q, 32);
                    if (fq == 0) *(f32x2*)(stats + ((size_t)row * 32 + vt * 4 + wc) * 2) = (f32x2){s, q};
                }
        }
    }
};
struct EpiSWA {
    bf16_t *Q, *Kb, *Vb, *Z; const f32x2* rope;
    __device__ __forceinline__ void operator()(const Acc& acc, const Unit& u, int wr, int wc, int fr, int fq) const {
        const int pn = u.pn; bf16_t* base; int ld, colt; bool rp = false, act = false;
        if (pn < 8) { base = Q; ld = DM; colt = pn * 256; rp = true; }
        else if (pn == 8) { base = Kb; ld = 256; colt = 0; rp = true; }
        else if (pn == 9) { base = Vb; ld = 256; colt = 0; }
        else { base = Z; ld = DM; colt = (pn - 10) * 256; act = true; }
        const int row0 = u.pm * 256 + wr * 64 + fr, col0 = colt + wc * 32 + 8 * fq;
        const int f0 = 16 * (wc & 1) + 4 * fq;
#pragma unroll
        for (int ai = 0; ai < 2; ++ai)
#pragma unroll
            for (int m = 0; m < 4; ++m) {
                const int row = row0 + ai * 128 + m * 16;
                f32x4 cs0 = {1.f, 0.f, 1.f, 0.f}, cs1 = cs0;
                if (rp) { const f32x4* rr = (const f32x4*)(rope + (size_t)row * 32 + f0); cs0 = rr[0]; cs1 = rr[1]; }
#pragma unroll
                for (int bj = 0; bj < 2; ++bj) {
                    f32x4 a = acc[ai][bj][m][0], b = acc[ai][bj][m][1];
                    if (rp) {
                        const float c0 = cs0[0], s0 = cs0[1], c1 = cs0[2], s1 = cs0[3], c2 = cs1[0], s2 = cs1[1], c3 = cs1[2], s3 = cs1[3];
                        f32x4 o1, o2;
                        o1[0] = a[0] * c0 - b[0] * s0; o2[0] = b[0] * c0 + a[0] * s0;
                        o1[1] = a[1] * c1 - b[1] * s1; o2[1] = b[1] * c1 + a[1] * s1;
                        o1[2] = a[2] * c2 - b[2] * s2; o2[2] = b[2] * c2 + a[2] * s2;
                        o1[3] = a[3] * c3 - b[3] * s3; o2[3] = b[3] * c3 + a[3] * s3;
                        a = o1; b = o2;
                    }
                    if (act) {
#pragma unroll
                        for (int e = 0; e < 4; ++e) { a[e] = siluf_(a[e]); b[e] = siluf_(b[e]); }
                    }
                    u32x4 w; w.x = cvt_pk_bf16(a[0], a[1]); w.y = cvt_pk_bf16(a[2], a[3]); w.z = cvt_pk_bf16(b[0], b[1]); w.w = cvt_pk_bf16(b[2], b[3]);
                    *(u32x4*)(base + (size_t)row * ld + col0 + bj * 128) = w;
                }
            }
    }
};
struct EpiPlain {
    bf16_t* O; int ld;
    __device__ __forceinline__ void operator()(const Acc& acc, const Unit& u, int wr, int wc, int fr, int fq) const {
        const int row0 = u.pm * 256 + wr * 64 + fr, col0 = u.pn * 256 + wc * 32 + 8 * fq;
#pragma unroll
        for (int ai = 0; ai < 2; ++ai)
#pragma unroll
            for (int m = 0; m < 4; ++m) {
                const int row = row0 + ai * 128 + m * 16;
#pragma unroll
                for (int bj = 0; bj < 2; ++bj) {
                    const f32x4 a = acc[ai][bj][m][0], b = acc[ai][bj][m][1];
                    u32x4 w; w.x = cvt_pk_bf16(a[0], a[1]); w.y = cvt_pk_bf16(a[2], a[3]); w.z = cvt_pk_bf16(b[0], b[1]); w.w = cvt_pk_bf16(b[2], b[3]);
                    *(u32x4*)(O + (size_t)row * ld + col0 + bj * 128) = w;
                }
            }
    }
};
struct EpiOut {
    const float* xin; float* xout; const float* macc; const float* mb;
    bf16_t* xb; float* ssq; const float* g; const float* macc_sc; const float* mb_sc;
    __device__ __forceinline__ void operator()(const Acc& acc, const Unit& u, int wr, int wc, int fr, int fq) const {
        const int row0 = u.pm * 256 + wr * 64 + fr, col0 = u.pn * 256 + wc * 32 + 8 * fq;
        const int b = u.pm >> 4;
        float ss[2][4];
#pragma unroll
        for (int ai = 0; ai < 2; ++ai)
#pragma unroll
            for (int m = 0; m < 4; ++m) ss[ai][m] = 0.f;
#pragma unroll
        for (int bj = 0; bj < 2; ++bj) {
            const int cj = col0 + bj * 128;
            const f32x4 gt0 = *(const f32x4*)(macc + (size_t)b * N_SG + cj) + *(const f32x4*)(mb + cj), gt1 = *(const f32x4*)(macc + (size_t)b * N_SG + cj + 4) + *(const f32x4*)(mb + cj + 4);
            f32x4 gs0 = {0.f, 0.f, 0.f, 0.f}, gs1 = gs0;
            if (xb) { gs0 = *(const f32x4*)(g + cj) * (*(const f32x4*)(macc_sc + (size_t)b * N_SG + cj) + *(const f32x4*)(mb_sc + cj) + 1.0f);
                      gs1 = *(const f32x4*)(g + cj + 4) * (*(const f32x4*)(macc_sc + (size_t)b * N_SG + cj + 4) + *(const f32x4*)(mb_sc + cj + 4) + 1.0f); }
#pragma unroll
            for (int ai = 0; ai < 2; ++ai)
#pragma unroll
                for (int m = 0; m < 4; ++m) {
                    const size_t off = (size_t)(row0 + ai * 128 + m * 16) * DM + cj;
                    const f32x4 x0 = __builtin_nontemporal_load((const f32x4*)(xin + off)) + gt0 * acc[ai][bj][m][0];
                    const f32x4 x1 = __builtin_nontemporal_load((const f32x4*)(xin + off + 4)) + gt1 * acc[ai][bj][m][1];
                    *(f32x4*)(xout + off) = x0; *(f32x4*)(xout + off + 4) = x1;
                    if (xb) {
                        ss[ai][m] += (x0[0] * x0[0] + x0[1] * x0[1]) + (x0[2] * x0[2] + x0[3] * x0[3]) + (x1[0] * x1[0] + x1[1] * x1[1]) + (x1[2] * x1[2] + x1[3] * x1[3]);
                        const f32x4 h0 = x0 * gs0, h1 = x1 * gs1;
                        u32x4 w; w.x = cvt_pk_bf16(h0[0], h0[1]); w.y = cvt_pk_bf16(h0[2], h0[3]); w.z = cvt_pk_bf16(h1[0], h1[1]); w.w = cvt_pk_bf16(h1[2], h1[3]);
                        *(u32x4*)(xb + off) = w;
                    }
                    if (m & 1) asm volatile("" ::: "memory");
                }
        }
        if (xb) {
#pragma unroll
            for (int ai = 0; ai < 2; ++ai)
#pragma unroll
                for (int m = 0; m < 4; ++m) { float s = ss[ai][m]; s += __shfl_xor(s, 16); s += __shfl_xor(s, 32); if (fq == 0) atomicAdd(ssq + row0 + ai * 128 + m * 16, s); }
        }
    }
};
template <class Inner> struct EpiAdj {
    Inner in; const float* ssq; const float* bias;
    __device__ __forceinline__ void operator()(Acc& acc, const Unit& u, int wr, int wc, int fr, int fq) const {
        const int b = u.pm >> 4, colb = u.pn * 256 + wc * 32 + 8 * fq;
        f32x4 bs[2][2];
#pragma unroll
        for (int bj = 0; bj < 2; ++bj)
#pragma unroll
            for (int n = 0; n < 2; ++n) bs[bj][n] = *(const f32x4*)(bias + (size_t)b * N_RWP + colb + bj * 128 + 4 * n);
#pragma unroll
        for (int ai = 0; ai < 2; ++ai)
#pragma unroll
            for (int m = 0; m < 4; ++m) {
                const float rstd = rsqrtf(ssq[u.pm * 256 + ai * 128 + wr * 64 + m * 16 + fr] * (1.0f / DM) + 1e-6f);
#pragma unroll
                for (int bj = 0; bj < 2; ++bj)
#pragma unroll
                    for (int n = 0; n < 2; ++n) acc[ai][bj][m][n] = acc[ai][bj][m][n] * rstd + bs[bj][n];
            }
        in(acc, u, wr, wc, fr, fq);
    }
};

struct Params { const float* in[28]; float* out; unsigned char* ws; int ph_lo, ph_hi, use_cg, pad; };

struct Frame {
    LAS unsigned char* lds; int tid, lane, wave, gw, NGW;
    const Params* p;
};

#define XB_TMO      128
#define XB_XCNT(j)  (256  + 64 * (j))
#define XB_XSUB(j)  (1280 + 64 * (j))
#define XB_XGEN(j)  (2304 + 64 * (j))
#define XB_TOP      3328
#define XB_TOPGEN   3392
#define XB_SPIN_CAP (1u << 22)
__device__ __forceinline__ unsigned xb_ld(unsigned* p)              { return __hip_atomic_load(p, __ATOMIC_RELAXED, __HIP_MEMORY_SCOPE_AGENT); }
__device__ __forceinline__ unsigned xb_add(unsigned* p, unsigned v) { return __hip_atomic_fetch_add(p, v, __ATOMIC_RELAXED, __HIP_MEMORY_SCOPE_AGENT); }
__device__ __forceinline__ unsigned xb_xcc_id() { return (unsigned)__builtin_amdgcn_s_getreg((3 << 11) | 20) & 0xFu; }
#define XB_SPIN(cond, bar) do { unsigned _sp = 0; while (cond) { __builtin_amdgcn_s_sleep(1); \
    if ((++_sp & 255u) == 0u) { if (xb_ld(&(bar)[XB_TMO])) break; if (_sp > XB_SPIN_CAP) { atomicAdd(&(bar)[XB_TMO], 1u); break; } } } } while (0)
struct XcdBarrier { unsigned* bar; unsigned x; volatile LAS unsigned* st; };
__device__ __forceinline__ XcdBarrier xcd_barrier_post(unsigned* bar, volatile LAS unsigned* st) {
    XcdBarrier b; b.bar = bar; b.x = xb_xcc_id(); b.st = st;
    if (threadIdx.x == 0) (void)xb_add(&bar[XB_XCNT(b.x)], 1u);
    return b;
}
__device__ __forceinline__ void xcd_barrier_complete(unsigned* bar, unsigned x, unsigned& nloc, unsigned& nx) {
    const unsigned G = gridDim.x * gridDim.y * gridDim.z;
    unsigned sum, cnt, mine, sp = 0u;
    for (;;) {
        sum = 0u; cnt = 0u; mine = 0u;
#pragma unroll
        for (unsigned j = 0; j < 16; ++j) { const unsigned c = xb_ld(&bar[XB_XCNT(j)]); sum += c; cnt += (c > 0u) ? 1u : 0u; mine = (j == x) ? c : mine; }
        if (sum == G) break;
        __builtin_amdgcn_s_sleep(1);
        if ((++sp & 255u) == 0u) { if (xb_ld(&bar[XB_TMO])) break; if (sp > XB_SPIN_CAP) { atomicAdd(&bar[XB_TMO], 1u); break; } }
    }
    nloc = mine > 0u ? mine : 1u; nx = cnt > 0u ? cnt : 1u;
}
__device__ __forceinline__ void xcd_barrier(const XcdBarrier& b) {
    asm volatile("s_waitcnt vmcnt(0)" ::: "memory");
    __syncthreads();
    if (threadIdx.x == 0) {
        unsigned* bar = b.bar;
        __builtin_amdgcn_s_waitcnt(0);
        unsigned nloc = b.st[0], nx = b.st[1];
        if (nloc == 0u) { xcd_barrier_complete(bar, b.x, nloc, nx); b.st[0] = nloc; b.st[1] = nx; }
        const unsigned old = xb_add(&bar[XB_XSUB(b.x)], 1u);
        const unsigned gen = old / nloc;
        if (old + 1u == (gen + 1u) * nloc) {
            __builtin_amdgcn_fence(__ATOMIC_RELEASE, "agent");
            asm volatile("s_waitcnt vmcnt(0)" ::: "memory");
            const unsigned og = xb_add(&bar[XB_TOP], 1u);
            const unsigned tg = og / nx;
            if (og + 1u == (tg + 1u) * nx) xb_add(&bar[XB_TOPGEN], 1u);
            else XB_SPIN(xb_ld(&bar[XB_TOPGEN]) == tg, bar);
            __builtin_amdgcn_fence(__ATOMIC_ACQUIRE, "agent");
            xb_add(&bar[XB_XGEN(b.x)], 1u);
            asm volatile("s_waitcnt vmcnt(0)" ::: "memory");
        } else {
            XB_SPIN(xb_ld(&bar[XB_XGEN(b.x)]) == gen, bar);
            __builtin_amdgcn_fence(__ATOMIC_ACQUIRE, "agent");
            asm volatile("s_waitcnt vmcnt(0)" ::: "memory");
        }
    }
    __syncthreads();
}

__device__ const float ROPE_INVF[32] = {1.f, 0.749894202f, 0.562341332f, 0.421696514f, 0.316227764f, 0.237137377f, 0.177827939f, 0.133352146f, 0.100000001f, 0.0749894232f, 0.0562341325f, 0.0421696492f, 0.0316227749f, 0.0237137377f, 0.0177827943f, 0.013335214f, 0.00999999978f, 0.00749894232f, 0.00562341325f, 0.00421696482f, 0.00316227763f, 0.00237137382f, 0.00177827943f, 0.00133352145f, 0.00100000005f, 0.000749894185f, 0.000562341302f, 0.000421696517f, 0.000316227757f, 0.00023713737f, 0.00017782794f, 0.00013335215f};

__device__ __forceinline__ int sg_maprow(int n) {
    if (n < DM) return (n >> 7) * 256 + (n & 127);
    if (n >= 2 * DM) { const int c = n - 2 * DM; return (c >> 7) * 256 + 128 + (c & 127); }
    return 2 * DM + (n - DM);
}
__device__ __forceinline__ int swa_maprow(int n) {
    if (n >= 2304) return n;
    const int d = n & 63, half = d >> 5, dd = d & 31, j = dd >> 2, i = dd & 3;
    return (n & ~63) + 8 * j + 4 * half + i;
}
__device__ __forceinline__ void p0_transpose_item(const float* W, int N, bf16_t* WT, int mode, LAS float* scr, int item, int lane) {
    const int nblk = N / 32, kb = item / nblk, nb = item % nblk, k0 = 64 * kb, n0 = 32 * nb;
#pragma unroll 8
    for (int i = 0; i < 32; ++i) { const int kk = 2 * i + (lane >> 5); scr[kk * 33 + (lane & 31)] = __builtin_nontemporal_load(W + (size_t)(k0 + kk) * N + n0 + (lane & 31)); }
    asm volatile("s_waitcnt lgkmcnt(0)" ::: "memory");
    const int c = lane & 7;
#pragma unroll
    for (int j = 0; j < 4; ++j) { const int n = (lane >> 3) + 8 * j; const LAS float* s = scr + (8 * c) * 33 + n;
        u32x4 o; o.x = pk2(s[0 * 33], s[1 * 33]); o.y = pk2(s[2 * 33], s[3 * 33]); o.z = pk2(s[4 * 33], s[5 * 33]); o.w = pk2(s[6 * 33], s[7 * 33]);
        const int dn = mode == 1 ? swa_maprow(n0 + n) : (mode == 2 ? sg_maprow(n0 + n) : (n0 + n));
        *(u32x4*)(WT + (size_t)dn * DM + k0 + 8 * c) = o; }
    asm volatile("s_waitcnt lgkmcnt(0)" ::: "memory");
}
__device__ __forceinline__ void phase_p0(Frame& F) {
    const Params& P = *F.p; unsigned char* ws = P.ws;
    LAS float* scr = (LAS float*)(F.lds + F.wave * 16384);
    const int lane = F.lane;
    constexpr int I_SGIN = 32 * (N_SG / 32), I_OUT = 32 * (DM / 32), I_SWAIN = 32 * (N_SWA / 32), I_RWIN = 32 * (N_RW / 32);
    constexpr int NITEMS = 2 * I_SGIN + 2 * I_OUT + I_SWAIN + I_OUT + I_RWIN + I_OUT;
#ifndef P0REP
#define P0REP 1
#endif
    _Pragma("unroll 1") for (int rep_ = 0; rep_ < P0REP; ++rep_)
    for (int it = F.gw; it < NITEMS; it += F.NGW) {
        int r = it;
        if (r < I_SGIN) { p0_transpose_item(P.in[7], N_SG, (bf16_t*)(ws + W_SGIN0), 2, scr, r, lane); continue; } r -= I_SGIN;
        if (r < I_SGIN) { p0_transpose_item(P.in[7] + (size_t)DM * N_SG, N_SG, (bf16_t*)(ws + W_SGIN1), 2, scr, r, lane); continue; } r -= I_SGIN;
        if (r < I_OUT) { p0_transpose_item(P.in[8], DM, (bf16_t*)(ws + W_SGOUT0), 0, scr, r, lane); continue; } r -= I_OUT;
        if (r < I_OUT) { p0_transpose_item(P.in[8] + (size_t)DM * DM, DM, (bf16_t*)(ws + W_SGOUT1), 0, scr, r, lane); continue; } r -= I_OUT;
        if (r < I_SWAIN) { p0_transpose_item(P.in[13], N_SWA, (bf16_t*)(ws + W_SWAIN), 1, scr, r, lane); continue; } r -= I_SWAIN;
        if (r < I_OUT) { p0_transpose_item(P.in[14], DM, (bf16_t*)(ws + W_SWAOUT), 0, scr, r, lane); continue; } r -= I_OUT;
        if (r < I_RWIN) { p0_transpose_item(P.in[16], N_RW, (bf16_t*)(ws + W_RWIN), 0, scr, r, lane); continue; } r -= I_RWIN;
        p0_transpose_item(P.in[17], DM, (bf16_t*)(ws + W_RWOUT), 0, scr, r, lane);
    }
    { u32x4* z = (u32x4*)(ws + W_RWIN + (size_t)N_RW * DM * 2); const int n16 = (N_RWP - N_RW) * DM * 2 / 16;
      for (int i = blockIdx.x * NTHREADS + F.tid; i < n16; i += gridDim.x * NTHREADS) z[i] = (u32x4){0u, 0u, 0u, 0u}; }
    { float* macc = (float*)(ws + WS_CTL); const float* cin = P.in[1]; const float* mw = P.in[4];
      LAS float* my = (LAS float*)(F.lds + F.wave * 16384);
      for (int bt = blockIdx.x; bt < 4 * 24 * 8; bt += gridDim.x) {
          const int i = bt / 192, rem = bt % 192, cgp = rem / 8, ks = (rem % 8) * 8 + F.wave, n0 = cgp * 256 + lane * 4, k0 = ks * 32;
          const float c0v = siluf_(cin[k0 + (lane & 31)]), c1v = siluf_(cin[DM + k0 + (lane & 31)]);
          f32x4 a0 = {0.f, 0.f, 0.f, 0.f}, a1 = a0;
          const float* wp = mw + ((size_t)i * DM + k0) * N_SG + n0;
#pragma unroll 8
          for (int kk = 0; kk < 32; ++kk) {
              const f32x4 w = __builtin_nontemporal_load((const f32x4*)(wp + (size_t)kk * N_SG));
              const float s0 = __builtin_bit_cast(float, __builtin_amdgcn_readlane(__builtin_bit_cast(int, c0v), kk));
              const float s1 = __builtin_bit_cast(float, __builtin_amdgcn_readlane(__builtin_bit_cast(int, c1v), kk));
              a0 += w * s0; a1 += w * s1;
          }
          *(LAS f32x4*)(my + lane * 4) = a0; *(LAS f32x4*)(my + 256 + lane * 4) = a1;
          __syncthreads();
          { const int b = F.tid >> 8, col = F.tid & 255; float s = 0.f;
#pragma unroll
            for (int w8 = 0; w8 < 8; ++w8) s += *((const LAS float*)(F.lds + w8 * 16384) + b * 256 + col);
            atomicAdd(macc + ((size_t)i * 2 + b) * N_SG + cgp * 256 + col, s); }
          __syncthreads();
      } }
    { bf16_t* LWH = (bf16_t*)(ws + WS_LORA); bf16_t* LWL = LWH + 2048 * 96; bf16_t* LA = LWL + 2048 * 96; const float* wl = P.in[20]; const float* al = P.in[22];
      for (int idx = blockIdx.x * NTHREADS + F.tid; idx < 96 * DM; idx += gridDim.x * NTHREADS) {
          const int k = idx >> 11, c = idx & (DM - 1); const float w = wl[idx]; const unsigned hi = f2bf(w);
          LWH[c * 96 + k] = (bf16_t)hi; LWL[c * 96 + k] = (bf16_t)f2bf(w - __builtin_bit_cast(float, hi << 16)); LA[c * 96 + k] = (bf16_t)f2bf(al[idx]);
      } }
    { f32x2* tab = (f32x2*)(ws + WS_ROPE); const int* pos = (const int*)P.in[2];
      for (int idx = blockIdx.x * NTHREADS + F.tid; idx < M * 32; idx += gridDim.x * NTHREADS) {
          const int m = idx >> 5, f = idx & 31;
          const float ang = (float)pos[m] * ROPE_INVF[f];
          double rev = (double)ang * 0.15915494309189535; rev -= __builtin_rint(rev);
          const float rf = (float)rev;
          tab[idx] = (f32x2){__builtin_amdgcn_cosf(rf), __builtin_amdgcn_sinf(rf)};
      } }
}

__device__ __forceinline__ void phase_norm(Frame& F, const float* xin, int layer, bf16_t* XN) {
    const Params& P = *F.p; const float* macc = (const float*)(P.ws + WS_CTL); const float* mb = P.in[5] + (size_t)layer * N_SG; const float* g = P.in[3] + (size_t)layer * DM;
    for (int row = F.gw; row < M; row += F.NGW) {
        const int b = row >> 12; const float* ma = macc + ((size_t)layer * 2 + b) * N_SG;
        const f32x4* xr = (const f32x4*)(xin + (size_t)row * DM) + F.lane;
        f32x4 v[8]; float ss = 0.f;
#pragma unroll
        for (int j = 0; j < 8; ++j) { v[j] = __builtin_nontemporal_load(xr + 64 * j); ss += (v[j].x * v[j].x + v[j].y * v[j].y) + (v[j].z * v[j].z + v[j].w * v[j].w); }
        const float rstd = rsqrtf(wave_sum(ss) * (1.0f / DM) + 1e-6f);
#pragma unroll
        for (int j = 0; j < 8; ++j) {
            const int c = 256 * j + 4 * F.lane;
            const f32x4 g4 = *(const f32x4*)(g + c);
            const f32x4 sh = *(const f32x4*)(ma + c) + *(const f32x4*)(mb + c);
            const f32x4 sc = *(const f32x4*)(ma + DM + c) + *(const f32x4*)(mb + DM + c);
            const f32x4 h = v[j] * rstd * g4 * (sc + 1.0f) + sh;
            u32x2 w; w.x = pk2(h.x, h.y); w.y = pk2(h.z, h.w);
            *(u32x2*)(XN + (size_t)row * DM + c) = w;
        }
    }
}
__device__ __forceinline__ void phase_bias(Frame& F) {
    const Params& P = *F.p; const float* macc = (const float*)(P.ws + WS_CTL); float* bias = (float*)(P.ws + WS_BIAS);
#pragma unroll 1
    for (int l = 1; l < 4; ++l) {
        const bf16_t* Wt = (const bf16_t*)(P.ws + (l == 1 ? W_SWAIN : (l == 2 ? W_RWIN : W_SGIN1))); const int N = l == 1 ? N_SWA : (l == 2 ? N_RWP : N_SG);
        f32x4 sh[2][4][2];
#pragma unroll
        for (int b = 0; b < 2; ++b)
#pragma unroll
            for (int j = 0; j < 4; ++j)
#pragma unroll
                for (int h = 0; h < 2; ++h) { const int k = 8 * F.lane + 512 * j + 4 * h; sh[b][j][h] = *(const f32x4*)(macc + ((size_t)l * 2 + b) * N_SG + k) + *(const f32x4*)(P.in[5] + (size_t)l * N_SG + k); }
        for (int n = F.gw; n < N; n += F.NGW) {
            float s0 = 0.f, s1 = 0.f;
#pragma unroll
            for (int j = 0; j < 4; ++j) {
                float w[8]; unpack8(*(const u32x4*)(Wt + (size_t)n * DM + 8 * F.lane + 512 * j), w);
#pragma unroll
                for (int e = 0; e < 8; ++e) { s0 += w[e] * sh[0][j][e >> 2][e & 3]; s1 += w[e] * sh[1][j][e >> 2][e & 3]; }
            }
            s0 = wave_sum(s0); s1 = wave_sum(s1);
            if (F.lane == 0) { bias[((size_t)(l - 1) * 2 + 0) * N_RWP + n] = s0; bias[((size_t)(l - 1) * 2 + 1) * N_RWP + n] = s1; }
        }
    }
}
__device__ __forceinline__ void phase_final(Frame& F, const float* xin) {
    const Params& P = *F.p; const float* g = P.in[6];
    for (int row = F.gw; row < M; row += F.NGW) {
        const f32x4* xr = (const f32x4*)(xin + (size_t)row * DM) + F.lane;
        f32x4 v[8]; float ss = 0.f;
#pragma unroll
        for (int j = 0; j < 8; ++j) { v[j] = __builtin_nontemporal_load(xr + 64 * j); ss += (v[j].x * v[j].x + v[j].y * v[j].y) + (v[j].z * v[j].z + v[j].w * v[j].w); }
        const float rstd = rsqrtf(wave_sum(ss) * (1.0f / DM) + 1e-6f);
        f32x4* o = (f32x4*)(P.out + (size_t)row * DM) + F.lane;
#pragma unroll
        for (int j = 0; j < 8; ++j) { const f32x4 g4 = *(const f32x4*)(g + 256 * j + 4 * F.lane); __builtin_nontemporal_store(v[j] * rstd * g4, o + 64 * j); }
    }
}

__device__ __forceinline__ void phase_sgmix(Frame& F, int j, const bf16_t* UZ, const bf16_t* GV, const float* stats, bf16_t* A2) {
    const Params& P = *F.p;
    const float* ln_g = P.in[9] + (size_t)j * DM; const float* ln_b = P.in[10] + (size_t)j * DM;
    const float* wsp = P.in[11] + (size_t)j * 16 * 128 * 128; const float* bsp = P.in[12] + (size_t)j * 16 * 128;
    LAS bf16_t* VT = (LAS bf16_t*)F.lds;
    LAS f32x2* rowstat = (LAS f32x2*)(F.lds + 128 * 136 * 2);
    const int tid = F.tid, lane = F.lane, w = F.wave, gq = lane >> 4, rho = lane & 15;
    for (int item = blockIdx.x; item < 1024; item += gridDim.x) {
        const int g = item & 15, chunk = item >> 4, t0 = chunk * 128, c0 = g * 128;
        const int t = 16 * w + rho, nks = (w >> 1) + 1;
        u32x4 raw[4];
#pragma unroll
        for (int jj = 0; jj < 4; ++jj) { const int q_ = tid + 512 * jj; raw[jj] = __builtin_nontemporal_load((const u32x4*)(GV + (size_t)(t0 + (q_ >> 4)) * DM + c0 + (q_ & 15) * 8)); }
        f32x4 wa[4], wb[4];
#pragma unroll
        for (int ks = 0; ks < 4; ++ks) {
            wa[ks] = (f32x4){0.f, 0.f, 0.f, 0.f}; wb[ks] = wa[ks];
            if (ks < nks) { const float* wp = wsp + ((size_t)(g * 128 + t)) * 128 + 32 * ks + 8 * gq; wa[ks] = *(const f32x4*)wp; wb[ks] = *(const f32x4*)(wp + 4); }
        }
        const float bias = bsp[g * 128 + t]; const size_t rowoff = (size_t)(t0 + t) * DM + c0;
        u32x4 ur[4];
#pragma unroll
        for (int ntp = 0; ntp < 4; ++ntp) ur[ntp] = __builtin_nontemporal_load((const u32x4*)(UZ + rowoff + 32 * ntp + 8 * gq));
        float s_ = 0.f, q2_ = 0.f;
        if (tid < 128) {
            const f32x2* sp = (const f32x2*)(stats + (size_t)(t0 + tid) * 64);
#pragma unroll 8
            for (int p = 0; p < 32; ++p) { const f32x2 v = sp[p]; s_ += v.x; q2_ += v.y; }
        }
        __syncthreads();
        if (tid < 128) {
            const float mean = s_ * (1.0f / DM), var = q2_ * (1.0f / DM) - mean * mean;
            rowstat[tid] = (f32x2){mean, rsqrtf(var + 1e-5f)};
        }
        __syncthreads();
#pragma unroll
        for (int jj = 0; jj < 4; ++jj) {
            const int q_ = tid + 512 * jj, s = q_ >> 4, cc = (q_ & 15) * 8;
            const f32x2 st = rowstat[s];
            float v[8]; unpack8(raw[jj], v);
            const f32x4 g0 = *(const f32x4*)(ln_g + c0 + cc), g1 = *(const f32x4*)(ln_g + c0 + cc + 4);
            const f32x4 b0 = *(const f32x4*)(ln_b + c0 + cc), b1 = *(const f32x4*)(ln_b + c0 + cc + 4);
#pragma unroll
            for (int e = 0; e < 8; ++e) {
                const float gg = e < 4 ? g0[e & 3] : g1[e & 3], bb = e < 4 ? b0[e & 3] : b1[e & 3];
                VT[(cc + e) * 136 + (s ^ (cc & 120))] = (bf16_t)f2bf((v[e] - st.x) * st.y * gg + bb);
            }
        }
        __syncthreads();
        bf16x8 yf[4];
#pragma unroll
        for (int ks = 0; ks < 4; ++ks) {
            const int s0 = 32 * ks + 8 * gq; float v[8];
#pragma unroll
            for (int e = 0; e < 4; ++e) { v[e] = (s0 + e <= t) ? wa[ks][e] : 0.f; v[4 + e] = (s0 + 4 + e <= t) ? wb[ks][e] : 0.f; }
            const u32x4 pk = pack8(v); yf[ks] = __builtin_bit_cast(bf16x8, pk);
        }
        f32x4 acc[4][2];
#pragma unroll
        for (int ntp = 0; ntp < 4; ++ntp)
#pragma unroll
            for (int n = 0; n < 2; ++n) {
                acc[ntp][n] = (f32x4){0.f, 0.f, 0.f, 0.f};
                const int c = 32 * ntp + 8 * (rho >> 2) + 4 * n + (rho & 3);
#pragma unroll
                for (int ks = 0; ks < 4; ++ks)
                    if (ks < nks) {
                        const bf16x8 xf = *(const LAS bf16x8*)(VT + c * 136 + ((32 * ks + 8 * gq) ^ (c & 120)));
                        acc[ntp][n] = __builtin_amdgcn_mfma_f32_16x16x32_bf16(xf, yf[ks], acc[ntp][n], 0, 0, 0);
                    }
            }
#pragma unroll
        for (int ntp = 0; ntp < 4; ++ntp) {
            const int c = 32 * ntp + 8 * gq;
            float uf[8], o[8]; unpack8(ur[ntp], uf);
#pragma unroll
            for (int e = 0; e < 8; ++e) { const float f = (e < 4 ? acc[ntp][0][e & 3] : acc[ntp][1][e & 3]) + bias; o[e] = uf[e] * f; }
            *(u32x4*)(A2 + rowoff + c) = pack8(o);
        }
    }
}

__device__ __forceinline__ void phase_attn(Frame& F, const bf16_t* Qb, const bf16_t* Kb, const bf16_t* Vb, const bf16_t* Zb, bf16_t* A2) {
    const Params& P = *F.p; const float* sinks = P.in[15];
    LAS bf16_t* KS = (LAS bf16_t*)F.lds;
    LAS bf16_t* VT = (LAS bf16_t*)(F.lds + 36864);
    LAS bf16_t* PS = (LAS bf16_t*)(F.lds + 72704 + F.wave * 5376);
    const int tid = F.tid, lane = F.lane, w = F.wave, gq = lane >> 4, rho = lane & 15;
    for (int item = blockIdx.x; item < 256; item += gridDim.x) {
        const int g = item & 3, nb = (item >> 2) & 31, b = item >> 7;
        const int tq0 = b * SEQ + nb * 128;
        __syncthreads();
#pragma unroll
        for (int jj = 0; jj < 4; ++jj) {
            const int q_ = tid + 512 * jj, key = q_ >> 3, ch = q_ & 7; const bool valid = (nb > 0) || (key >= 128);
            const size_t go = (size_t)(tq0 - 128 + key) * 256 + g * 64 + ch * 8;
            u32x4 kv = {0u, 0u, 0u, 0u}, vv = kv;
            if (valid) { kv = *(const u32x4*)(Kb + go); vv = *(const u32x4*)(Vb + go); }
            *(LAS u32x4*)(KS + key * 72 + ch * 8) = kv;
            const unsigned ww[4] = {vv.x, vv.y, vv.z, vv.w};
#pragma unroll
            for (int e = 0; e < 4; ++e) { VT[(ch * 8 + 2 * e) * 280 + key] = (bf16_t)(ww[e] & 0xffffu); VT[(ch * 8 + 2 * e + 1) * 280 + key] = (bf16_t)(ww[e] >> 16); }
        }
        if (tid < 192) { const int row = tid / 3, part = tid % 3; *(LAS u32x4*)(VT + row * 280 + 256 + part * 8) = (u32x4){0u, 0u, 0u, 0u}; }
        __syncthreads();
        const bf16_t* qbase = Qb + (size_t)(tq0 + 16 * w + rho) * DM + g * 512 + 8 * gq;
        const size_t zbase = (size_t)(tq0 + 16 * w + rho) * DM + g * 512 + 4 * gq;
        bf16x8 qn0 = __builtin_nontemporal_load((const bf16x8*)qbase), qn1 = __builtin_nontemporal_load((const bf16x8*)(qbase + 32));
        u32x2 zn[4];
#pragma unroll
        for (int dt = 0; dt < 4; ++dt) zn[dt] = __builtin_nontemporal_load((const u32x2*)(Zb + zbase + 16 * dt));
        for (int r = 0; r < 8; ++r) {
            const int hq = g * 8 + r; const float sink = sinks[hq];
            const bf16x8 qf0 = qn0, qf1 = qn1;
            u32x2 zc[4];
#pragma unroll
            for (int dt = 0; dt < 4; ++dt) zc[dt] = zn[dt];
            if (r < 7) {
                qn0 = __builtin_nontemporal_load((const bf16x8*)(qbase + 64 * (r + 1))); qn1 = __builtin_nontemporal_load((const bf16x8*)(qbase + 64 * (r + 1) + 32));
#pragma unroll
                for (int dt = 0; dt < 4; ++dt) zn[dt] = __builtin_nontemporal_load((const u32x2*)(Zb + zbase + 64 * (r + 1) + 16 * dt));
            }
            f32x4 sc[9];
#pragma unroll
            for (int jt = 0; jt < 9; ++jt) {
                const int kt = w + jt; const LAS bf16_t* kp = KS + (16 * kt + rho) * 72 + 8 * gq;
                const bf16x8 k0 = *(const LAS bf16x8*)kp, k1 = *(const LAS bf16x8*)(kp + 32);
                f32x4 a = {0.f, 0.f, 0.f, 0.f};
                a = __builtin_amdgcn_mfma_f32_16x16x32_bf16(qf0, k0, a, 0, 0, 0);
                a = __builtin_amdgcn_mfma_f32_16x16x32_bf16(qf1, k1, a, 0, 0, 0);
                const int kj = 16 * kt + rho;
#pragma unroll
                for (int i = 0; i < 4; ++i) { const int rel = 16 * w + 4 * gq + i + 128 - kj; const bool ok = (rel >= 0) && (rel < 128) && ((nb > 0) || (kj >= 128)); sc[jt][i] = ok ? a[i] * 0.125f : -INFINITY; }
            }
#pragma unroll
            for (int i = 0; i < 4; ++i) {
                float mx = sc[0][i];
#pragma unroll
                for (int jt = 1; jt < 9; ++jt) mx = fmaxf(mx, sc[jt][i]);
                mx = fmaxf(mx, __shfl_xor(mx, 1)); mx = fmaxf(mx, __shfl_xor(mx, 2)); mx = fmaxf(mx, __shfl_xor(mx, 4)); mx = fmaxf(mx, __shfl_xor(mx, 8));
                const float mm = fmaxf(mx, sink); float sum = 0.f;
#pragma unroll
                for (int jt = 0; jt < 9; ++jt) { const float e = __expf(sc[jt][i] - mm); sc[jt][i] = e; sum += e; }
                sum += __shfl_xor(sum, 1); sum += __shfl_xor(sum, 2); sum += __shfl_xor(sum, 4); sum += __shfl_xor(sum, 8);
                const float inv = frcp(sum + __expf(sink - mm));
#pragma unroll
                for (int jt = 0; jt < 9; ++jt) PS[(4 * gq + i) * 168 + 16 * jt + rho] = (bf16_t)f2bf(sc[jt][i] * inv);
                PS[(4 * gq + i) * 168 + 144 + rho] = 0;
            }
            asm volatile("s_waitcnt lgkmcnt(0)" ::: "memory");
            f32x4 o[4];
#pragma unroll
            for (int dt = 0; dt < 4; ++dt) o[dt] = (f32x4){0.f, 0.f, 0.f, 0.f};
#pragma unroll
            for (int ks = 0; ks < 5; ++ks) {
                const bf16x8 pf = *(const LAS bf16x8*)(PS + rho * 168 + 32 * ks + 8 * gq);
#pragma unroll
                for (int dt = 0; dt < 4; ++dt) {
                    const bf16x8 vf = *(const LAS bf16x8*)(VT + (16 * dt + rho) * 280 + 16 * w + 32 * ks + 8 * gq);
                    o[dt] = __builtin_amdgcn_mfma_f32_16x16x32_bf16(vf, pf, o[dt], 0, 0, 0);
                }
            }
            asm volatile("s_waitcnt lgkmcnt(0)" ::: "memory");
#pragma unroll
            for (int dt = 0; dt < 4; ++dt) {
                const size_t off = (size_t)(tq0 + 16 * w + rho) * DM + hq * 64 + 16 * dt + 4 * gq;
                const u32x2 zr = zc[dt];
                u32x2 pk; pk.x = pk2(o[dt][0] * bflo(zr.x), o[dt][1] * bfhi(zr.x)); pk.y = pk2(o[dt][2] * bflo(zr.y), o[dt][3] * bfhi(zr.y));
                *(u32x2*)(A2 + off) = pk;
            }
        }
    }
}

struct RwBufs { bf16_t *R, *K, *V, *KK, *B, *ZS; float *W, *bonus, *Y, *Pc, *Qc, *Sst; };
__device__ __forceinline__ RwBufs rw_bufs(unsigned char* ws) {
    RwBufs r; unsigned char* b = ws + WS_RW;
    r.R = (bf16_t*)b; r.K = (bf16_t*)(b + 32 * MiB); r.V = (bf16_t*)(b + 64 * MiB); r.KK = (bf16_t*)(b + 96 * MiB); r.B = (bf16_t*)(b + 128 * MiB);
    r.W = (float*)(b + 160 * MiB); r.ZS = (bf16_t*)(b + 224 * MiB); r.bonus = (float*)(ws + WS_BONUS);
    r.Y = (float*)(ws + WS_P); r.Pc = (float*)(ws + WS_P + 64 * MiB); r.Qc = (float*)(ws + WS_P + 96 * MiB); r.Sst = (float*)(ws + WS_XN);
    return r;
}
__device__ __forceinline__ void lerp8(const u32x4 cu4, const u32x4 pr4, const LAS float* m, float (&o)[8]) {
    float cu[8], pr[8]; unpack8(cu4, cu); unpack8(pr4, pr);
    const f32x4 m0 = *(const LAS f32x4*)m, m1 = *(const LAS f32x4*)(m + 4);
#pragma unroll
    for (int e = 0; e < 8; ++e) o[e] = cu[e] + (pr[e] - cu[e]) * (e < 4 ? m0[e & 3] : m1[e & 3]);
}
__device__ __forceinline__ void phase_rwprep(Frame& F, const bf16_t* Pb) {
    const Params& P = *F.p; const RwBufs rb = rw_bufs(P.ws);
    const float* mu = P.in[18];
    LAS bf16_t* YWH = (LAS bf16_t*)F.lds; LAS bf16_t* YWL = YWH + 32 * 104; LAS bf16_t* YA = YWL + 32 * 104;
    LAS float* PRM = (LAS float*)(F.lds + 20480);
    const bf16_t* LWH = (const bf16_t*)(P.ws + WS_LORA); const bf16_t* LWL = LWH + 2048 * 96; const bf16_t* LA = LWL + 2048 * 96;
    const int tid = F.tid, lane = F.lane, gq = lane >> 4, rho = lane & 15;
    int cur_hg = -1;
    for (int item = blockIdx.x; item < 1024; item += gridDim.x) {
        const int tt = item >> 2, hg = item & 3, t0 = tt * 32, head = hg * 8 + F.wave;
        __syncthreads();
        if (hg != cur_hg) {
            cur_hg = hg;
#pragma unroll
            for (int v = 0; v < 9; ++v) {
                const float* srcp = v < 4 ? mu + v * DM : P.in[v == 4 ? 19 : (v == 5 ? 21 : (v == 6 ? 23 : (v == 7 ? 24 : 25)))];
                PRM[v * 512 + tid] = srcp[hg * 512 + tid];
            }
        }
#pragma unroll
        for (int jj = 0; jj < 2; ++jj) {
            const int q_ = tid + 512 * jj;
            if (q_ < 768) {
                const int tok = q_ / 24, ch = q_ % 24, row = t0 + tok, col = 4 * DM + ch * 8;
                const u32x4 c4 = *(const u32x4*)(Pb + (size_t)row * N_RWP + col);
                u32x4 p4 = {0u, 0u, 0u, 0u};
                if (row & (SEQ - 1)) p4 = *(const u32x4*)(Pb + (size_t)(row - 1) * N_RWP + col);
                const f32x4 m0 = *(const f32x4*)(mu + col), m1 = *(const f32x4*)(mu + col + 4);
                float cu[8], pr[8], hi[8], lo[8]; unpack8(c4, cu); unpack8(p4, pr);
#pragma unroll
                for (int x = 0; x < 8; ++x) cu[x] = cu[x] + (pr[x] - cu[x]) * (x < 4 ? m0[x & 3] : m1[x & 3]);
                if (ch < 12) {
#pragma unroll
                    for (int x = 0; x < 8; ++x) { const float th = tanhf_(cu[x]); const unsigned h = f2bf(th); hi[x] = __builtin_bit_cast(float, h << 16); lo[x] = th - hi[x]; }
                    *(LAS u32x4*)(YWH + tok * 104 + ch * 8) = pack8(hi); *(LAS u32x4*)(YWL + tok * 104 + ch * 8) = pack8(lo);
                } else *(LAS u32x4*)(YA + tok * 104 + (ch - 12) * 8) = pack8(cu);
            }
        }
        __syncthreads();
        const int cb = head * 64 + 8 * (rho >> 2) + (rho & 3);
        float carry[2][8];
#pragma unroll
        for (int ntp = 0; ntp < 2; ++ntp)
#pragma unroll
            for (int e = 0; e < 8; ++e) carry[ntp][e] = 0.f;
#pragma unroll 1
        for (int mt = 0; mt < 2; ++mt) {
            const int row = t0 + 16 * mt + rho, t = row & (SEQ - 1), bh = (row >> 12) * 32 + head; const bool first = (t == 0);
            const size_t obase = ((size_t)bh * SEQ + t) * 64;
            const bf16_t* prow = Pb + (size_t)row * N_RWP + head * 64 + 8 * gq; const bf16_t* pprev = first ? prow : prow - N_RWP;
            const u32x4 kc0 = *(const u32x4*)(prow + DM), kc1 = *(const u32x4*)(prow + DM + 32);
            u32x4 kp0 = *(const u32x4*)(pprev + DM), kp1 = *(const u32x4*)(pprev + DM + 32);
            if (first) { kp0 = (u32x4){0u, 0u, 0u, 0u}; kp1 = kp0; }
            const u32x4 rc0 = *(const u32x4*)(prow), vc0 = *(const u32x4*)(prow + 2 * DM), zc0 = *(const u32x4*)(prow + 3 * DM);
            u32x4 rp0 = *(const u32x4*)(pprev), vp0 = *(const u32x4*)(pprev + 2 * DM), zp0 = *(const u32x4*)(pprev + 3 * DM);
            if (first) { rp0 = (u32x4){0u, 0u, 0u, 0u}; vp0 = rp0; zp0 = rp0; }
            f32x4 aw[2][2], aa[2][2];
            const int yo = (16 * mt + rho) * 104 + 8 * gq;
#pragma unroll
            for (int ntp = 0; ntp < 2; ++ntp)
#pragma unroll
                for (int n = 0; n < 2; ++n) {
                    aw[ntp][n] = (f32x4){0.f, 0.f, 0.f, 0.f}; aa[ntp][n] = aw[ntp][n];
                    const size_t xo = (size_t)(cb + 32 * ntp + 4 * n) * 96 + 8 * gq;
#pragma unroll
                    for (int k3 = 0; k3 < 3; ++k3) {
                        const bf16x8 xh = *(const bf16x8*)(LWH + xo + 32 * k3), xl = *(const bf16x8*)(LWL + xo + 32 * k3), xa = *(const bf16x8*)(LA + xo + 32 * k3);
                        const bf16x8 ywh = *(const LAS bf16x8*)(YWH + yo + 32 * k3), ywl = *(const LAS bf16x8*)(YWL + yo + 32 * k3), ya = *(const LAS bf16x8*)(YA + yo + 32 * k3);
                        aw[ntp][n] = __builtin_amdgcn_mfma_f32_16x16x32_bf16(xh, ywh, aw[ntp][n], 0, 0, 0);
                        aw[ntp][n] = __builtin_amdgcn_mfma_f32_16x16x32_bf16(xh, ywl, aw[ntp][n], 0, 0, 0);
                        aw[ntp][n] = __builtin_amdgcn_mfma_f32_16x16x32_bf16(xl, ywh, aw[ntp][n], 0, 0, 0);
                        aa[ntp][n] = __builtin_amdgcn_mfma_f32_16x16x32_bf16(xa, ya, aa[ntp][n], 0, 0, 0);
                    }
                    asm volatile("" ::: "memory");
                }
            const LAS float* prm = PRM + F.wave * 64 + 8 * gq;
            float kl[2][8]; float kkss = 0.f, bon = 0.f;
            lerp8(kc0, kp0, prm + 512, kl[0]); lerp8(kc1, kp1, prm + 512 + 32, kl[1]);
#pragma unroll
            for (int ntp = 0; ntp < 2; ++ntp) {
                const f32x4 q0 = *(const LAS f32x4*)(prm + 6 * 512 + 32 * ntp), q1 = *(const LAS f32x4*)(prm + 6 * 512 + 32 * ntp + 4);
#pragma unroll
                for (int e = 0; e < 8; ++e) { const float l = kl[ntp][e] * (e < 4 ? q0[e & 3] : q1[e & 3]); kkss += l * l; }
            }
            kkss += __shfl_xor(kkss, 16); kkss += __shfl_xor(kkss, 32);
            const float inv = 1.0f / fmaxf(sqrtf(kkss), 1e-12f);
#pragma unroll
            for (int ntp = 0; ntp < 2; ++ntp) {
                const int cl = 32 * ntp + 8 * gq;
                const f32x4 aa0 = aa[ntp][0], aa1 = aa[ntp][1];
                const LAS float* pq = prm + 32 * ntp;
                u32x4 rcx = rc0, vcx = vc0, zcx = zc0, rpx = rp0, vpx = vp0, zpx = zp0;
                if (ntp == 1) {
                    rcx = *(const u32x4*)(prow + 32); vcx = *(const u32x4*)(prow + 2 * DM + 32); zcx = *(const u32x4*)(prow + 3 * DM + 32);
                    rpx = *(const u32x4*)(pprev + 32); vpx = *(const u32x4*)(pprev + 2 * DM + 32); zpx = *(const u32x4*)(pprev + 3 * DM + 32);
                    if (first) { vpx = (u32x4){0u, 0u, 0u, 0u}; zpx = vpx; rpx = vpx; }
                }
                float lwv[8], G[8];
                { const f32x4 w0a = *(const LAS f32x4*)(pq + 4 * 512), w0b = *(const LAS f32x4*)(pq + 4 * 512 + 4);
#pragma unroll
                  for (int e = 0; e < 8; ++e) {
                    const float lw = (e < 4 ? aw[ntp][0][e & 3] + w0a[e & 3] : aw[ntp][1][e & 3] + w0b[e & 3]);
                    const float l = -DECAY_SCALE * sigmoidf_(lw); lwv[e] = l;
                    float x = l;
                    x += __builtin_bit_cast(float, __builtin_amdgcn_update_dpp(0, __builtin_bit_cast(int, x), 0x111, 0xF, 0xF, true));
                    x += __builtin_bit_cast(float, __builtin_amdgcn_update_dpp(0, __builtin_bit_cast(int, x), 0x112, 0xF, 0xF, true));
                    x += __builtin_bit_cast(float, __builtin_amdgcn_update_dpp(0, __builtin_bit_cast(int, x), 0x114, 0xF, 0xF, true));
                    x += __builtin_bit_cast(float, __builtin_amdgcn_update_dpp(0, __builtin_bit_cast(int, x), 0x118, 0xF, 0xF, true));
                    x += carry[ntp][e]; G[e] = x;
                    carry[ntp][e] = __shfl(x, (lane & 48) | 15);
                  } }
                float rl[8], vl[8], zl[8];
                lerp8(rcx, rpx, pq, rl); lerp8(vcx, vpx, pq + 2 * 512, vl); lerp8(zcx, zpx, pq + 3 * 512, zl);
#pragma unroll
                for (int e = 0; e < 8; ++e) zl[e] = siluf_(zl[e]);
                *(u32x4*)(rb.V + obase + cl) = pack8(vl);
                *(u32x4*)(rb.ZS + obase + cl) = pack8(zl);
                const f32x4 a0a = *(const LAS f32x4*)(pq + 5 * 512), a0b = *(const LAS f32x4*)(pq + 5 * 512 + 4);
                const f32x4 kka = *(const LAS f32x4*)(pq + 6 * 512), kkb = *(const LAS f32x4*)(pq + 6 * 512 + 4), kaa = *(const LAS f32x4*)(pq + 7 * 512), kab = *(const LAS f32x4*)(pq + 7 * 512 + 4);
                const f32x4 rka = *(const LAS f32x4*)(pq + 8 * 512), rkb = *(const LAS f32x4*)(pq + 8 * 512 + 4);
                float eg[8], rs[8], ks_[8], kkn[8], bbn[8];
#pragma unroll
                for (int e = 0; e < 8; ++e) {
                    const float la = (e < 4 ? aa0[e & 3] + a0a[e & 3] : aa1[e & 3] + a0b[e & 3]);
                    const float a = sigmoidf_(la);
                    const float g = G[e]; eg[e] = __expf(g); const float egn = __expf(-g), egp = __expf(g - lwv[e]);
                    const float kx = kl[ntp][e];
                    const float kk = kx * (e < 4 ? kka[e & 3] : kkb[e & 3]) * inv;
                    kkn[e] = kk * egp; bbn[e] = kk * a * egn;
                    const float kmod = kx * (1.0f + (a - 1.0f) * (e < 4 ? kaa[e & 3] : kab[e & 3]));
                    bon += rl[e] * kmod * (e < 4 ? rka[e & 3] : rkb[e & 3]);
                    ks_[e] = kmod * egn; rs[e] = rl[e] * eg[e];
                }
                *(u32x4*)(rb.KK + obase + cl) = pack8(kkn);
                *(u32x4*)(rb.B + obase + cl) = pack8(bbn);
                *(u32x4*)(rb.K + obase + cl) = pack8(ks_);
                *(u32x4*)(rb.R + obase + cl) = pack8(rs);
                if ((t & 31) == 31) {
                    float* gp = rb.W + ((size_t)bh * (SEQ / 32) + (t >> 5)) * 64 + cl;
                    *(f32x4*)gp = (f32x4){eg[0], eg[1], eg[2], eg[3]}; *(f32x4*)(gp + 4) = (f32x4){eg[4], eg[5], eg[6], eg[7]};
                }
            }
            bon += __shfl_xor(bon, 16); bon += __shfl_xor(bon, 32);
            if (gq == 0) rb.bonus[(size_t)bh * SEQ + t] = bon;
        }
    }
}

__device__ __forceinline__ float dpp_xor1(float v) { return __builtin_bit_cast(float, __builtin_amdgcn_mov_dpp(__builtin_bit_cast(int, v), 0xB1, 0xF, 0xF, true)); }
__device__ __forceinline__ float dpp_xor2(float v) { return __builtin_bit_cast(float, __builtin_amdgcn_mov_dpp(__builtin_bit_cast(int, v), 0x4E, 0xF, 0xF, true)); }

template <int MODE>
__device__ __forceinline__ void scan_task(LAS float* L, int lane, int bh, int chunk, const RwBufs& rb, const float* gn_g = nullptr, const float* gn_b = nullptr, bf16_t* A2 = nullptr) {
    const int rg = lane >> 2, ks = lane & 3;
    f32x2 s[4][8];
    const size_t mat = ((size_t)bh * NCH + chunk) * 4096;
#pragma unroll
    for (int j = 0; j < 4; ++j)
#pragma unroll
        for (int i = 0; i < 8; ++i) {
            if (MODE == 0) { const int v = 4 * rg + j, k = 16 * ks + 2 * i; s[j][i] = (f32x2){v == k ? 1.f : 0.f, v == k + 1 ? 1.f : 0.f}; }
            else if (MODE == 1) s[j][i] = (f32x2){0.f, 0.f};
            else s[j][i] = *(const f32x2*)(rb.Sst + mat + (4 * rg + j) * 64 + 16 * ks + 2 * i);
        }
    const size_t g0 = ((size_t)bh * SEQ + (size_t)chunk * CHL) * 64;
    const float* gam = rb.W + ((size_t)bh * (SEQ / 32) + (size_t)chunk * (CHL / 32)) * 64 + 16 * ks;
    u32x4 rkk, rbb, rk = {0u, 0u, 0u, 0u}, rr = rk, rv = rk;
    { const size_t go = g0 + lane * 8;
      rkk = *(const u32x4*)(rb.KK + go); rbb = *(const u32x4*)(rb.B + go);
      if (MODE != 0) { rk = *(const u32x4*)(rb.K + go); rv = *(const u32x4*)(rb.V + go); }
      if (MODE == 2) rr = __builtin_nontemporal_load((const u32x4*)(rb.R + go)); }
    f32x4 gm[4];
    const int sp = lane >> 3, ch = lane & 7, hh = bh & 31;
    f32x4 gg0 = {0.f, 0.f, 0.f, 0.f}, gg1 = gg0, gb0 = gg0, gb1 = gg0;
    if (MODE == 2) { gg0 = *(const f32x4*)(gn_g + hh * 64 + ch * 8); gg1 = *(const f32x4*)(gn_g + hh * 64 + ch * 8 + 4); gb0 = *(const f32x4*)(gn_b + hh * 64 + ch * 8); gb1 = *(const f32x4*)(gn_b + hh * 64 + ch * 8 + 4); }
    for (int blk = 0; blk < CHL / 8; ++blk) {
        LAS float* d = L + lane * 8;
        u32x4 zs4 = {0u, 0u, 0u, 0u}; float bon = 0.f;
        if (MODE == 2) { const size_t pr = (size_t)bh * SEQ + (size_t)chunk * CHL + blk * 8 + sp; zs4 = __builtin_nontemporal_load((const u32x4*)(rb.ZS + pr * 64 + ch * 8)); bon = rb.bonus[pr]; }
        { float f[8]; unpack8(rkk, f); *(LAS f32x4*)(d) = (f32x4){f[0], f[1], f[2], f[3]}; *(LAS f32x4*)(d + 4) = (f32x4){f[4], f[5], f[6], f[7]}; }
        { float f[8]; unpack8(rbb, f); *(LAS f32x4*)(d + 512) = (f32x4){f[0], f[1], f[2], f[3]}; *(LAS f32x4*)(d + 516) = (f32x4){f[4], f[5], f[6], f[7]}; }
        if (MODE != 0) {
            { float f[8]; unpack8(rk, f); *(LAS f32x4*)(d + 1024) = (f32x4){f[0], f[1], f[2], f[3]}; *(LAS f32x4*)(d + 1028) = (f32x4){f[4], f[5], f[6], f[7]}; }
            { float f[8]; unpack8(rv, f); *(LAS f32x4*)(d + 2048) = (f32x4){f[0], f[1], f[2], f[3]}; *(LAS f32x4*)(d + 2052) = (f32x4){f[4], f[5], f[6], f[7]}; }
        }
        if (MODE == 2) { float f[8]; unpack8(rr, f); *(LAS f32x4*)(d + 1536) = (f32x4){f[0], f[1], f[2], f[3]}; *(LAS f32x4*)(d + 1540) = (f32x4){f[4], f[5], f[6], f[7]}; }
        if (blk + 1 < CHL / 8) {
            const size_t go = g0 + (size_t)(blk + 1) * 512 + lane * 8;
            rkk = *(const u32x4*)(rb.KK + go); rbb = *(const u32x4*)(rb.B + go);
            if (MODE != 0) { rk = *(const u32x4*)(rb.K + go); rv = *(const u32x4*)(rb.V + go); }
            if (MODE == 2) rr = __builtin_nontemporal_load((const u32x4*)(rb.R + go));
        }
        if ((blk & 3) == 0) {
            const float* gp = gam + (size_t)(blk >> 2) * 64;
            gm[0] = *(const f32x4*)gp; gm[1] = *(const f32x4*)(gp + 4); gm[2] = *(const f32x4*)(gp + 8); gm[3] = *(const f32x4*)(gp + 12);
        }
        asm volatile("s_waitcnt lgkmcnt(0)" ::: "memory");
#pragma unroll 1
        for (int st = 0; st < 8; ++st) {
            const LAS float* q = L + st * 64 + 16 * ks;
            f32x2 kk2[8], b2[8], k2[8], r2[8];
#pragma unroll
            for (int i4 = 0; i4 < 4; ++i4) {
                const f32x4 b = *(const LAS f32x4*)(q + 4 * i4); kk2[2 * i4] = (f32x2){b.x, b.y}; kk2[2 * i4 + 1] = (f32x2){b.z, b.w};
                const f32x4 c = *(const LAS f32x4*)(q + 512 + 4 * i4); b2[2 * i4] = (f32x2){c.x, c.y}; b2[2 * i4 + 1] = (f32x2){c.z, c.w};
                if (MODE != 0) { const f32x4 dd = *(const LAS f32x4*)(q + 1024 + 4 * i4); k2[2 * i4] = (f32x2){dd.x, dd.y}; k2[2 * i4 + 1] = (f32x2){dd.z, dd.w}; }
                if (MODE == 2) { const f32x4 e = *(const LAS f32x4*)(q + 1536 + 4 * i4); r2[2 * i4] = (f32x2){e.x, e.y}; r2[2 * i4 + 1] = (f32x2){e.z, e.w}; }
            }
            f32x4 vv = {0.f, 0.f, 0.f, 0.f};
            if (MODE != 0) vv = *(const LAS f32x4*)(L + 2048 + st * 64 + 4 * rg);
            float yv[4], sa[4];
#pragma unroll
            for (int j = 0; j < 4; ++j) {
                f32x2 a0 = s[j][0] * kk2[0], a1 = s[j][1] * kk2[1];
#pragma unroll
                for (int i = 2; i < 8; i += 2) { a0 += s[j][i] * kk2[i]; a1 += s[j][i + 1] * kk2[i + 1]; }
                const f32x2 a = a0 + a1; sa[j] = a.x + a.y;
            }
#pragma unroll
            for (int j = 0; j < 4; ++j) sa[j] += dpp_xor1(sa[j]);
#pragma unroll
            for (int j = 0; j < 4; ++j) sa[j] += dpp_xor2(sa[j]);
            if (MODE != 0) {
#pragma unroll
                for (int j = 0; j < 4; ++j) {
                    const f32x2 vj = (f32x2){vv[j], vv[j]};
#pragma unroll
                    for (int i = 0; i < 8; ++i) s[j][i] = __builtin_elementwise_fma(vj, k2[i], s[j][i]);
                }
            }
#pragma unroll
            for (int j = 0; j < 4; ++j) {
                const f32x2 nsa = (f32x2){-sa[j], -sa[j]};
#pragma unroll
                for (int i = 0; i < 8; ++i) s[j][i] = __builtin_elementwise_fma(nsa, b2[i], s[j][i]);
            }
            if (MODE == 2) {
#pragma unroll
                for (int j = 0; j < 4; ++j) {
                    f32x2 y0 = s[j][0] * r2[0], y1 = s[j][1] * r2[1];
#pragma unroll
                    for (int i = 2; i < 8; i += 2) { y0 += s[j][i] * r2[i]; y1 += s[j][i + 1] * r2[i + 1]; }
                    const f32x2 y = y0 + y1; yv[j] = y.x + y.y;
                }
#pragma unroll
                for (int j = 0; j < 4; ++j) yv[j] += dpp_xor1(yv[j]);
#pragma unroll
                for (int j = 0; j < 4; ++j) yv[j] += dpp_xor2(yv[j]);
            }
            if (MODE == 2) { if (ks == 0) *(LAS f32x4*)(L + 2560 + st * 64 + 4 * rg) = (f32x4){yv[0], yv[1], yv[2], yv[3]}; }
        }
        if (MODE == 2) {
            asm volatile("s_waitcnt lgkmcnt(0)" ::: "memory");
            const f32x4 y0 = *(const LAS f32x4*)(L + 2560 + sp * 64 + ch * 8), y1 = *(const LAS f32x4*)(L + 2560 + sp * 64 + ch * 8 + 4);
            const f32x4 v0 = *(const LAS f32x4*)(L + 2048 + sp * 64 + ch * 8), v1 = *(const LAS f32x4*)(L + 2048 + sp * 64 + ch * 8 + 4);
            float y[8] = {y0.x, y0.y, y0.z, y0.w, y1.x, y1.y, y1.z, y1.w};
            const float vf[8] = {v0.x, v0.y, v0.z, v0.w, v1.x, v1.y, v1.z, v1.w};
            float sm = 0.f;
#pragma unroll
            for (int e = 0; e < 8; ++e) sm += y[e];
            sm += __shfl_xor(sm, 1); sm += __shfl_xor(sm, 2); sm += __shfl_xor(sm, 4);
            const float mean = sm * (1.0f / 64.0f); float qq = 0.f;
#pragma unroll
            for (int e = 0; e < 8; ++e) { y[e] -= mean; qq += y[e] * y[e]; }
            qq += __shfl_xor(qq, 1); qq += __shfl_xor(qq, 2); qq += __shfl_xor(qq, 4);
            const float rstd = rsqrtf(qq * (1.0f / 64.0f) + 64e-5f);
            float zf[8], o[8]; unpack8(zs4, zf);
#pragma unroll
            for (int e = 0; e < 8; ++e) o[e] = (y[e] * rstd * (e < 4 ? gg0[e & 3] : gg1[e & 3]) + (e < 4 ? gb0[e & 3] : gb1[e & 3]) + bon * vf[e]) * zf[e];
            const size_t tok = (size_t)(bh >> 5) * SEQ + (size_t)chunk * CHL + blk * 8 + sp;
            *(u32x4*)(A2 + tok * DM + hh * 64 + ch * 8) = pack8(o);
        }
        if ((blk & 3) == 3) {
#pragma unroll
            for (int j = 0; j < 4; ++j)
#pragma unroll
                for (int i4 = 0; i4 < 4; ++i4) { s[j][2 * i4] *= (f32x2){gm[i4].x, gm[i4].y}; s[j][2 * i4 + 1] *= (f32x2){gm[i4].z, gm[i4].w}; }
        }
        asm volatile("s_waitcnt lgkmcnt(0)" ::: "memory");
    }
    if (MODE != 2) {
        float* dst = (MODE == 0 ? rb.Pc : rb.Qc) + mat;
#pragma unroll
        for (int j = 0; j < 4; ++j)
#pragma unroll
            for (int i = 0; i < 8; ++i) *(f32x2*)(dst + (4 * rg + j) * 64 + 16 * ks + 2 * i) = s[j][i];
    }
}
__device__ __forceinline__ void phase_scanA(Frame& F) {
    const RwBufs rb = rw_bufs(F.p->ws); LAS float* L = (LAS float*)(F.lds + F.wave * 12288);
    const int part = F.wave >> 2, npair = gridDim.x * 4;
    for (int bc = blockIdx.x * 4 + (F.wave & 3); bc < 64 * NCH; bc += npair) {
        const int bh = bc / NCH, chunk = bc % NCH;
        if (part == 0) scan_task<0>(L, F.lane, bh, chunk, rb); else scan_task<1>(L, F.lane, bh, chunk, rb);
    }
}
__device__ __forceinline__ void phase_scanC(Frame& F) {
    const RwBufs rb = rw_bufs(F.p->ws); LAS float* L = (LAS float*)(F.lds + F.wave * 12288);
    for (int task = F.gw; task < 64 * NCH; task += F.NGW) scan_task<2>(L, F.lane, task / NCH, task % NCH, rb, F.p->in[26], F.p->in[27], (bf16_t*)(F.p->ws + WS_A2));
}
__device__ __forceinline__ void phase_scanB(Frame& F) {
    const RwBufs rb = rw_bufs(F.p->ws);
    LAS float* SL = (LAS float*)F.lds;
    LAS float* PL = SL + 16 * 68;
    const int tid = F.tid, lane = F.lane, w = F.wave, g = lane >> 4, rho = lane & 15;
    for (int unit = blockIdx.x; unit < 256; unit += gridDim.x) {
        const int bh = unit >> 2, vq = unit & 3;
        f32x4 acc = {0.f, 0.f, 0.f, 0.f};
        const size_t rowoff = (size_t)(16 * vq + 4 * g) * 64 + 16 * (w & 3) + rho;
        if (w < 4) {
            float* d = rb.Sst + ((size_t)bh * NCH) * 4096 + rowoff;
#pragma unroll
            for (int i = 0; i < 4; ++i) d[64 * i] = 0.f;
        }
        f32x4 pa, pb; float qv[4];
        { const size_t mat = ((size_t)bh * NCH) * 4096;
          pa = *(const f32x4*)(rb.Pc + mat + tid * 8); pb = *(const f32x4*)(rb.Pc + mat + tid * 8 + 4);
#pragma unroll
          for (int i = 0; i < 4; ++i) qv[i] = rb.Qc[mat + rowoff + 64 * i]; }
        for (int c = 0; c < NCH - 1; ++c) {
            const size_t mat = ((size_t)bh * NCH + c) * 4096;
            __syncthreads();
            { const int r = tid >> 3, cc = (tid & 7) * 8; *(LAS f32x4*)(PL + r * 68 + cc) = pa; *(LAS f32x4*)(PL + r * 68 + cc + 4) = pb; }
            if (w < 4) {
#pragma unroll
                for (int i = 0; i < 4; ++i) SL[(4 * g + i) * 68 + 16 * w + rho] = acc[i];
            }
            f32x4 a0 = {qv[0], qv[1], qv[2], qv[3]};
            if (c + 1 < NCH - 1) {
                pa = *(const f32x4*)(rb.Pc + mat + 4096 + tid * 8); pb = *(const f32x4*)(rb.Pc + mat + 4096 + tid * 8 + 4);
#pragma unroll
                for (int i = 0; i < 4; ++i) qv[i] = rb.Qc[mat + 4096 + rowoff + 64 * i];
            }
            __syncthreads();
            if (w < 4) {
                f32x4 a1 = {0.f, 0.f, 0.f, 0.f};
#pragma unroll
                for (int ks = 0; ks < 16; ks += 2) {
                    const float s0 = SL[rho * 68 + 4 * ks + g], p0 = PL[(4 * ks + g) * 68 + 16 * w + rho];
                    const float s1 = SL[rho * 68 + 4 * ks + 4 + g], p1 = PL[(4 * ks + 4 + g) * 68 + 16 * w + rho];
                    a0 = __builtin_amdgcn_mfma_f32_16x16x4f32(s0, p0, a0, 0, 0, 0);
                    a1 = __builtin_amdgcn_mfma_f32_16x16x4f32(s1, p1, a1, 0, 0, 0);
                }
                acc = a0 + a1;
                float* d = rb.Sst + mat + 4096 + rowoff;
#pragma unroll
                for (int i = 0; i < 4; ++i) d[64 * i] = acc[i];
            }
        }
    }
}
__device__ __forceinline__ void phase_rwpost(Frame& F, bf16_t* A2) {
    const Params& P = *F.p; const RwBufs rb = rw_bufs(P.ws); const float* gn_g = P.in[26]; const float* gn_b = P.in[27];
    const int lane = F.lane, ch = lane & 7;
    for (int it = F.gw; it < 64 * SEQ / 8; it += F.NGW) {
        const int pair = it * 8 + (lane >> 3), bh = pair >> 12, t = pair & (SEQ - 1), h = bh & 31, b = bh >> 5, c = h * 64 + ch * 8;
        const size_t go = (size_t)pair * 64 + ch * 8;
        const f32x4 y0 = *(const f32x4*)(rb.Y + go), y1 = *(const f32x4*)(rb.Y + go + 4);
        float y[8] = {y0.x, y0.y, y0.z, y0.w, y1.x, y1.y, y1.z, y1.w};
        float s = 0.f;
#pragma unroll
        for (int e = 0; e < 8; ++e) s += y[e];
        s += __shfl_xor(s, 1); s += __shfl_xor(s, 2); s += __shfl_xor(s, 4);
        const float mean = s * (1.0f / 64.0f); float q = 0.f;
#pragma unroll
        for (int e = 0; e < 8; ++e) { y[e] -= mean; q += y[e] * y[e]; }
        q += __shfl_xor(q, 1); q += __shfl_xor(q, 2); q += __shfl_xor(q, 4);
        const float rstd = rsqrtf(q * (1.0f / 64.0f) + 64e-5f), bon = rb.bonus[pair];
        float vf[8], zf[8], o[8]; unpack8(*(const u32x4*)(rb.V + go), vf); unpack8(*(const u32x4*)(rb.ZS + go), zf);
        const f32x4 g0 = *(const f32x4*)(gn_g + c), g1 = *(const f32x4*)(gn_g + c + 4), b0 = *(const f32x4*)(gn_b + c), b1 = *(const f32x4*)(gn_b + c + 4);
#pragma unroll
        for (int e = 0; e < 8; ++e) o[e] = (y[e] * rstd * (e < 4 ? g0[e & 3] : g1[e & 3]) + (e < 4 ? b0[e & 3] : b1[e & 3]) + bon * vf[e]) * zf[e];
        *(u32x4*)(A2 + ((size_t)b * SEQ + t) * DM + c) = pack8(o);
    }
}

constexpr int LDS_BYTES = 147456;
constexpr int NPHASE = 22;
__global__ void __launch_bounds__(NTHREADS, 2) fwd(Params prm) {
    extern __shared__ __attribute__((aligned(16))) unsigned char lds_raw[];
    Frame F; F.lds = (LAS unsigned char*)lds_raw; F.tid = threadIdx.x; F.lane = F.tid & 63; F.wave = __builtin_amdgcn_readfirstlane(F.tid >> 6);
    F.gw = blockIdx.x * NWAVES + F.wave; F.NGW = gridDim.x * NWAVES; F.p = &prm;
    unsigned char* ws = prm.ws;
    volatile LAS unsigned* MISC = (volatile LAS unsigned*)(F.lds + 131072 + 8192);
    if (F.tid < 16) MISC[F.tid] = 0u;
    __syncthreads();
    XcdBarrier bar; bar.bar = (unsigned*)(ws + WS_BAR); bar.x = 0; bar.st = MISC;
#if SINGLE_LAUNCH
    bar = xcd_barrier_post((unsigned*)(ws + WS_BAR), MISC);
    if (prm.use_cg) cg::this_grid().sync();
#endif
    const int lo = prm.ph_lo, hi = prm.ph_hi;
    float* X = (float*)(ws + WS_X); bf16_t* XN = (bf16_t*)(ws + WS_XN); bf16_t* A2 = (bf16_t*)(ws + WS_A2);
    bf16_t* PB = (bf16_t*)(ws + WS_P); float* stats = (float*)(ws + WS_STATS);
    const float* macc = (const float*)(ws + WS_CTL); float* ssq = (float*)(ws + WS_SSQ); const float* biasb = (const float*)(ws + WS_BIAS);
#ifndef PHMASK
#define PHMASK 0x3fffff
#endif
#define IN(k) ((((PHMASK) >> (k)) & 1) && lo <= (k) && (k) < hi)
#ifndef REPMASK
#define REPMASK 0
#endif
#define RP(k) _Pragma("unroll 1") for (int rp_ = 0; rp_ < 1 + (((REPMASK) >> (k)) & 1); ++rp_)
#if SINGLE_LAUNCH
#define SEAM(k) do { if (IN(k) && IN((k) + 1)) xcd_barrier(bar); } while (0)
#else
#define SEAM(k) do { } while (0)
#endif
#define GEMM_IN(EPI, Wt, N_) do { pg8::Gemm g{XN, (const bf16_t*)(ws + (Wt)), M, (N_), DM}; pg8::StaticOrder S; S.init(M, (N_), gridDim.x, blockIdx.x); pg8::gemm_phase(F.lds, g, S, EPI); } while (0)
#define GEMM_OUT(layer, Wt, xin_, fuse_) do { pg8::Gemm g{A2, (const bf16_t*)(ws + (Wt)), M, DM, DM}; pg8::StaticOrder S; S.init(M, DM, gridDim.x, blockIdx.x); \
        EpiOut E{(xin_), X, macc + (size_t)(layer) * 2 * N_SG + 2 * DM, prm.in[5] + (size_t)(layer) * N_SG + 2 * DM, \
                 (fuse_) ? XN : (bf16_t*)nullptr, ssq + (size_t)((layer) + 1) * M, prm.in[3] + (size_t)((layer) + 1) * DM, macc + (size_t)((layer) + 1) * 2 * N_SG + DM, prm.in[5] + (size_t)((layer) + 1) * N_SG + DM}; \
        pg8::gemm_phase(F.lds, g, S, E); } while (0)

    if (IN(0)) RP(0) { phase_p0(F); } SEAM(0);
    if (IN(1)) RP(1) { phase_norm(F, prm.in[0], 0, XN); phase_bias(F); } SEAM(1);
    if (IN(2)) RP(2) { EpiSG E{PB, stats}; GEMM_IN(E, W_SGIN0, N_SG); } SEAM(2);
    if (IN(3)) RP(3) { phase_sgmix(F, 0, PB, PB + (size_t)M * DM, stats, A2); } SEAM(3);
    if (IN(4)) RP(4) { GEMM_OUT(0, W_SGOUT0, prm.in[0], true); } SEAM(4);
    if (IN(6)) RP(6) { EpiAdj<EpiSWA> E{{PB, PB + (size_t)M * DM, PB + (size_t)M * DM + (size_t)M * 256, PB + (size_t)2 * M * DM, (const f32x2*)(ws + WS_ROPE)}, ssq + (size_t)1 * M, biasb}; GEMM_IN(E, W_SWAIN, N_SWA); } SEAM(6);
    if (IN(7)) RP(7) { phase_attn(F, PB, PB + (size_t)M * DM, PB + (size_t)M * DM + (size_t)M * 256, PB + (size_t)2 * M * DM, A2); } SEAM(7);
    if (IN(8)) RP(8) { GEMM_OUT(1, W_SWAOUT, X, true); } SEAM(8);
    if (IN(10)) RP(10) { EpiAdj<EpiPlain> E{{PB, N_RWP}, ssq + (size_t)2 * M, biasb + (size_t)2 * N_RWP}; GEMM_IN(E, W_RWIN, N_RWP); } SEAM(10);
    if (IN(11)) RP(11) { phase_rwprep(F, PB); } SEAM(11);
    if (IN(12)) RP(12) { phase_scanA(F); } SEAM(12);
    if (IN(13)) RP(13) { phase_scanB(F); } SEAM(13);
    if (IN(14)) RP(14) { phase_scanC(F); } SEAM(14);
    if (IN(16)) RP(16) { GEMM_OUT(2, W_RWOUT, X, true); } SEAM(16);
    if (IN(18)) RP(18) { EpiAdj<EpiSG> E{{PB, stats}, ssq + (size_t)3 * M, biasb + (size_t)4 * N_RWP}; GEMM_IN(E, W_SGIN1, N_SG); } SEAM(18);
    if (IN(19)) RP(19) { phase_sgmix(F, 1, PB, PB + (size_t)M * DM, stats, A2); } SEAM(19);
    if (IN(20)) RP(20) { GEMM_OUT(3, W_SGOUT1, X, false); } SEAM(20);
    if (IN(21)) RP(21) { phase_final(F, X); }
}

extern "C" void kernel_launch(void* const* d_in, const int* in_sizes, int n_in, void* d_out, int out_size, void* d_ws, size_t ws_size, hipStream_t stream) {
    static int grid = 0;
    if (grid == 0) {
        if (n_in != 28 || out_size != M * DM || ws_size < WS_END) { fprintf(stderr, "kernel_launch: unexpected shapes (n_in %d out %d ws %zu)\n", n_in, out_size, ws_size); grid = -1; return; }
        int dev = 0, cus = 0, per_cu = 0;
        hipGetDevice(&dev); hipDeviceGetAttribute(&cus, hipDeviceAttributeMultiprocessorCount, dev);
        hipFuncSetAttribute((const void*)fwd, hipFuncAttributeMaxDynamicSharedMemorySize, LDS_BYTES);
        hipOccupancyMaxActiveBlocksPerMultiprocessor(&per_cu, (const void*)fwd, NTHREADS, LDS_BYTES);
        (void)hipGetLastError();
        if (per_cu < 1) per_cu = 1;
        grid = cus;
        if (grid > 256) grid = 256;
    }
    if (grid < 0) return;
    hipMemsetAsync((char*)d_ws + WS_CTL, 0, CTL_BYTES, stream);
    Params p{};
    for (int i = 0; i < 28; ++i) p.in[i] = (const float*)d_in[i];
    p.out = (float*)d_out; p.ws = (unsigned char*)d_ws; p.use_cg = 0; p.pad = 0;
#if SINGLE_LAUNCH
    p.ph_lo = 0; p.ph_hi = NPHASE;
    void* args[] = {&p};
    hipError_t e = hipLaunchCooperativeKernel((const void*)fwd, dim3(grid), dim3(NTHREADS), args, LDS_BYTES, stream);
    if (e != hipSuccess) fprintf(stderr, "cooperative launch failed: %s (grid %d)\n", hipGetErrorString(e), grid);
#else
    for (int ph = 0; ph < NPHASE; ++ph) {
        p.ph_lo = ph; p.ph_hi = ph + 1;
        hipLaunchKernelGGL(fwd, dim3(grid), dim3(NTHREADS), LDS_BYTES, stream, p);
    }
#endif
}
```
